# Optimizing an MI355X kernel written in HIP

```python
import math
import jax, jax.numpy as jnp
from jax import lax
import numpy as np

D_MODEL = 1024
BATCH = 1
SEQ = 16384
DEPTH = 4

N_MIXERS = 3
HGRN_EXPAND = 128
HGRN_HEADS = D_MODEL // HGRN_EXPAND
HGRN_DV = D_MODEL // HGRN_HEADS
HGRN_CHUNK = 64
ATTN_HEADS = 8
HEAD_DIM = D_MODEL // ATTN_HEADS
MOBA_BLOCK = 256
MOBA_TOPK = 3
MOBA_QCHUNK = 64
ROPE_THETA = 500000.0
ROPE_DIM = HEAD_DIM // 4
CONV_WIDTH = 3
D_FF = 2816
FFN_CONV_WIDTH = 3
LN_EPS = 1e-5
RMS_EPS = 1e-6
DEEPNORM_ALPHA = (2.0 * DEPTH) ** 0.25
DEEPNORM_BETA = (8.0 * DEPTH) ** -0.25
MASK_NEG = -1e30

kernel_name = 'hybrid_hgrn2_moba_shortconv_deepnorm'


def layer_norm(x, g, b):
    xf = x.astype(jnp.float32)
    mu = jnp.mean(xf, axis=-1, keepdims=True)
    var = jnp.mean(jnp.square(xf - mu), axis=-1, keepdims=True)
    y = (xf - mu) * lax.rsqrt(var + LN_EPS) * g.astype(jnp.float32) + b.astype(jnp.float32)
    return y.astype(x.dtype)


def causal_dwconv(x, w):
    W = w.shape[0]
    S = x.shape[1]
    xp = jnp.pad(x, ((0, 0), (W - 1, 0), (0, 0)))
    return sum(xp[:, j:j + S, :] * w[j] for j in range(W))


def partial_rope(x, positions):
    half = ROPE_DIM // 2
    inv_freq = 1.0 / (ROPE_THETA ** (jnp.arange(0, ROPE_DIM, 2, dtype=jnp.float32) / ROPE_DIM))
    ang = positions.astype(jnp.float32)[..., None] * inv_freq
    cos = jnp.cos(ang)[:, :, None, :]
    sin = jnp.sin(ang)[:, :, None, :]
    xf = x.astype(jnp.float32)
    x1 = xf[..., :half]
    x2 = xf[..., half:ROPE_DIM]
    out = jnp.concatenate([x1 * cos - x2 * sin, x2 * cos + x1 * sin, xf[..., ROPE_DIM:]], axis=-1)
    return out.astype(x.dtype)


def hgrn_lower_bound(lower_bounds, layer):
    s = jax.nn.softmax(lower_bounds.astype(jnp.float32), axis=0)
    lb = jnp.cumsum(s, axis=0) - s[0]
    return lb[layer]


def hgrn2_mixer(x, lb, w_in, norm_g, w_out):
    B, S, _ = x.shape
    H, dk, dv, C = HGRN_HEADS, HGRN_EXPAND, HGRN_DV, HGRN_CHUNK
    NC = S // C
    proj = x @ w_in
    q, fz, i, gate = jnp.split(proj, [H * dk, 2 * H * dk, 2 * H * dk + H * dv], axis=-1)
    q = jax.nn.silu(q.astype(jnp.float32)).reshape(B, S, H, dk)
    fz = fz.astype(jnp.float32).reshape(B, S, H, dk)
    lb = lb.reshape(H, dk)
    sig = jax.nn.sigmoid(fz)
    k = (1.0 - lb) * (1.0 - sig)
    g = jnp.log(lb + (1.0 - lb) * sig)
    v = i.astype(jnp.float32).reshape(B, S, H, dv)

    def to_chunks(t):
        return t.reshape(B, NC, C, H, t.shape[-1]).transpose(1, 0, 3, 2, 4)

    qc, kc, vc, gc = to_chunks(q), to_chunks(k), to_chunks(v), to_chunks(g)
    bc = jnp.cumsum(gc, axis=3)
    causal = jnp.tril(jnp.ones((C, C), dtype=bool))[:, :, None]

    def step(state, inp):
        q_, k_, v_, b_ = inp
        o_inter = jnp.einsum('bhtd,bhdv->bhtv', q_ * jnp.exp(b_), state)
        diff = b_[:, :, :, None, :] - b_[:, :, None, :, :]
        decay = jnp.where(causal, jnp.exp(jnp.where(causal, diff, 0.0)), 0.0)
        a = jnp.einsum('bhtd,bhsd,bhtsd->bhts', q_, k_, decay)
        o = o_inter + jnp.einsum('bhts,bhsv->bhtv', a, v_)
        b_last = b_[:, :, -1, :]
        k_dec = k_ * jnp.exp(b_last[:, :, None, :] - b_)
        state = jnp.exp(b_last)[..., None] * state + jnp.einsum('bhsd,bhsv->bhdv', k_dec, v_)
        return state, o

    state0 = jnp.zeros((B, H, dk, dv), jnp.float32)
    _, oc = lax.scan(step, state0, (qc, kc, vc, bc))
    o = oc.transpose(1, 0, 3, 2, 4).reshape(B, S, H, dv)
    o = o * lax.rsqrt(jnp.mean(jnp.square(o), axis=-1, keepdims=True) + RMS_EPS)
    o = o.reshape(B, S, H * dv) * norm_g.astype(jnp.float32) * jax.nn.silu(gate.astype(jnp.float32))
    return o.astype(x.dtype) @ w_out


def moba_mixer(x, positions, w_in, w_out):
    B, S, _ = x.shape
    H, hd, L = ATTN_HEADS, HEAD_DIM, MOBA_BLOCK
    qkv = (x @ w_in).reshape(B, S, 3, H, hd)
    q = partial_rope(qkv[:, :, 0], positions)
    k = partial_rope(qkv[:, :, 1], positions)
    v = qkv[:, :, 2]
    Sp = -(-S // L) * L
    pad = Sp - S
    q, k, v = [jnp.pad(t, ((0, 0), (0, pad), (0, 0), (0, 0))) for t in (q, k, v)]
    NB = Sp // L
    K = min(MOBA_TOPK, NB)
    kb = k.reshape(B, NB, L, H, hd).transpose(0, 1, 3, 2, 4)
    vb = v.reshape(B, NB, L, H, hd).transpose(0, 1, 3, 2, 4)
    kmean = jnp.mean(kb.astype(jnp.float32), axis=3)
    gate = jnp.einsum('bshd,bnhd->bshn', q.astype(jnp.float32), kmean)
    qblk = jnp.arange(Sp) // L
    past = jnp.arange(NB)[None, :] < qblk[:, None]
    gate = jnp.where(past[None, :, None, :], gate, MASK_NEG)
    _, sel = lax.top_k(gate, K)

    QC = MOBA_QCHUNK
    NQ = Sp // QC
    q_chunks = q.reshape(B, NQ, QC, H, hd).transpose(1, 0, 2, 3, 4)
    sel_chunks = sel.reshape(B, NQ, QC, H, K).transpose(1, 0, 2, 3, 4)
    bidx = jnp.arange(B)[:, None, None, None]
    hidx = jnp.arange(H)[None, None, :, None]
    scale = 1.0 / math.sqrt(hd)

    def attend(args):
        qc, sc, ci = args
        start = ci * QC
        blk = start // L
        k_sel = kb[bidx, sc, hidx]
        v_sel = vb[bidx, sc, hidx]
        k_own = lax.dynamic_index_in_dim(kb, blk, axis=1, keepdims=False)
        v_own = lax.dynamic_index_in_dim(vb, blk, axis=1, keepdims=False)
        s_sel = jnp.einsum('bqhd,bqhjld->bqhjl', qc, k_sel).astype(jnp.float32) * scale
        slot_ok = jnp.arange(K) < blk
        s_sel = jnp.where(slot_ok[:, None], s_sel, MASK_NEG).reshape(B, QC, H, K * L)
        s_own = jnp.einsum('bqhd,bhld->bqhl', qc, k_own).astype(jnp.float32) * scale
        qpos = start + jnp.arange(QC)
        kpos = blk * L + jnp.arange(L)
        s_own = jnp.where((kpos[None, :] <= qpos[:, None])[None, :, None, :], s_own, MASK_NEG)
        p = jax.nn.softmax(jnp.concatenate([s_sel, s_own], axis=-1), axis=-1).astype(v.dtype)
        p_sel = p[..., :K * L].reshape(B, QC, H, K, L)
        p_own = p[..., K * L:]
        return (jnp.einsum('bqhjl,bqhjld->bqhd', p_sel, v_sel)
                + jnp.einsum('bqhl,bhld->bqhd', p_own, v_own))

    o = lax.map(attend, (q_chunks, sel_chunks, jnp.arange(NQ)))
    o = o.transpose(1, 0, 2, 3, 4).reshape(B, Sp, H * hd)[:, :S]
    return o @ w_out


def short_conv_mixer(x, w_in, conv_w, w_out):
    bg, cg, h = jnp.split(x @ w_in, 3, axis=-1)
    y = bg * causal_dwconv(cg * h, conv_w)
    return y @ w_out


def conv_ffn(x, w_up, conv_w, w_down):
    u = causal_dwconv(x @ w_up, conv_w)
    a, b = jnp.split(u, 2, axis=-1)
    return (jax.nn.silu(a) * b) @ w_down


def setup_inputs(seed: int = 0) -> dict:
    key = jax.random.key(seed)
    keys = iter(jax.random.split(key, 64))

    def nrm(shape, scale):
        return jax.random.normal(next(keys), shape, jnp.float32) * scale

    D = D_MODEL
    p = {}
    p['x'] = nrm((BATCH, SEQ, D), 1.0)
    p['positions'] = jnp.tile(jnp.arange(SEQ, dtype=jnp.int32)[None, :], (BATCH, 1))
    p['hgrn_lower_bounds'] = nrm((DEPTH, HGRN_HEADS * HGRN_EXPAND), 0.5)
    for i in range(DEPTH):
        kind = i % N_MIXERS
        if kind == 0:
            p[f'l{i}_mix_w_in'] = nrm((D, 2 * HGRN_HEADS * HGRN_EXPAND + 2 * HGRN_HEADS * HGRN_DV), D ** -0.5)
            p[f'l{i}_mix_norm_g'] = 1.0 + nrm((HGRN_HEADS * HGRN_DV,), 0.02)
            p[f'l{i}_mix_w_out'] = nrm((HGRN_HEADS * HGRN_DV, D), DEEPNORM_BETA * (HGRN_HEADS * HGRN_DV) ** -0.5)
        elif kind == 1:
            p[f'l{i}_mix_w_in'] = nrm((D, 3 * ATTN_HEADS * HEAD_DIM), D ** -0.5)
            p[f'l{i}_mix_w_out'] = nrm((ATTN_HEADS * HEAD_DIM, D), DEEPNORM_BETA * (ATTN_HEADS * HEAD_DIM) ** -0.5)
        else:
            p[f'l{i}_mix_w_in'] = nrm((D, 3 * D), D ** -0.5)
            p[f'l{i}_mix_conv'] = nrm((CONV_WIDTH, D), CONV_WIDTH ** -0.5)
            p[f'l{i}_mix_w_out'] = nrm((D, D), DEEPNORM_BETA * D ** -0.5)
        p[f'l{i}_ln1_g'] = 1.0 + nrm((D,), 0.02)
        p[f'l{i}_ln1_b'] = nrm((D,), 0.02)
        p[f'l{i}_ffn_w_up'] = nrm((D, 2 * D_FF), D ** -0.5)
        p[f'l{i}_ffn_conv'] = nrm((FFN_CONV_WIDTH, 2 * D_FF), FFN_CONV_WIDTH ** -0.5)
        p[f'l{i}_ffn_w_down'] = nrm((D_FF, D), DEEPNORM_BETA * D_FF ** -0.5)
        p[f'l{i}_ln2_g'] = 1.0 + nrm((D,), 0.02)
        p[f'l{i}_ln2_b'] = nrm((D,), 0.02)
    return p


def reference(x, positions, hgrn_lower_bounds,
              l0_mix_w_in, l0_mix_norm_g, l0_mix_w_out, l0_ln1_g, l0_ln1_b,
              l0_ffn_w_up, l0_ffn_conv, l0_ffn_w_down, l0_ln2_g, l0_ln2_b,
              l1_mix_w_in, l1_mix_w_out, l1_ln1_g, l1_ln1_b,
              l1_ffn_w_up, l1_ffn_conv, l1_ffn_w_down, l1_ln2_g, l1_ln2_b,
              l2_mix_w_in, l2_mix_conv, l2_mix_w_out, l2_ln1_g, l2_ln1_b,
              l2_ffn_w_up, l2_ffn_conv, l2_ffn_w_down, l2_ln2_g, l2_ln2_b,
              l3_mix_w_in, l3_mix_norm_g, l3_mix_w_out, l3_ln1_g, l3_ln1_b,
              l3_ffn_w_up, l3_ffn_conv, l3_ffn_w_down, l3_ln2_g, l3_ln2_b):
    layers = [
        ((l0_mix_w_in, l0_mix_norm_g, l0_mix_w_out), l0_ln1_g, l0_ln1_b,
         (l0_ffn_w_up, l0_ffn_conv, l0_ffn_w_down), l0_ln2_g, l0_ln2_b),
        ((l1_mix_w_in, l1_mix_w_out), l1_ln1_g, l1_ln1_b,
         (l1_ffn_w_up, l1_ffn_conv, l1_ffn_w_down), l1_ln2_g, l1_ln2_b),
        ((l2_mix_w_in, l2_mix_conv, l2_mix_w_out), l2_ln1_g, l2_ln1_b,
         (l2_ffn_w_up, l2_ffn_conv, l2_ffn_w_down), l2_ln2_g, l2_ln2_b),
        ((l3_mix_w_in, l3_mix_norm_g, l3_mix_w_out), l3_ln1_g, l3_ln1_b,
         (l3_ffn_w_up, l3_ffn_conv, l3_ffn_w_down), l3_ln2_g, l3_ln2_b),
    ]
    for i in range(DEPTH):
        mix_p, ln1_g, ln1_b, ffn_p, ln2_g, ln2_b = layers[i]
        kind = i % N_MIXERS
        if kind == 0:
            m = hgrn2_mixer(x, hgrn_lower_bound(hgrn_lower_bounds, i), *mix_p)
        elif kind == 1:
            m = moba_mixer(x, positions, *mix_p)
        else:
            m = short_conv_mixer(x, *mix_p)
        x = layer_norm(DEEPNORM_ALPHA * x + m, ln1_g, ln1_b)
        x = layer_norm(DEEPNORM_ALPHA * x + conv_ffn(x, *ffn_p), ln2_g, ln2_b)
    return x
```

```cpp
#include <hip/hip_runtime.h>
#include <hip/hip_cooperative_groups.h>
#include <cstdio>
#include <cstdint>
namespace cg = cooperative_groups;

#ifndef ONE_LAUNCH
#define ONE_LAUNCH 1
#endif
#define DBG_SKIPR 0
#define R1_VAR 0

namespace pg8 {
#define PG8_LAS __attribute__((address_space(3)))
typedef unsigned short bf16_t;
typedef short bf16x8 __attribute__((ext_vector_type(8)));
typedef float f32x4 __attribute__((ext_vector_type(4)));
typedef unsigned u32x4 __attribute__((ext_vector_type(4)));
constexpr int BM = 256, BK = 64, HALF = 128, HTB = HALF * BK * 2  , STAGE_BYTES = 8 * HTB, NXCD = 8, WGM = 8;

__host__ __device__ __forceinline__ int lds_byte(int r, int c) { const int st = (r >> 4) * 2 + (c >> 5), rr = r & 15, cc = c & 31, ob = rr * 64 + cc * 2; return st * 1024 + (ob ^ (((ob >> 9) & 1) << 5)); }
__host__ __device__ __forceinline__ void stage_rc(int b, int& R, int& C) { const int st = b / 1024, sb = b % 1024, swz = sb ^ (((sb >> 9) & 1) << 5); R = (st >> 1) * 16 + swz / 64; C = (st & 1) * 32 + (swz % 64) / 2; }
__host__ __device__ __forceinline__ int perm32(int rho) { const int n = rho >> 4, i = rho & 15; return 8 * (i >> 2) + 4 * n + (i & 3); }

struct Unit { int pm, pn; };
struct Gemm { const bf16_t* A; const bf16_t* Bt; int M, N, K, amode; };

typedef float f32x2_t __attribute__((ext_vector_type(2))); typedef __bf16 bf16x2_t __attribute__((ext_vector_type(2)));
__device__ __forceinline__ unsigned cvt_pk_bf16(float lo, float hi) { f32x2_t v = {lo, hi}; bf16x2_t b = __builtin_convertvector(v, bf16x2_t); return __builtin_bit_cast(unsigned, b); }

struct StaticOrder {
    int nM, nN, nwg, G, c;
    __host__ __device__ void init(int nM_, int nN_, int G_, int c_) { nM = nM_; nN = nN_; nwg = nM * nN; G = G_; c = c_; }
    __host__ __device__ bool next(int i, Unit& u) const {
        const long L = (long)i * G + c; if (L >= nwg) return false;
        int wgid = (int)L; { const int q = nwg / NXCD, r = nwg % NXCD, xcd = wgid % NXCD, off = wgid / NXCD; wgid = (xcd < r ? xcd * (q + 1) : r * (q + 1) + (xcd - r) * q) + off; }
        const int nig = WGM * nN, gid = wgid / nig, fm = gid * WGM, gsz = (nM - fm) < WGM ? (nM - fm) : WGM;
        u.pm = fm + ((wgid % nig) % gsz); u.pn = (wgid % nig) / gsz; return true;
    }
    __device__ __forceinline__ void a_ready(const Unit&) const {}
    __device__ __forceinline__ void done(const Unit&) const {}
};

typedef unsigned u32x2 __attribute__((ext_vector_type(2)));
typedef _Float16 h16x4 __attribute__((ext_vector_type(4)));
__device__ __forceinline__ float bf_lo(unsigned w) { return __uint_as_float(w << 16); }
__device__ __forceinline__ float bf_hi(unsigned w) { return __uint_as_float(w & 0xffff0000u); }
__device__ __forceinline__ float silu_f(float x) { return x * __builtin_amdgcn_rcpf(1.0f + __builtin_amdgcn_exp2f(-1.4426950408889634f * x)); }
__device__ __forceinline__ float ror1(float x) { return __int_as_float(__builtin_amdgcn_update_dpp(0, __float_as_int(x), 0x121, 0xF, 0xF, false)); }
__device__ __forceinline__ float ror2(float x) { return __int_as_float(__builtin_amdgcn_update_dpp(0, __float_as_int(x), 0x122, 0xF, 0xF, false)); }
__device__ const double ROPE_F[16] = {0.15915494309189535, 0.070086521587798503, 0.03086376340470123, 0.013591370636193905, 0.0059851857127137054, 0.002635675898667414, 0.001160663641240061, 0.00051111750453754386,
    0.00022507907903927653, 9.9117309369019355e-05, 4.3647952792802891e-05, 1.9221100684944863e-05, 8.4643308082414014e-06, 3.7274086019153519e-06, 1.6414262627950345e-06, 7.2282930688328648e-07};
constexpr int TOK = 16384;
constexpr float DN_ALPHA = 1.6817928305074290f;
enum { EPI_SILU_SPLIT = 0, EPI_PLAIN = 1, EPI_ROPE_SPLIT = 2, EPI_T_HGRN = 3, EPI_T_PLAIN = 4, EPI_RES = 5, EPI_UPCONV = 6 };
struct Epi {
    static constexpr bool PERM = false, AFTER_DRAIN = false;
    int mode, ldc; void* O0; void* O1; const float* aux; const int* pos;
    __device__ __forceinline__ void st4(bf16_t* p, f32x4 v) const { u32x2 w; w.x = cvt_pk_bf16(v[0], v[1]); w.y = cvt_pk_bf16(v[2], v[3]); *(u32x2*)p = w; }
    __device__ __forceinline__ void operator()(const f32x4 (&acc)[2][2][4][2], const Unit& u, int wr, int wc, int fr, int fq) const {
        const int row0 = u.pm * BM + wr * 64 + fr, col0 = u.pn * BM + wc * 32 + 4 * fq;
        if (mode == EPI_RES) {
            float* Y = (float*)O0; const bf16_t* XB = (const bf16_t*)O1;
#pragma unroll
            for (int ai = 0; ai < 2; ++ai)
#pragma unroll
                for (int m = 0; m < 4; ++m) { const size_t ro = (size_t)(row0 + ai * HALF + m * 16) * 1024 + col0;
#pragma unroll
                    for (int bj = 0; bj < 2; ++bj)
#pragma unroll
                        for (int n = 0; n < 2; ++n) { const size_t o = ro + bj * HALF + n * 16; const u32x2 xw = *(const u32x2*)(XB + o);
                            f32x4 r; r[0] = DN_ALPHA * bf_lo(xw.x) + acc[ai][bj][m][n][0]; r[1] = DN_ALPHA * bf_hi(xw.x) + acc[ai][bj][m][n][1];
                            r[2] = DN_ALPHA * bf_lo(xw.y) + acc[ai][bj][m][n][2]; r[3] = DN_ALPHA * bf_hi(xw.y) + acc[ai][bj][m][n][3];
                            *(f32x4*)(Y + o) = r; } }
        } else if (mode == EPI_UPCONV) {
            bf16_t* H = (bf16_t*)O0; const float* cw = aux;
            const int cbase = 128 * u.pn + 32 * wc + 4 * fq;
#pragma unroll
            for (int n = 0; n < 2; ++n) {
                const f32x4 wa0 = *(const f32x4*)(cw + cbase + 16 * n), wa1 = *(const f32x4*)(cw + 5632 + cbase + 16 * n), wa2 = *(const f32x4*)(cw + 2 * 5632 + cbase + 16 * n);
                const f32x4 wb0 = *(const f32x4*)(cw + 2816 + cbase + 16 * n), wb1 = *(const f32x4*)(cw + 5632 + 2816 + cbase + 16 * n), wb2 = *(const f32x4*)(cw + 2 * 5632 + 2816 + cbase + 16 * n);
#pragma unroll
                for (int ai = 0; ai < 2; ++ai) { const int tok0 = 248 * u.pm + 62 * (2 * ai + wr) - 2;
                    f32x4 pa1 = {0.f, 0.f, 0.f, 0.f}, pa2 = pa1, pb1 = pa1, pb2 = pa1;
#pragma unroll
                    for (int m = 0; m < 4; ++m) { const int rho = 16 * m + fr, tok = tok0 + rho;
                        const f32x4 za = acc[ai][0][m][n], zb = acc[ai][1][m][n]; f32x4 ra1, ra2, rb1, rb2, hv;
#pragma unroll
                        for (int e = 0; e < 4; ++e) { ra1[e] = ror1(za[e]); ra2[e] = ror2(za[e]); rb1[e] = ror1(zb[e]); rb2[e] = ror2(zb[e]); }
#pragma unroll
                        for (int e = 0; e < 4; ++e) {
                            float a1 = fr == 0 ? pa1[e] : ra1[e], a2 = fr < 2 ? pa2[e] : ra2[e], b1 = fr == 0 ? pb1[e] : rb1[e], b2 = fr < 2 ? pb2[e] : rb2[e];
                            if (tok < 1) { a1 = 0.f; b1 = 0.f; } if (tok < 2) { a2 = 0.f; b2 = 0.f; }
                            const float ua = wa2[e] * za[e] + wa1[e] * a1 + wa0[e] * a2, ub = wb2[e] * zb[e] + wb1[e] * b1 + wb0[e] * b2;
                            hv[e] = silu_f(ua) * ub; }
                        if (rho >= 2 && tok < TOK) st4(H + (size_t)tok * 2816 + cbase + 16 * n, hv);
                        pa1 = ra1; pa2 = ra2; pb1 = rb1; pb2 = rb2; }
                    asm volatile("" ::: "memory"); } }
        } else if (mode == EPI_T_HGRN || mode == EPI_T_PLAIN) {
            const bool isg = (mode == EPI_T_HGRN) && (u.pm < 4);
            bf16_t* base = (mode == EPI_T_HGRN && u.pm >= 4) ? (bf16_t*)O1 - (size_t)1024 * TOK : (bf16_t*)O0;
#pragma unroll
            for (int ai = 0; ai < 2; ++ai)
#pragma unroll
                for (int m = 0; m < 4; ++m) { const int r = row0 + ai * HALF + m * 16; const size_t ro = (size_t)r * TOK + col0; const float lb = isg ? aux[r] : 0.f;
#pragma unroll
                    for (int bj = 0; bj < 2; ++bj)
#pragma unroll
                        for (int n = 0; n < 2; ++n) { const f32x4 v = acc[ai][bj][m][n]; bf16_t* p = base + ro + bj * HALF + n * 16;
                            if (isg) { h16x4 hg;
#pragma unroll
                                for (int e = 0; e < 4; ++e) { const float sg = __builtin_amdgcn_rcpf(1.0f + __expf(-v[e])); hg[e] = (_Float16)__logf(lb + (1.0f - lb) * sg); }
                                *(h16x4*)p = hg; }
                            else st4(p, v); } }
        } else {
            int colt = u.pn * BM; bf16_t* base = (bf16_t*)O0;
            if (mode != EPI_PLAIN) { if (colt >= 1024) { base = (bf16_t*)O1; colt -= 1024; } }
            const int c0 = colt + wc * 32 + 4 * fq;
            double rf[4];
#pragma unroll
            for (int e = 0; e < 4; ++e) rf[e] = ROPE_F[4 * fq + e];
#pragma unroll
            for (int ai = 0; ai < 2; ++ai)
#pragma unroll
                for (int m = 0; m < 4; ++m) { const int r = row0 + ai * HALF + m * 16; bf16_t* rowp = base + (size_t)r * ldc + c0;
                    float cs[4], sn[4];
                    if (mode == EPI_ROPE_SPLIT && wc == 0) { const double pp = (double)pos[r];
#pragma unroll
                        for (int e = 0; e < 4; ++e) { double tt = pp * rf[e]; tt -= __builtin_floor(tt); const float tf = (float)tt; sn[e] = __builtin_amdgcn_sinf(tf); cs[e] = __builtin_amdgcn_cosf(tf); } }
#pragma unroll
                    for (int bj = 0; bj < 2; ++bj) { f32x4 v0 = acc[ai][bj][m][0], v1 = acc[ai][bj][m][1];
                        if (mode == EPI_SILU_SPLIT) {
#pragma unroll
                            for (int e = 0; e < 4; ++e) { v0[e] = silu_f(v0[e]); v1[e] = silu_f(v1[e]); } }
                        if (mode == EPI_ROPE_SPLIT && wc == 0) {
#pragma unroll
                            for (int e = 0; e < 4; ++e) { const float x1 = v0[e], x2 = v1[e]; v0[e] = x1 * cs[e] - x2 * sn[e]; v1[e] = x2 * cs[e] + x1 * sn[e]; } }
                        st4(rowp + bj * HALF, v0); st4(rowp + bj * HALF + 16, v1); } }
        }
    }
};

template <class Epi, class Sched, bool ALIGN_EPI = false, bool SP2 = false>
__device__ __forceinline__ void gemm_phase(PG8_LAS unsigned char* lds, const Gemm g, const Sched& S, const Epi& E) {
    int tid = threadIdx.x; asm volatile("" : "+v"(tid));
    const int wid = __builtin_amdgcn_readfirstlane(tid >> 6), lane = tid & 63, wr = wid >> 2, wc = wid & 3, fr = lane & 15, fq = lane >> 4;
    const int K = g.K, nt = K / BK;
    unsigned voffA[2], voffB[2];
#pragma unroll
    for (int i = 0; i < 2; ++i) { int R, C; stage_rc(tid * 16 + i * 8192, R, C); const int Rb = Epi::PERM ? ((R & ~31) + perm32(R & 31)) : R;
        voffA[i] = (unsigned)((g.amode ? (R - 2 * (R >> 6)) : R) * K + C) * 2u; voffB[i] = (unsigned)(Rb * K + C) * 2u; }
    const size_t kstep = (size_t)(BK * 2);
    const size_t hstep = (size_t)HALF * K * 2;
    const size_t tstep = 2 * hstep;  const size_t hstepA = g.amode ? (size_t)124 * K * 2 : hstep, tstepA = 2 * hstepA;
    const unsigned ldsw = (unsigned)wid * 1024u;
    const int aoff = lds_byte(wr * 64 + fr, fq * 8), boff = lds_byte(wc * 32 + fr, fq * 8);
#define PG8_SA(b, h) (((b) * 2 + (h)) * HTB)
#define PG8_SB(b, h) ((4 + (b) * 2 + (h)) * HTB)
#define PG8_STAGE(bufoff, gbase, voff) do { _Pragma("unroll") for (int _i = 0; _i < 2; ++_i) \
        __builtin_amdgcn_global_load_lds((const unsigned*)((const char*)(gbase) + (voff)[_i]), (PG8_LAS unsigned*)(lds + (bufoff) + ldsw + _i * 8192), 16, 0, 0); } while (0)
#define PG8_LDA(dst, b, h) do { _Pragma("unroll") for (int m = 0; m < 4; ++m) _Pragma("unroll") for (int k = 0; k < 2; ++k) dst[m][k] = *(const PG8_LAS bf16x8*)(lds + PG8_SA(b, h) + aoff + m * 2048 + k * 1024); } while (0)
#define PG8_LDB(dst, b, h) do { _Pragma("unroll") for (int n = 0; n < 2; ++n) _Pragma("unroll") for (int k = 0; k < 2; ++k) dst[n][k] = *(const PG8_LAS bf16x8*)(lds + PG8_SB(b, h) + boff + n * 2048 + k * 1024); } while (0)
#define PG8_MMA(ai, bj, At, Bt) do { __builtin_amdgcn_s_setprio(1); _Pragma("unroll") for (int m = 0; m < 4; ++m) _Pragma("unroll") for (int n = 0; n < 2; ++n) _Pragma("unroll") for (int k = 0; k < 2; ++k) \
        acc[ai][bj][m][n] = __builtin_amdgcn_mfma_f32_16x16x32_bf16(Bt[n][k], At[m][k], acc[ai][bj][m][n], 0, 0, 0); __builtin_amdgcn_s_setprio(0); } while (0)
#define PG8_WAIT_V(n) asm volatile("s_waitcnt vmcnt(" #n ")" ::: "memory")
#define PG8_WAIT_L(n) asm volatile("s_waitcnt lgkmcnt(" #n ")" ::: "memory")
#define PG8_BAR __builtin_amdgcn_s_barrier()
#define PG8_SCHED __builtin_amdgcn_sched_barrier(0)
    Unit cur, nxt; int ui = 0;
    if (!S.next(0, cur)) return;
    f32x4 acc[2][2][4][2];
#pragma unroll
    for (int a = 0; a < 2; ++a)
#pragma unroll
        for (int b = 0; b < 2; ++b)
#pragma unroll
            for (int m = 0; m < 4; ++m)
#pragma unroll
                for (int n = 0; n < 2; ++n) acc[a][b][m][n] = (f32x4){0.f, 0.f, 0.f, 0.f};
    bf16x8 At[4][2], B0[2][2], B1[2][2];
    const char* cA = (const char*)g.A + (size_t)cur.pm * tstepA; const char* cB = (const char*)g.Bt + (size_t)cur.pn * tstep;
    S.a_ready(cur);
    if constexpr (SP2) {
        PG8_STAGE(PG8_SB(0, 0), cB, voffB); PG8_STAGE(PG8_SB(0, 1), cB + hstep, voffB); PG8_STAGE(PG8_SA(0, 0), cA, voffA); PG8_STAGE(PG8_SA(0, 1), cA + hstepA, voffA);
        if (wr == 1) PG8_BAR;
        PG8_WAIT_V(2); PG8_BAR;
        PG8_STAGE(PG8_SB(1, 0), cB + kstep, voffB); PG8_STAGE(PG8_SA(1, 0), cA + kstep, voffA); PG8_STAGE(PG8_SB(1, 1), cB + hstep + kstep, voffB);
        PG8_WAIT_V(6); PG8_BAR;
    } else {
        PG8_STAGE(PG8_SB(0, 0), cB, voffB); PG8_STAGE(PG8_SA(0, 0), cA, voffA); PG8_STAGE(PG8_SB(0, 1), cB + hstep, voffB); PG8_STAGE(PG8_SA(0, 1), cA + hstepA, voffA);
        if (wr == 1) PG8_BAR;
        PG8_WAIT_V(4); PG8_BAR;
        PG8_STAGE(PG8_SB(1, 0), cB + kstep, voffB); PG8_STAGE(PG8_SA(1, 0), cA + kstep, voffA); PG8_STAGE(PG8_SB(1, 1), cB + hstep + kstep, voffB);
        PG8_WAIT_V(6); PG8_BAR;
    }
    for (;;) {
        const bool has_next = S.next(ui + 1, nxt);
        const char* nA = has_next ? (const char*)g.A + (size_t)nxt.pm * tstepA : cA; const char* nB = has_next ? (const char*)g.Bt + (size_t)nxt.pn * tstep : cB;
        for (int t = 0; t < nt; t += 2) {
            const bool last = (t == nt - 2);
            const char* a1 = cA + (size_t)(t + 1) * kstep;
            const char* a2 = last ? nA : cA + (size_t)(t + 2) * kstep; const char* b2 = last ? nB : cB + (size_t)(t + 2) * kstep;
            const char* a3 = a2 + kstep; const char* b3 = b2 + kstep;
            if (last && has_next) S.a_ready(nxt);
            if constexpr (SP2) {
            PG8_LDB(B0, 0, 0); PG8_LDB(B1, 0, 1); PG8_SCHED; PG8_LDA(At, 0, 0); PG8_STAGE(PG8_SA(1, 1), a1 + hstepA, voffA);
            PG8_WAIT_V(8); PG8_WAIT_L(0); PG8_BAR; PG8_MMA(0, 0, At, B0); PG8_MMA(0, 1, At, B1); PG8_BAR; PG8_SCHED;
            PG8_LDA(At, 0, 1); PG8_STAGE(PG8_SB(0, 0), b2, voffB); PG8_STAGE(PG8_SB(0, 1), b2 + hstep, voffB); PG8_STAGE(PG8_SA(0, 0), a2, voffA);
            PG8_WAIT_V(8); PG8_WAIT_L(0); PG8_BAR; PG8_MMA(1, 0, At, B0); PG8_MMA(1, 1, At, B1); PG8_BAR; PG8_SCHED;
            PG8_LDB(B0, 1, 0); PG8_LDB(B1, 1, 1); PG8_SCHED; PG8_LDA(At, 1, 0); PG8_STAGE(PG8_SA(0, 1), a2 + hstepA, voffA);
            PG8_WAIT_V(8); PG8_WAIT_L(0); PG8_BAR; PG8_MMA(0, 0, At, B0); PG8_MMA(0, 1, At, B1); PG8_BAR; PG8_SCHED;
            PG8_LDA(At, 1, 1); PG8_STAGE(PG8_SB(1, 0), b3, voffB); PG8_STAGE(PG8_SB(1, 1), b3 + hstep, voffB); PG8_STAGE(PG8_SA(1, 0), a3, voffA);
            PG8_WAIT_V(8); PG8_WAIT_L(0); PG8_BAR; PG8_MMA(1, 0, At, B0); PG8_MMA(1, 1, At, B1); PG8_BAR; PG8_SCHED;
            } else {
            PG8_LDB(B0, 0, 0); PG8_SCHED; PG8_LDA(At, 0, 0); PG8_STAGE(PG8_SA(1, 1), a1 + hstepA, voffA);
            PG8_WAIT_L(8); PG8_BAR; PG8_WAIT_L(0); PG8_MMA(0, 0, At, B0); PG8_BAR; PG8_SCHED;
            PG8_LDB(B1, 0, 1); PG8_STAGE(PG8_SB(0, 0), b2, voffB);
            PG8_BAR; PG8_WAIT_L(0); PG8_MMA(0, 1, At, B1); PG8_BAR;
            PG8_LDA(At, 0, 1); PG8_STAGE(PG8_SA(0, 0), a2, voffA);
            PG8_BAR; PG8_WAIT_L(0); PG8_MMA(1, 0, At, B0); PG8_BAR; PG8_SCHED;
            PG8_STAGE(PG8_SB(0, 1), b2 + hstep, voffB);
            PG8_WAIT_V(6); PG8_BAR; PG8_MMA(1, 1, At, B1); PG8_BAR;
            PG8_LDB(B0, 1, 0); PG8_SCHED; PG8_LDA(At, 1, 0); PG8_STAGE(PG8_SA(0, 1), a2 + hstepA, voffA);
            PG8_WAIT_L(8); PG8_BAR; PG8_WAIT_L(0); PG8_MMA(0, 0, At, B0); PG8_BAR; PG8_SCHED;
            PG8_LDB(B1, 1, 1); PG8_STAGE(PG8_SB(1, 0), b3, voffB);
            PG8_BAR; PG8_WAIT_L(0); PG8_MMA(0, 1, At, B1); PG8_BAR;
            PG8_LDA(At, 1, 1); PG8_STAGE(PG8_SA(1, 0), a3, voffA);
            PG8_BAR; PG8_WAIT_L(0); PG8_MMA(1, 0, At, B0); PG8_BAR; PG8_SCHED;
            PG8_STAGE(PG8_SB(1, 1), b3 + hstep, voffB);
            PG8_WAIT_V(6); PG8_BAR; PG8_MMA(1, 1, At, B1); PG8_BAR;
            }
        }
        if constexpr (ALIGN_EPI) { if (wr == 0) PG8_BAR; }
        if constexpr (!Epi::AFTER_DRAIN) { E(acc, cur, wr, wc, fr, fq); S.done(cur); }
        if (!has_next) break;
#pragma unroll
        for (int a = 0; a < 2; ++a)
#pragma unroll
            for (int b = 0; b < 2; ++b)
#pragma unroll
                for (int m = 0; m < 4; ++m)
#pragma unroll
                    for (int n = 0; n < 2; ++n) acc[a][b][m][n] = (f32x4){0.f, 0.f, 0.f, 0.f};
        cur = nxt; cA = nA; cB = nB; ++ui;
        if constexpr (ALIGN_EPI) { if (wr == 1) PG8_BAR; }
    }
    PG8_WAIT_V(0);
    if constexpr (!ALIGN_EPI) { if (wr == 0) PG8_BAR; }
    PG8_BAR;
    if constexpr (Epi::AFTER_DRAIN) { E.fused(acc, cur, wr, wc, fr, fq, lds, wid, lane); S.done(cur); }
#undef PG8_SA
#undef PG8_SB
#undef PG8_STAGE
#undef PG8_LDA
#undef PG8_LDB
#undef PG8_MMA
#undef PG8_WAIT_V
#undef PG8_WAIT_L
#undef PG8_BAR
#undef PG8_SCHED
}
}

#define LAS __attribute__((address_space(3)))
typedef unsigned short bf16;
typedef short bf16x8 __attribute__((ext_vector_type(8)));
typedef float f32x4 __attribute__((ext_vector_type(4)));
typedef unsigned u32x4 __attribute__((ext_vector_type(4)));
typedef unsigned u32x2 __attribute__((ext_vector_type(2)));
typedef _Float16 h16x8 __attribute__((ext_vector_type(8)));
using pg8::bf_lo; using pg8::bf_hi; using pg8::cvt_pk_bf16;

constexpr int M = 16384, D = 1024, DFF = 2816, NFF = 5632;
constexpr float LN_EPS = 1e-5f, RMS_EPS = 1e-6f;
constexpr size_t MiB = 1u << 20;
constexpr size_t WS_CNT = 0, WS_LBTAB = 4096, WS_KNMAX = 16384, WS_KMEAN = 65536, WS_QREF = 512 * 1024, WS_DEC = 1 * MiB, WS_LPART = 2 * MiB;
constexpr size_t WS_WIN = 4 * MiB, WS_WOUT = 12 * MiB, WS_WUP = 14 * MiB, WS_WDN = 25 * MiB;
constexpr size_t WS_XB = 32 * MiB, WS_L = 64 * MiB;
constexpr size_t WS_Q = WS_L, WS_GT = WS_L + 32 * MiB, WS_VT = WS_L + 64 * MiB, WS_GATE = WS_L + 96 * MiB, WS_ST = WS_L + 128 * MiB;
constexpr size_t WS_K = WS_L + 32 * MiB, WS_LIST = WS_L + 96 * MiB, WS_PART = WS_L + 104 * MiB;
constexpr size_t WS_PROJ = WS_L, WS_OGSC = WS_L + 96 * MiB;
constexpr size_t WS_H = WS_L;
constexpr size_t WS_NEED = WS_PART + 96 * MiB;
constexpr int LDS_BYTES = 147456;
#ifndef DIAG_OFF
#define DIAG_OFF WS_VT
#define DIAG_ELEMS (16u << 20)
#endif
constexpr int LIST_PER_HEAD = 256 * 2016;

enum { OP_PRO = 0, OP_HG_IN, OP_HG_R1, OP_HG_R2, OP_HG_R3, OP_MB_IN, OP_MB_KMEAN, OP_MB_GATE, OP_MB_SEL, OP_MB_OWN, OP_SC_IN, OP_SC_CONV, OP_OUT, OP_LN1, OP_UP, OP_DOWN, OP_LN2, OP_CONVW, OP_DUMP, OP_DIAG1, OP_DIAG2 };
struct Params { const float* in[42]; float* out; unsigned char* ws; unsigned char prog[64]; int nprog, lo, hi, pad; };

__device__ __forceinline__ unsigned f2bf(float f) { unsigned u = __float_as_uint(f); return (u + 0x7fffu + ((u >> 16) & 1u)) >> 16; }
__device__ __forceinline__ float bf2f(unsigned short b) { return __uint_as_float((unsigned)b << 16); }
__device__ __forceinline__ bf16x8 pack8(const float (&v)[8]) { u32x4 w; w.x = cvt_pk_bf16(v[0], v[1]); w.y = cvt_pk_bf16(v[2], v[3]); w.z = cvt_pk_bf16(v[4], v[5]); w.w = cvt_pk_bf16(v[6], v[7]); return __builtin_bit_cast(bf16x8, w); }
__device__ __forceinline__ void unpack8(bf16x8 x, float (&v)[8]) { const u32x4 w = __builtin_bit_cast(u32x4, x); v[0] = bf_lo(w.x); v[1] = bf_hi(w.x); v[2] = bf_lo(w.y); v[3] = bf_hi(w.y); v[4] = bf_lo(w.z); v[5] = bf_hi(w.z); v[6] = bf_lo(w.w); v[7] = bf_hi(w.w); }
__device__ __forceinline__ float wave_sum(float v) {
#pragma unroll
    for (int o = 1; o < 64; o <<= 1) v += __shfl_xor(v, o);
    return v;
}
#define MFMA16(a, b, c) __builtin_amdgcn_mfma_f32_16x16x32_bf16((a), (b), (c), 0, 0, 0)

__device__ __forceinline__ int kind_of(int L) { return L == 1 ? 1 : (L == 2 ? 2 : 0); }
__device__ __forceinline__ int base_of(int L) { return L == 0 ? 3 : (L == 1 ? 13 : (L == 2 ? 22 : 32)); }
__device__ __forceinline__ int wout_of(int L) { return base_of(L) + (L == 1 ? 1 : 2); }

__device__ __forceinline__ void transpose_item(const float* W, int ldw, int K, int col0, int ncols, bf16* WT, int drow0, int mode, LAS float* scr, int item, int lane) {
    const int nblk = ncols / 32, kb = item / nblk, nb = item % nblk, k0 = 64 * kb, n0 = 32 * nb;
    int dr;
    if (mode == 1) { const int c = n0; dr = c < DFF ? 256 * (c / 128) + (c % 128) : 256 * ((c - DFF) / 128) + 128 + ((c - DFF) % 128); } else dr = drow0 + n0;
#pragma unroll 8
    for (int i = 0; i < 32; ++i) { const int kk = 2 * i + (lane >> 5); scr[kk * 33 + (lane & 31)] = W[(size_t)(k0 + kk) * ldw + col0 + n0 + (lane & 31)]; }
    asm volatile("s_waitcnt lgkmcnt(0)" ::: "memory");
    const int c = lane & 7;
#pragma unroll
    for (int j = 0; j < 4; ++j) { const int n = (lane >> 3) + 8 * j; const LAS float* s = scr + (8 * c) * 33 + n;
        u32x4 o; o.x = cvt_pk_bf16(s[0 * 33], s[1 * 33]); o.y = cvt_pk_bf16(s[2 * 33], s[3 * 33]); o.z = cvt_pk_bf16(s[4 * 33], s[5 * 33]); o.w = cvt_pk_bf16(s[6 * 33], s[7 * 33]);
        *(u32x4*)(WT + (size_t)(dr + n) * K + k0 + 8 * c) = o; }
    asm volatile("s_waitcnt lgkmcnt(0)" ::: "memory");
}
__device__ __forceinline__ void convert_weights(const Params& p, unsigned char* ws, int L, LAS unsigned char* lds, int gw, int NGW, int wave, int lane) {
    LAS float* scr = (LAS float*)(lds + wave * 16384);
    const int kind = kind_of(L), wo = wout_of(L);
    const float* w_in = p.in[base_of(L)]; const float* w_out = p.in[wo]; const float* w_up = p.in[wo + 3]; const float* w_dn = p.in[wo + 5];
    bf16* WIN = (bf16*)(ws + WS_WIN); bf16* WOUT = (bf16*)(ws + WS_WOUT); bf16* WUP = (bf16*)(ws + WS_WUP); bf16* WDN = (bf16*)(ws + WS_WDN);
    const int ldin = kind == 0 ? 4096 : 3072;
    const int n0 = (kind == 0 ? 1024 : 3072), n1 = (kind == 0 ? 1024 : 0), n2 = (kind == 0 ? 2048 : 0);
    const int i0 = 16 * (n0 / 32), i1 = 16 * (n1 / 32), i2 = 16 * (n2 / 32), i3 = 16 * 32, i4 = 16 * (NFF / 32), i5 = (DFF / 64) * 32;
    const int total = i0 + i1 + i2 + i3 + i4 + i5;
    for (int it = gw; it < total; it += NGW) {
        int r = it;
        if (r < i0) { transpose_item(w_in, ldin, 1024, 0, n0, WIN, 0, 0, scr, r, lane); continue; } r -= i0;
        if (r < i1) { transpose_item(w_in, ldin, 1024, 3072, n1, WIN, 1024, 0, scr, r, lane); continue; } r -= i1;
        if (r < i2) { transpose_item(w_in, ldin, 1024, 1024, n2, WIN, 2048, 0, scr, r, lane); continue; } r -= i2;
        if (r < i3) { transpose_item(w_out, 1024, 1024, 0, 1024, WOUT, 0, 0, scr, r, lane); continue; } r -= i3;
        if (r < i4) { transpose_item(w_up, NFF, 1024, 0, NFF, WUP, 0, 1, scr, r, lane); continue; } r -= i4;
        transpose_item(w_dn, 1024, DFF, 0, 1024, WDN, 0, 0, scr, r, lane);
    }
}

__device__ __forceinline__ void ln_row(const float* yrow, const float* g, const float* b, bf16* orow, float* frow, int lane) {
    const f32x4* xr = (const f32x4*)yrow + lane;
    f32x4 v[4]; float s = 0.f;
#pragma unroll
    for (int j = 0; j < 4; ++j) { v[j] = xr[64 * j]; s += (v[j].x + v[j].y) + (v[j].z + v[j].w); }
    const float mean = wave_sum(s) * (1.f / D); float s2 = 0.f;
#pragma unroll
    for (int j = 0; j < 4; ++j) { v[j] = v[j] - mean; s2 += (v[j].x * v[j].x + v[j].y * v[j].y) + (v[j].z * v[j].z + v[j].w * v[j].w); }
    const float rstd = 1.f / sqrtf(wave_sum(s2) * (1.f / D) + LN_EPS);
#pragma unroll
    for (int j = 0; j < 4; ++j) { const f32x4 gg = ((const f32x4*)g)[lane + 64 * j], bb = ((const f32x4*)b)[lane + 64 * j]; const f32x4 o = v[j] * rstd * gg + bb;
        if (orow) { u32x2 w; w.x = cvt_pk_bf16(o.x, o.y); w.y = cvt_pk_bf16(o.z, o.w); ((u32x2*)orow)[lane + 64 * j] = w; }
        if (frow) ((f32x4*)frow)[lane + 64 * j] = o; }
}

__device__ __forceinline__ void hg_prefix(const _Float16* grow, int fr, int fq, float (&g)[2][8], float (&b)[2][8], float& blast) {
    const h16x8 v0 = *(const h16x8*)(grow + 8 * fq), v1 = *(const h16x8*)(grow + 32 + 8 * fq);
    float t0 = 0.f, t1 = 0.f;
#pragma unroll
    for (int j = 0; j < 8; ++j) { g[0][j] = (float)v0[j]; t0 += g[0][j]; b[0][j] = t0; g[1][j] = (float)v1[j]; t1 += g[1][j]; b[1][j] = t1; }
    float off0 = 0.f, off1 = 0.f, sum0 = 0.f, sum1 = 0.f;
#pragma unroll
    for (int q = 0; q < 4; ++q) { const float a0 = __shfl(t0, fr + 16 * q), a1 = __shfl(t1, fr + 16 * q); if (q < fq) { off0 += a0; off1 += a1; } sum0 += a0; sum1 += a1; }
#pragma unroll
    for (int j = 0; j < 8; ++j) { b[0][j] += off0; b[1][j] += sum0 + off1; }
    blast = sum0 + sum1;
}

__device__ __forceinline__ void hg_r1(const Params& p, unsigned char* ws, int wave, int lane) {
    const _Float16* GT = (const _Float16*)(ws + WS_GT); const bf16* VT = (const bf16*)(ws + WS_VT); bf16* ST = (bf16*)(ws + WS_ST); float* DEC = (float*)(ws + WS_DEC);
    const int fr = lane & 15, fq = lane >> 4;
    for (int unit = blockIdx.x; unit < 2048; unit += gridDim.x) {
        const int h = unit >> 8, c = unit & 255, d = 16 * wave + fr;
        float g[2][8], b[2][8], blast;
        hg_prefix(GT + (size_t)(h * 128 + d) * M + c * 64, fr, fq, g, b, blast);
        bf16x8 afr[2];
#pragma unroll
        for (int ks = 0; ks < 2; ++ks) { float kd[8];
#pragma unroll
            for (int j = 0; j < 8; ++j) {
#if R1_VAR == 1
                kd[j] = (1.0f - __expf(g[ks][j]));
#elif R1_VAR == 2
                kd[j] = __expf(blast - b[ks][j]);
#elif R1_VAR == 3
                kd[j] = 1.0f;
#else
                kd[j] = (1.0f - __expf(g[ks][j])) * __expf(blast - b[ks][j]);
#endif
            }
            afr[ks] = pack8(kd); }
        if (fq == 0) DEC[(h * 256 + c) * 128 + d] = __expf(blast);
#pragma unroll
        for (int nt = 0; nt < 8; ++nt) { f32x4 acc = {0.f, 0.f, 0.f, 0.f};
#pragma unroll
            for (int ks = 0; ks < 2; ++ks) { const bf16x8 bfr = *(const bf16x8*)(VT + (size_t)(h * 128 + 16 * nt + fr) * M + c * 64 + 32 * ks + 8 * fq); acc = MFMA16(afr[ks], bfr, acc); }
            u32x2 w; w.x = cvt_pk_bf16(acc[0], acc[1]); w.y = cvt_pk_bf16(acc[2], acc[3]);
            *(u32x2*)(ST + ((size_t)(h * 256 + c) * 128 + 16 * nt + fr) * 128 + 16 * wave + 4 * fq) = w; }
    }
}
__device__ __forceinline__ void hg_r2(const Params& p, unsigned char* ws, int tid) {
    bf16* ST = (bf16*)(ws + WS_ST); const float* DEC = (const float*)(ws + WS_DEC);
    for (int e = blockIdx.x * 512 + tid; e < 131072; e += gridDim.x * 512) {
        const int h = e >> 14, r = e & 16383, d = r & 127;
        bf16* sp = ST + (size_t)h * 256 * 16384 + r; const float* dp = DEC + h * 256 * 128 + d;
        float S = 0.f;
        for (int c = 0; c < 256; c += 8) { unsigned short loc[8]; float dc[8];
#pragma unroll
            for (int i = 0; i < 8; ++i) { loc[i] = sp[(size_t)(c + i) * 16384]; dc[i] = dp[(c + i) * 128]; }
#pragma unroll
            for (int i = 0; i < 8; ++i) { sp[(size_t)(c + i) * 16384] = (bf16)f2bf(S); S = dc[i] * S + bf2f(loc[i]); } }
    }
}
__device__ __forceinline__ void hg_r3(const Params& p, unsigned char* ws, int L, LAS unsigned char* lds, int tid, int wave, int lane) {
    const _Float16* GT = (const _Float16*)(ws + WS_GT); const bf16* VT = (const bf16*)(ws + WS_VT); const bf16* ST = (const bf16*)(ws + WS_ST);
    const bf16* Q = (const bf16*)(ws + WS_Q); const bf16* GATE = (const bf16*)(ws + WS_GATE); bf16* OG = (bf16*)(ws + WS_Q);
    const float* norm_g = p.in[base_of(L) + 1];
    LAS float* bt = (LAS float*)lds; LAS float* red = bt + 65 * 132;
    const int fr = lane & 15, fq = lane >> 4;
    if (tid < 132) bt[tid] = 0.f;
    const int mt = wave >> 1, nh = wave & 1;
    for (int unit = blockIdx.x; unit < 2048; unit += gridDim.x) {
        const int h = unit >> 8, c = unit & 255;
        { const int d = 16 * wave + fr; float g[2][8], b[2][8], blast;
            hg_prefix(GT + (size_t)(h * 128 + d) * M + c * 64, fr, fq, g, b, blast);
#pragma unroll
            for (int ks = 0; ks < 2; ++ks)
#pragma unroll
                for (int j = 0; j < 8; ++j) bt[(32 * ks + 8 * fq + j + 1) * 132 + d] = b[ks][j]; }
        __syncthreads();
        const int t = 16 * mt + fr; const size_t tok = (size_t)c * 64 + t;
        bf16x8 qtil[4], qhat[4]; float Rr[4][8];
#pragma unroll
        for (int ks = 0; ks < 4; ++ks) { float qf[8], bq[8], a[8], a2[8];
            unpack8(*(const bf16x8*)(Q + tok * 1024 + h * 128 + 32 * ks + 8 * fq), qf);
            const f32x4 b0 = *(const LAS f32x4*)(bt + (t + 1) * 132 + 32 * ks + 8 * fq), b1 = *(const LAS f32x4*)(bt + (t + 1) * 132 + 32 * ks + 8 * fq + 4);
            const f32x4 r0 = *(const LAS f32x4*)(bt + (16 * mt) * 132 + 32 * ks + 8 * fq), r1 = *(const LAS f32x4*)(bt + (16 * mt) * 132 + 32 * ks + 8 * fq + 4);
#pragma unroll
            for (int j = 0; j < 4; ++j) { bq[j] = b0[j]; bq[4 + j] = b1[j]; Rr[ks][j] = r0[j]; Rr[ks][4 + j] = r1[j]; }
#pragma unroll
            for (int j = 0; j < 8; ++j) { a[j] = qf[j] * __expf(bq[j]); a2[j] = qf[j] * __expf(bq[j] - Rr[ks][j]); }
            qtil[ks] = pack8(a); qhat[ks] = pack8(a2); }
        f32x4 o[4];
#pragma unroll
        for (int n = 0; n < 4; ++n) { o[n] = (f32x4){0.f, 0.f, 0.f, 0.f};
#pragma unroll
            for (int ks = 0; ks < 4; ++ks) { const bf16x8 sfr = *(const bf16x8*)(ST + ((size_t)(h * 256 + c) * 128 + 16 * (4 * nh + n) + fr) * 128 + 32 * ks + 8 * fq); o[n] = MFMA16(sfr, qtil[ks], o[n]); } }
        unsigned pk[4][2];
#pragma unroll
        for (int i = 0; i < 4; ++i) {
            if (i <= mt) { f32x4 sc = {0.f, 0.f, 0.f, 0.f}; const int s = 16 * i + fr;
#pragma unroll
                for (int ks = 0; ks < 4; ++ks) { float kt[8];
                    const f32x4 b0 = *(const LAS f32x4*)(bt + (s + 1) * 132 + 32 * ks + 8 * fq), b1 = *(const LAS f32x4*)(bt + (s + 1) * 132 + 32 * ks + 8 * fq + 4);
                    const f32x4 m0 = *(const LAS f32x4*)(bt + s * 132 + 32 * ks + 8 * fq), m1 = *(const LAS f32x4*)(bt + s * 132 + 32 * ks + 8 * fq + 4);
#pragma unroll
                    for (int j = 0; j < 4; ++j) { kt[j] = (1.0f - __expf(b0[j] - m0[j])) * __expf(Rr[ks][j] - b0[j]); kt[4 + j] = (1.0f - __expf(b1[j] - m1[j])) * __expf(Rr[ks][4 + j] - b1[j]); }
                    sc = MFMA16(pack8(kt), qhat[ks], sc); }
                if (i == mt) {
#pragma unroll
                    for (int j = 0; j < 4; ++j) if (4 * fq + j > fr) sc[j] = 0.f; }
                pk[i][0] = cvt_pk_bf16(sc[0], sc[1]); pk[i][1] = cvt_pk_bf16(sc[2], sc[3]);
            } else { pk[i][0] = 0u; pk[i][1] = 0u; } }
#pragma unroll
        for (int kk = 0; kk < 2; ++kk) if (2 * kk <= mt) {
            u32x4 pw; pw.x = pk[2 * kk][0]; pw.y = pk[2 * kk][1]; pw.z = pk[2 * kk + 1][0]; pw.w = pk[2 * kk + 1][1]; const bf16x8 pf = __builtin_bit_cast(bf16x8, pw);
#pragma unroll
            for (int n = 0; n < 4; ++n) { const bf16* vrow = VT + (size_t)(h * 128 + 16 * (4 * nh + n) + fr) * M + c * 64 + 32 * kk + 4 * fq;
                const u32x2 lo = *(const u32x2*)vrow, hi = *(const u32x2*)(vrow + 16); u32x4 vw; vw.x = lo.x; vw.y = lo.y; vw.z = hi.x; vw.w = hi.y;
                o[n] = MFMA16(__builtin_bit_cast(bf16x8, vw), pf, o[n]); } }
        float ss = 0.f;
#pragma unroll
        for (int n = 0; n < 4; ++n) ss += (o[n][0] * o[n][0] + o[n][1] * o[n][1]) + (o[n][2] * o[n][2] + o[n][3] * o[n][3]);
        ss += __shfl_xor(ss, 16); ss += __shfl_xor(ss, 32);
        if (fq == 0) red[wave * 16 + fr] = ss;
        __syncthreads();
        const float rstd = 1.0f / sqrtf((ss + red[(wave ^ 1) * 16 + fr]) * (1.0f / 128.0f) + RMS_EPS);
#pragma unroll
        for (int n = 0; n < 4; ++n) { const int v0 = h * 128 + 16 * (4 * nh + n) + 4 * fq; const u32x2 gw = *(const u32x2*)(GATE + tok * 1024 + v0); const f32x4 ng = *(const f32x4*)(norm_g + v0);
            u32x2 w; w.x = cvt_pk_bf16(o[n][0] * rstd * ng[0] * bf_lo(gw.x), o[n][1] * rstd * ng[1] * bf_hi(gw.x)); w.y = cvt_pk_bf16(o[n][2] * rstd * ng[2] * bf_lo(gw.y), o[n][3] * rstd * ng[3] * bf_hi(gw.y));
            *(u32x2*)(OG + tok * 1024 + v0) = w; }
    }
    __syncthreads();
}

constexpr int KS_STRIDE = 272, VS_STRIDE = 528, KS_BYTES = 256 * KS_STRIDE, VS_BYTES = 128 * VS_STRIDE, PRE_OFF = KS_BYTES + VS_BYTES;
constexpr float ATT_SC2 = 0.08838834764831845f * 1.4426950408889634f;
__device__ __forceinline__ int list_off(int n) { return 256 * (63 * n - (n * (n - 1)) / 2); }
__device__ __forceinline__ void mb_stage(const bf16* K, const bf16* VT, int h, int n, LAS unsigned char* lds, int tid) {
#pragma unroll
    for (int i = 0; i < 8; ++i) { const int row = (tid >> 4) + 32 * i, ch = tid & 15; *(LAS u32x4*)(lds + row * KS_STRIDE + ch * 16) = *(const u32x4*)(K + (size_t)(256 * n + row) * 1024 + h * 128 + 8 * ch); }
#pragma unroll
    for (int i = 0; i < 8; ++i) { const int row = (tid >> 5) + 16 * i, ch = tid & 31; *(LAS u32x4*)(lds + KS_BYTES + row * VS_STRIDE + ch * 16) = *(const u32x4*)(VT + (size_t)(h * 128 + row) * M + 256 * n + 8 * ch); }
}
__device__ __forceinline__ void attn_group(LAS const unsigned char* lds, const bf16* qrow, bool valid, float ref2, int nkt, bool causal, int qpos, int fr, int fq, f32x4 (&o)[8], float& l) {
    bf16x8 qf[4];
#pragma unroll
    for (int ks = 0; ks < 4; ++ks) qf[ks] = valid ? *(const bf16x8*)(qrow + 32 * ks + 8 * fq) : (bf16x8){0, 0, 0, 0, 0, 0, 0, 0};
    unsigned pk[16][2]; float lsum = 0.f;
#pragma unroll
    for (int kt = 0; kt < 16; ++kt) {
        if (kt < nkt) { f32x4 s = {0.f, 0.f, 0.f, 0.f};
#pragma unroll
            for (int ks = 0; ks < 4; ++ks) { const bf16x8 kf = *(const LAS bf16x8*)(lds + (16 * kt + fr) * KS_STRIDE + (32 * ks + 8 * fq) * 2); s = MFMA16(kf, qf[ks], s); }
            float pv[4];
#pragma unroll
            for (int j = 0; j < 4; ++j) { pv[j] = __builtin_amdgcn_exp2f(s[j] * ATT_SC2 - ref2); if (causal && (16 * kt + 4 * fq + j > qpos)) pv[j] = 0.f; lsum += pv[j]; }
            pk[kt][0] = cvt_pk_bf16(pv[0], pv[1]); pk[kt][1] = cvt_pk_bf16(pv[2], pv[3]);
        } else { pk[kt][0] = 0u; pk[kt][1] = 0u; } }
#pragma unroll
    for (int dt = 0; dt < 8; ++dt) o[dt] = (f32x4){0.f, 0.f, 0.f, 0.f};
#pragma unroll
    for (int kk = 0; kk < 8; ++kk) if (2 * kk < nkt) {
        u32x4 pw; pw.x = pk[2 * kk][0]; pw.y = pk[2 * kk][1]; pw.z = pk[2 * kk + 1][0]; pw.w = pk[2 * kk + 1][1]; const bf16x8 pf = __builtin_bit_cast(bf16x8, pw);
#pragma unroll
        for (int dt = 0; dt < 8; ++dt) { LAS const unsigned char* vp = lds + KS_BYTES + (16 * dt + fr) * VS_STRIDE + (32 * kk + 4 * fq) * 2;
            const u32x2 lo = *(const LAS u32x2*)vp, hi = *(const LAS u32x2*)(vp + 32); u32x4 vw; vw.x = lo.x; vw.y = lo.y; vw.z = hi.x; vw.w = hi.y;
            o[dt] = MFMA16(__builtin_bit_cast(bf16x8, vw), pf, o[dt]); } }
    lsum += __shfl_xor(lsum, 16); lsum += __shfl_xor(lsum, 32); l = lsum;
}
__device__ __forceinline__ void mb_kmean(const Params& p, unsigned char* ws, LAS unsigned char* lds, int tid, int wave, int lane) {
    const bf16* K = (const bf16*)(ws + WS_K); float* KMEAN = (float*)(ws + WS_KMEAN); float* KNMAX = (float*)(ws + WS_KNMAX);
    LAS float* part = (LAS float*)lds; LAS float* mx = part + 8 * 128;
    for (int unit = blockIdx.x; unit < 512; unit += gridDim.x) { const int h = unit >> 6, n = unit & 63;
        float s0 = 0.f, s1 = 0.f, rm = 0.f;
        for (int r = wave; r < 256; r += 8) { const unsigned w = *(const unsigned*)(K + (size_t)(256 * n + r) * 1024 + h * 128 + 2 * lane); const float x0 = bf_lo(w), x1 = bf_hi(w);
            s0 += x0; s1 += x1; rm = fmaxf(rm, wave_sum(x0 * x0 + x1 * x1)); }
        part[wave * 128 + 2 * lane] = s0; part[wave * 128 + 2 * lane + 1] = s1; if (lane == 0) mx[wave] = rm;
        __syncthreads();
        if (tid < 128) { float s = 0.f;
#pragma unroll
            for (int w = 0; w < 8; ++w) s += part[w * 128 + tid];
            KMEAN[(size_t)unit * 128 + tid] = s * (1.0f / 256.0f); }
        if (tid == 0) { float m = 0.f;
#pragma unroll
            for (int w = 0; w < 8; ++w) m = fmaxf(m, mx[w]);
            KNMAX[unit] = m; }
        __syncthreads(); }
}
__device__ __forceinline__ void mb_gate(const Params& p, unsigned char* ws, LAS unsigned char* lds, int tid) {
    const bf16* Q = (const bf16*)(ws + WS_Q); const float* KMEAN = (const float*)(ws + WS_KMEAN); const float* KNMAX = (const float*)(ws + WS_KNMAX);
    int* CNT = (int*)(ws + WS_CNT); unsigned short* LIST = (unsigned short*)(ws + WS_LIST); float* QREF = (float*)(ws + WS_QREF);
    LAS float* km = (LAS float*)lds; LAS float* kn = km + 64 * 128;
    for (int item = blockIdx.x; item < 256; item += gridDim.x) { const int h = item >> 5, s = (item & 31) * 512 + tid, blk = s >> 8;
        __syncthreads();
        for (int i = tid; i < 64 * 128 / 4; i += 512) ((LAS f32x4*)km)[i] = ((const f32x4*)(KMEAN + (size_t)h * 64 * 128))[i];
        if (tid < 64) kn[tid] = KNMAX[h * 64 + tid];
        __syncthreads();
        unsigned qp[64]; float qq = 0.f;
#pragma unroll
        for (int ch = 0; ch < 16; ++ch) { const u32x4 w = *(const u32x4*)(Q + (size_t)s * 1024 + h * 128 + 8 * ch); qp[4 * ch] = w.x; qp[4 * ch + 1] = w.y; qp[4 * ch + 2] = w.z; qp[4 * ch + 3] = w.w; }
#pragma unroll
        for (int i = 0; i < 64; ++i) { const float x0 = bf_lo(qp[i]), x1 = bf_hi(qp[i]); qq += x0 * x0 + x1 * x1; }
        float kmax = 0.f;
#pragma unroll 8
        for (int n = 0; n < 64; ++n) kmax = fmaxf(kmax, kn[n]);
        QREF[(size_t)s * 8 + h] = sqrtf(qq) * sqrtf(kmax) * ATT_SC2;
        float b0 = -3.0e38f, b1 = -3.0e38f, b2 = -3.0e38f; int i0 = 0, i1 = 0, i2 = 0;
#pragma unroll 1
        for (int n = 0; n < blk; ++n) { float d0 = 0.f, d1 = 0.f, d2 = 0.f, d3 = 0.f;
#pragma unroll
            for (int c8 = 0; c8 < 4; ++c8) {
#pragma unroll
                for (int c4 = 8 * c8; c4 < 8 * c8 + 8; ++c4) { const f32x4 k4 = *(const LAS f32x4*)(km + n * 128 + 4 * c4);
                    d0 += bf_lo(qp[2 * c4]) * k4[0]; d1 += bf_hi(qp[2 * c4]) * k4[1]; d2 += bf_lo(qp[2 * c4 + 1]) * k4[2]; d3 += bf_hi(qp[2 * c4 + 1]) * k4[3]; }
                asm volatile("" ::: "memory"); }
            const float v = (d0 + d1) + (d2 + d3);
            if (v > b0) { b2 = b1; i2 = i1; b1 = b0; i1 = i0; b0 = v; i0 = n; } else if (v > b1) { b2 = b1; i2 = i1; b1 = v; i1 = n; } else if (v > b2) { b2 = v; i2 = n; } }
#pragma unroll
        for (int r = 0; r < 3; ++r) { if (r < blk) { const int bi = r == 0 ? i0 : (r == 1 ? i1 : i2);
                const int pos = atomicAdd(&CNT[h * 64 + bi], 1);
                LIST[(size_t)h * LIST_PER_HEAD + list_off(bi) + pos] = (unsigned short)(s | (r << 14)); } }
    }
    __syncthreads();
}
__device__ __forceinline__ void mb_sel(const Params& p, unsigned char* ws, LAS unsigned char* lds, int tid, int wave, int lane) {
    const bf16* Q = (const bf16*)(ws + WS_Q); const bf16* K = (const bf16*)(ws + WS_K); const bf16* VT = (const bf16*)(ws + WS_VT);
    const int* CNT = (const int*)(ws + WS_CNT); const unsigned short* LIST = (const unsigned short*)(ws + WS_LIST); const float* QREF = (const float*)(ws + WS_QREF);
    bf16* PART = (bf16*)(ws + WS_PART); float* LPART = (float*)(ws + WS_LPART);
    LAS int* pre = (LAS int*)(lds + PRE_OFF); LAS int* wtot = pre + 520;
    const int fr = lane & 15, fq = lane >> 4;
    { const int tl = (CNT[tid] + 127) >> 7; int x = tl;
#pragma unroll
        for (int o = 1; o < 64; o <<= 1) { const int y = __shfl_up(x, o); if (lane >= o) x += y; }
        if (lane == 63) wtot[wave] = x;
        __syncthreads();
        int add = 0;
#pragma unroll
        for (int w = 0; w < 8; ++w) if (w < wave) add += wtot[w];
        pre[tid + 1] = x + add; if (tid == 0) pre[0] = 0;
        __syncthreads(); }
    const int T = pre[512];
    const int lo = (int)(((long)T * blockIdx.x) / gridDim.x), hi = (int)(((long)T * (blockIdx.x + 1)) / gridDim.x);
    int cur = -1;
    for (int it = lo; it < hi; ++it) {
        int a = 0, b = 511;
        while (a < b) { const int mid = (a + b + 1) >> 1; if (pre[mid] <= it) a = mid; else b = mid - 1; }
        const int hn = a, h = hn >> 6, n = hn & 63, tile = it - pre[hn];
        if (hn != cur) { __syncthreads(); mb_stage(K, VT, h, n, lds, tid); __syncthreads(); cur = hn; }
        const int cnt = CNT[hn], e0 = (tile * 8 + wave) * 16;
        if (e0 < cnt) { const int idx = e0 + fr; const bool valid = idx < cnt;
            const unsigned ent = valid ? LIST[(size_t)h * LIST_PER_HEAD + list_off(n) + idx] : 0u; const int s = ent & 0x3fff, slot = ent >> 14;
            f32x4 o[8]; float l;
            attn_group(lds, Q + (size_t)s * 1024 + h * 128, valid, QREF[(size_t)s * 8 + h], 16, false, 0, fr, fq, o, l);
            if (valid) { bf16* pp = PART + ((size_t)slot * M + s) * 1024 + h * 128 + 4 * fq;
#pragma unroll
                for (int dt = 0; dt < 8; ++dt) { u32x2 w; w.x = cvt_pk_bf16(o[dt][0], o[dt][1]); w.y = cvt_pk_bf16(o[dt][2], o[dt][3]); *(u32x2*)(pp + 16 * dt) = w; }
                if (fq == 0) LPART[((size_t)slot * M + s) * 8 + h] = l; } }
    }
    __syncthreads();
}
__device__ __forceinline__ void mb_own(const Params& p, unsigned char* ws, LAS unsigned char* lds, int tid, int wave, int lane) {
    const bf16* Q = (const bf16*)(ws + WS_Q); const bf16* K = (const bf16*)(ws + WS_K); const bf16* VT = (const bf16*)(ws + WS_VT);
    const float* QREF = (const float*)(ws + WS_QREF); const bf16* PART = (const bf16*)(ws + WS_PART); const float* LPART = (const float*)(ws + WS_LPART); bf16* OG = (bf16*)(ws + WS_Q);
    const int fr = lane & 15, fq = lane >> 4;
    for (int unit = blockIdx.x; unit < 512; unit += gridDim.x) { const int h = unit >> 6, b = unit & 63;
        __syncthreads(); mb_stage(K, VT, h, b, lds, tid); __syncthreads();
        const int nsl = b < 3 ? b : 3;
#pragma unroll 1
        for (int gi = 0; gi < 2; ++gi) { const int g = gi ? 15 - wave : wave, s = 256 * b + 16 * g + fr;
            f32x4 o[8]; float l;
            attn_group(lds, Q + (size_t)s * 1024 + h * 128, true, QREF[(size_t)s * 8 + h], g + 1, true, 16 * g + fr, fr, fq, o, l);
            for (int j = 0; j < nsl; ++j) { const bf16* pp = PART + ((size_t)j * M + s) * 1024 + h * 128 + 4 * fq; l += LPART[((size_t)j * M + s) * 8 + h];
#pragma unroll
                for (int dt = 0; dt < 8; ++dt) { const u32x2 w = *(const u32x2*)(pp + 16 * dt); o[dt][0] += bf_lo(w.x); o[dt][1] += bf_hi(w.x); o[dt][2] += bf_lo(w.y); o[dt][3] += bf_hi(w.y); } }
            const float inv = 1.0f / l; bf16* op = OG + (size_t)s * 1024 + h * 128 + 4 * fq;
#pragma unroll
            for (int dt = 0; dt < 8; ++dt) { u32x2 w; w.x = cvt_pk_bf16(o[dt][0] * inv, o[dt][1] * inv); w.y = cvt_pk_bf16(o[dt][2] * inv, o[dt][3] * inv); *(u32x2*)(op + 16 * dt) = w; } }
    }
    __syncthreads();
}
__device__ __forceinline__ void sc_conv(const Params& p, unsigned char* ws, int L, int tid) {
    const bf16* PROJ = (const bf16*)(ws + WS_PROJ); bf16* OG = (bf16*)(ws + WS_OGSC); const float* cw = p.in[base_of(L) + 1];
    for (int idx = blockIdx.x * 512 + tid; idx < M * 128; idx += gridDim.x * 512) { const int t = idx >> 7, c = (idx & 127) * 8;
        float accv[8];
#pragma unroll
        for (int j = 0; j < 8; ++j) accv[j] = 0.f;
#pragma unroll
        for (int k = 0; k < 3; ++k) { const int tt = t - 2 + k; if (tt >= 0) { float cgv[8], hv[8]; unpack8(*(const bf16x8*)(PROJ + (size_t)tt * 3072 + 1024 + c), cgv); unpack8(*(const bf16x8*)(PROJ + (size_t)tt * 3072 + 2048 + c), hv);
                const f32x4 w0 = *(const f32x4*)(cw + k * 1024 + c), w1 = *(const f32x4*)(cw + k * 1024 + c + 4);
#pragma unroll
                for (int j = 0; j < 4; ++j) { accv[j] += w0[j] * cgv[j] * hv[j]; accv[4 + j] += w1[j] * cgv[4 + j] * hv[4 + j]; } } }
        float bg[8]; unpack8(*(const bf16x8*)(PROJ + (size_t)t * 3072 + c), bg);
#pragma unroll
        for (int j = 0; j < 8; ++j) accv[j] *= bg[j];
        *(bf16x8*)(OG + (size_t)t * 1024 + c) = pack8(accv); }
}

__global__ void __launch_bounds__(512, 2) mk_fwd(Params p) {
    extern __shared__ __attribute__((aligned(16))) unsigned char lds_raw[];
    LAS unsigned char* lds = (LAS unsigned char*)lds_raw;
    const int G = gridDim.x;
#define FRESH() unsigned char* ws = p.ws; float* Y = p.out; int zero = 0; int tid = threadIdx.x; asm volatile("" : "+s"(ws), "+s"(Y), "+s"(zero), "+v"(tid)); \
        const int lane = tid & 63, wave = __builtin_amdgcn_readfirstlane(tid >> 6), gw = blockIdx.x * 8 + wave, NGW = G * 8; bf16* XB = (bf16*)(ws + WS_XB); (void)lane; (void)gw; (void)NGW; (void)XB; (void)Y; (void)zero;
    for (int pi = p.lo; pi < p.hi; ++pi) {
        const int op = p.prog[pi] & 31, L = p.prog[pi] >> 5;
        if (op == OP_PRO) { FRESH();
            const float* x = p.in[zero];
            for (size_t i = (size_t)blockIdx.x * 512 + tid; i < (size_t)M * D / 8; i += (size_t)G * 512) { const f32x4 a = ((const f32x4*)x)[2 * i], b = ((const f32x4*)x)[2 * i + 1];
                u32x4 w; w.x = cvt_pk_bf16(a.x, a.y); w.y = cvt_pk_bf16(a.z, a.w); w.z = cvt_pk_bf16(b.x, b.y); w.w = cvt_pk_bf16(b.z, b.w); ((u32x4*)XB)[i] = w; }
            if (blockIdx.x == 0 && tid == 0) *(unsigned*)(ws + 3 * 1024) = 0u;
            if (blockIdx.x == 0) { const float* lbp = p.in[2 + zero]; float* LB = (float*)(ws + WS_LBTAB);
                for (int c = tid; c < 1024; c += 512) { const float a0 = lbp[c], a1 = lbp[1024 + c], a2 = lbp[2048 + c], a3 = lbp[3072 + c]; const float mx = fmaxf(fmaxf(a0, a1), fmaxf(a2, a3));
                    const float e0 = __expf(a0 - mx), e1 = __expf(a1 - mx), e2 = __expf(a2 - mx), e3 = __expf(a3 - mx); const float inv = 1.0f / (e0 + e1 + e2 + e3);
                    LB[c] = 0.f; LB[1024 + c] = (e1 + e2 + e3) * inv; } }
            convert_weights(p, ws, 0, lds, gw, NGW, wave, lane);
        } else if (op == OP_HG_IN || op == OP_MB_IN || op == OP_SC_IN || op == OP_OUT || op == OP_UP || op == OP_DOWN) {
            FRESH(); const int nsub = (op == OP_HG_IN || op == OP_MB_IN) ? 2 : 1;
            if (op == OP_MB_IN && blockIdx.x == 0) ((int*)(ws + WS_CNT))[tid] = 0;
            for (int sub = 0; sub < nsub; ++sub) {
                pg8::Gemm g; pg8::Epi E; int nM, nN; g.M = M; g.amode = 0; E.aux = nullptr; E.pos = nullptr; E.O1 = nullptr; E.ldc = 1024;
                bf16* WIN = (bf16*)(ws + WS_WIN);
                if (op == OP_HG_IN) {
                    if (sub == 0) { g.A = XB; g.Bt = WIN; g.N = 2048; g.K = 1024; nM = 64; nN = 8; E.mode = pg8::EPI_SILU_SPLIT; E.O0 = ws + WS_Q; E.O1 = ws + WS_GATE; }
                    else { g.A = WIN + (size_t)2048 * 1024; g.Bt = XB; g.N = M; g.K = 1024; nM = 8; nN = 64; E.mode = pg8::EPI_T_HGRN; E.O0 = ws + WS_GT; E.O1 = ws + WS_VT; E.aux = (const float*)(ws + WS_LBTAB) + (L == 0 ? 0 : 1024); }
                } else if (op == OP_MB_IN) {
                    if (sub == 0) { g.A = XB; g.Bt = WIN; g.N = 2048; g.K = 1024; nM = 64; nN = 8; E.mode = pg8::EPI_ROPE_SPLIT; E.O0 = ws + WS_Q; E.O1 = ws + WS_K; E.pos = (const int*)p.in[1 + zero]; }
                    else { g.A = WIN + (size_t)2048 * 1024; g.Bt = XB; g.N = M; g.K = 1024; nM = 4; nN = 64; E.mode = pg8::EPI_T_PLAIN; E.O0 = ws + WS_VT; }
                } else if (op == OP_SC_IN) { g.A = XB; g.Bt = WIN; g.N = 3072; g.K = 1024; nM = 64; nN = 12; E.mode = pg8::EPI_PLAIN; E.O0 = ws + WS_PROJ; E.ldc = 3072;
                } else if (op == OP_OUT) { g.A = (const bf16*)(ws + (kind_of(L) == 2 ? WS_OGSC : WS_Q)); g.Bt = (const bf16*)(ws + WS_WOUT); g.N = 1024; g.K = 1024; nM = 64; nN = 4; E.mode = pg8::EPI_RES; E.O0 = Y; E.O1 = XB;
                } else if (op == OP_UP) { g.A = XB - (size_t)2 * 1024; g.Bt = (const bf16*)(ws + WS_WUP); g.N = NFF; g.K = 1024; g.amode = 1; nM = 67; nN = 22; E.mode = pg8::EPI_UPCONV; E.O0 = ws + WS_H; E.aux = p.in[wout_of(L) + 4];
                } else { g.A = (const bf16*)(ws + WS_H); g.Bt = (const bf16*)(ws + WS_WDN); g.N = 1024; g.K = DFF; nM = 64; nN = 4; E.mode = pg8::EPI_RES; E.O0 = Y; E.O1 = XB; }
                pg8::StaticOrder S; S.init(nM, nN, G, (int)blockIdx.x);
                pg8::gemm_phase<pg8::Epi, pg8::StaticOrder, true, true>(lds, g, S, E);
            }
        } else if (op == OP_HG_R1) { FRESH(); hg_r1(p, ws, wave, lane);
        } else if (op == OP_HG_R2) { FRESH(); hg_r2(p, ws, tid);
        } else if (op == OP_HG_R3) { FRESH(); hg_r3(p, ws, L, lds, tid, wave, lane);
        } else if (op == OP_MB_KMEAN) { FRESH(); mb_kmean(p, ws, lds, tid, wave, lane);
        } else if (op == OP_MB_GATE) { FRESH(); mb_gate(p, ws, lds, tid);
        } else if (op == OP_MB_SEL) { FRESH(); mb_sel(p, ws, lds, tid, wave, lane);
        } else if (op == OP_MB_OWN) { FRESH(); mb_own(p, ws, lds, tid, wave, lane);
        } else if (op == OP_SC_CONV) { FRESH(); sc_conv(p, ws, L, tid);
        } else if (op == OP_LN1 || op == OP_LN2) { FRESH();
            const int wo = wout_of(L); const float* gg = p.in[wo + (op == OP_LN1 ? 1 : 6)]; const float* bb = p.in[wo + (op == OP_LN1 ? 2 : 7)];
            const bool fin = (op == OP_LN2 && L == 3);
            for (int r = gw; r < M; r += NGW) ln_row(Y + (size_t)r * D, gg, bb, fin ? nullptr : XB + (size_t)r * D, fin ? Y + (size_t)r * D : nullptr, lane);
            if (op == OP_LN2 && L < 3) convert_weights(p, ws, L + 1, lds, gw, NGW, wave, lane);
        }
        else if (op == OP_CONVW) { FRESH(); convert_weights(p, ws, L, lds, gw, NGW, wave, lane); }
        else if (op == OP_DIAG1) { FRESH(); const unsigned short* R = (const unsigned short*)(ws + DIAG_OFF); unsigned bad = 0;
            for (size_t i = (size_t)blockIdx.x * 512 + tid; i < (size_t)DIAG_ELEMS; i += (size_t)G * 512) { const unsigned short v = R[i]; if ((v & 0x7f80u) == 0x7f80u) bad = 1; }
            if (bad) atomicOr((unsigned*)(ws + 3 * 1024), 1u); }
        else if (op == OP_DIAG2) { FRESH(); const float A = (*(const unsigned*)(ws + 3 * 1024)) ? 3.0f : 0.0f; for (size_t i = (size_t)blockIdx.x * 512 + tid; i < (size_t)M * D; i += (size_t)G * 512) Y[i] = A; }
        else if (op == OP_DUMP) { FRESH(); for (size_t i = (size_t)blockIdx.x * 512 + tid; i < (size_t)M * D; i += (size_t)G * 512) Y[i] = bf2f(XB[i]); }
        if (pi + 1 < p.hi) { cg::this_grid().sync(); }
    }
}

extern "C" void kernel_launch(void* const* d_in, const int* in_sizes, int n_in, void* d_out, int out_size, void* d_ws, size_t ws_size, hipStream_t stream) {
    static int grid = 0;
    if (grid == 0) {
        if (n_in != 42 || out_size != M * D || ws_size < WS_NEED) { fprintf(stderr, "kernel_launch: unexpected shapes (n_in %d out %d ws %zu need %zu)\n", n_in, out_size, ws_size, (size_t)WS_NEED); grid = -1; return; }
        int dev = 0, cus = 0, per_cu = 0;
        hipGetDevice(&dev); hipDeviceGetAttribute(&cus, hipDeviceAttributeMultiprocessorCount, dev);
        hipFuncSetAttribute((const void*)mk_fwd, hipFuncAttributeMaxDynamicSharedMemorySize, LDS_BYTES);
        hipOccupancyMaxActiveBlocksPerMultiprocessor(&per_cu, (const void*)mk_fwd, 512, LDS_BYTES);
        (void)hipGetLastError();
        if (per_cu < 1) per_cu = 1;
        grid = cus * 1;
        if (grid > 256) grid = 256;
    }
    if (grid < 0) return;
    Params p{};
    for (int i = 0; i < 42; ++i) p.in[i] = (const float*)d_in[i];
    p.out = (float*)d_out; p.ws = (unsigned char*)d_ws;
    int n = 0;
    p.prog[n++] = OP_PRO;
#ifndef DBG_MIX
#define DBG_MIX 15
#endif
#ifndef DBG_FFN
#define DBG_FFN 15
#endif
    bool have_w = true, out_done = false;
    for (int L = 0; L < 4; ++L) { const int k = L % 3; const unsigned char lb = (unsigned char)(L << 5);
        const bool mix = (DBG_MIX >> L) & 1, ffn = (DBG_FFN >> L) & 1;
        if (!have_w && (mix || ffn)) { p.prog[n++] = lb | OP_CONVW; have_w = true; }
        if (mix) {
            if (k == 0) { p.prog[n++] = lb | OP_HG_IN;
#ifndef DBG_SKIPR
#define DBG_SKIPR 0
#endif
                if (!(DBG_SKIPR & 1)) p.prog[n++] = lb | OP_HG_R1;
#ifdef DBG_DIAG_AFTER_R1
                p.prog[n++] = OP_DIAG1; p.prog[n++] = OP_DIAG2; goto prog_done;
#endif
 if (!(DBG_SKIPR & 2)) p.prog[n++] = lb | OP_HG_R2; if (!(DBG_SKIPR & 4)) p.prog[n++] = lb | OP_HG_R3; }
            else if (k == 1) { p.prog[n++] = lb | OP_MB_IN; p.prog[n++] = lb | OP_MB_KMEAN; p.prog[n++] = lb | OP_MB_GATE; p.prog[n++] = lb | OP_MB_SEL; p.prog[n++] = lb | OP_MB_OWN; }
            else { p.prog[n++] = lb | OP_SC_IN; p.prog[n++] = lb | OP_SC_CONV; }
            p.prog[n++] = lb | OP_OUT; p.prog[n++] = lb | OP_LN1; }
        if (ffn) { p.prog[n++] = lb | OP_UP; p.prog[n++] = lb | OP_DOWN; p.prog[n++] = lb | OP_LN2; out_done = (L == 3); }
        else have_w = false; }
    if (!out_done) p.prog[n++] = OP_DUMP;
prog_done:
    p.nprog = n;
#if ONE_LAUNCH
    p.lo = 0; p.hi = n;
    void* args[] = {&p};
    hipError_t e = hipLaunchCooperativeKernel((const void*)mk_fwd, dim3(grid), dim3(512), args, LDS_BYTES, stream);
    if (e != hipSuccess) fprintf(stderr, "cooperative launch failed: %s (grid %d)\n", hipGetErrorString(e), grid);
#else
    for (int i = 0; i < n; ++i) { p.lo = i; p.hi = i + 1; hipLaunchKernelGGL(mk_fwd, dim3(grid), dim3(512), LDS_BYTES, stream, p); }
#endif
}
```

```cpp
#include <hip/hip_runtime.h>
#include <hip/hip_cooperative_groups.h>
#include <cstdio>
#include <cstdint>
namespace cg = cooperative_groups;

#ifndef ONE_LAUNCH
#define ONE_LAUNCH 1
#endif
#define DBG_SKIPR 0
#define R1_VAR 0
#ifndef DUP_SYNC
#define DUP_SYNC 0
#endif
#ifndef DUP_GEMM
#define DUP_GEMM 0
#endif

namespace pg8 {
#define PG8_LAS __attribute__((address_space(3)))
typedef unsigned short bf16_t;
typedef short bf16x8 __attribute__((ext_vector_type(8)));
typedef float f32x4 __attribute__((ext_vector_type(4)));
typedef unsigned u32x4 __attribute__((ext_vector_type(4)));
constexpr int BM = 256, BK = 64, HALF = 128, HTB = HALF * BK * 2  , STAGE_BYTES = 8 * HTB, NXCD = 8, WGM = 8;

__host__ __device__ __forceinline__ int lds_byte(int r, int c) { const int st = (r >> 4) * 2 + (c >> 5), rr = r & 15, cc = c & 31, ob = rr * 64 + cc * 2; return st * 1024 + (ob ^ (((ob >> 9) & 1) << 5)); }
__host__ __device__ __forceinline__ void stage_rc(int b, int& R, int& C) { const int st = b / 1024, sb = b % 1024, swz = sb ^ (((sb >> 9) & 1) << 5); R = (st >> 1) * 16 + swz / 64; C = (st & 1) * 32 + (swz % 64) / 2; }
__host__ __device__ __forceinline__ int perm32(int rho) { const int n = rho >> 4, i = rho & 15; return 8 * (i >> 2) + 4 * n + (i & 3); }

struct Unit { int pm, pn; };
struct Gemm { const bf16_t* A; const bf16_t* Bt; int M, N, K, amode; };

typedef float f32x2_t __attribute__((ext_vector_type(2))); typedef __bf16 bf16x2_t __attribute__((ext_vector_type(2)));
__device__ __forceinline__ unsigned cvt_pk_bf16(float lo, float hi) { f32x2_t v = {lo, hi}; bf16x2_t b = __builtin_convertvector(v, bf16x2_t); return __builtin_bit_cast(unsigned, b); }

struct StaticOrder {
    int nM, nN, nwg, G, c;
    __host__ __device__ void init(int nM_, int nN_, int G_, int c_) { nM = nM_; nN = nN_; nwg = nM * nN; G = G_; c = c_; }
    __host__ __device__ bool next(int i, Unit& u) const {
        const long L = (long)i * G + c; if (L >= nwg) return false;
        int wgid = (int)L; { const int q = nwg / NXCD, r = nwg % NXCD, xcd = wgid % NXCD, off = wgid / NXCD; wgid = (xcd < r ? xcd * (q + 1) : r * (q + 1) + (xcd - r) * q) + off; }
        const int nig = WGM * nN, gid = wgid / nig, fm = gid * WGM, gsz = (nM - fm) < WGM ? (nM - fm) : WGM;
        u.pm = fm + ((wgid % nig) % gsz); u.pn = (wgid % nig) / gsz; return true;
    }
    __device__ __forceinline__ void a_ready(const Unit&) const {}
    __device__ __forceinline__ void done(const Unit&) const {}
};

typedef unsigned u32x2 __attribute__((ext_vector_type(2)));
typedef _Float16 h16x4 __attribute__((ext_vector_type(4)));
__device__ __forceinline__ float bf_lo(unsigned w) { return __uint_as_float(w << 16); }
__device__ __forceinline__ float bf_hi(unsigned w) { return __uint_as_float(w & 0xffff0000u); }
__device__ __forceinline__ float silu_f(float x) { return x * __builtin_amdgcn_rcpf(1.0f + __builtin_amdgcn_exp2f(-1.4426950408889634f * x)); }
__device__ __forceinline__ float ror1(float x) { return __int_as_float(__builtin_amdgcn_update_dpp(0, __float_as_int(x), 0x121, 0xF, 0xF, false)); }
__device__ __forceinline__ float ror2(float x) { return __int_as_float(__builtin_amdgcn_update_dpp(0, __float_as_int(x), 0x122, 0xF, 0xF, false)); }
__device__ const double ROPE_F[16] = {0.15915494309189535, 0.070086521587798503, 0.03086376340470123, 0.013591370636193905, 0.0059851857127137054, 0.002635675898667414, 0.001160663641240061, 0.00051111750453754386,
    0.00022507907903927653, 9.9117309369019355e-05, 4.3647952792802891e-05, 1.9221100684944863e-05, 8.4643308082414014e-06, 3.7274086019153519e-06, 1.6414262627950345e-06, 7.2282930688328648e-07};
constexpr int TOK = 16384;
constexpr float DN_ALPHA = 1.6817928305074290f;
enum { EPI_SILU_SPLIT = 0, EPI_PLAIN = 1, EPI_ROPE_SPLIT = 2, EPI_T_HGRN = 3, EPI_T_PLAIN = 4, EPI_RES = 5, EPI_UPCONV = 6 };
struct Epi {
    static constexpr bool PERM = false, AFTER_DRAIN = false;
    int mode, ldc; void* O0; void* O1; const float* aux; const int* pos;
    __device__ __forceinline__ void st4(bf16_t* p, f32x4 v) const { u32x2 w; w.x = cvt_pk_bf16(v[0], v[1]); w.y = cvt_pk_bf16(v[2], v[3]); *(u32x2*)p = w; }
    __device__ __forceinline__ void operator()(const f32x4 (&acc)[2][2][4][2], const Unit& u, int wr, int wc, int fr, int fq) const {
        const int row0 = u.pm * BM + wr * 64 + fr, col0 = u.pn * BM + wc * 32 + 4 * fq;
        if (mode == EPI_RES) {
            float* Y = (float*)O0; const bf16_t* XB = (const bf16_t*)O1;
#pragma unroll
            for (int ai = 0; ai < 2; ++ai)
#pragma unroll
                for (int m = 0; m < 4; ++m) { const size_t ro = (size_t)(row0 + ai * HALF + m * 16) * 1024 + col0;
#pragma unroll
                    for (int bj = 0; bj < 2; ++bj)
#pragma unroll
                        for (int n = 0; n < 2; ++n) { const size_t o = ro + bj * HALF + n * 16; const u32x2 xw = *(const u32x2*)(XB + o);
                            f32x4 r; r[0] = DN_ALPHA * bf_lo(xw.x) + acc[ai][bj][m][n][0]; r[1] = DN_ALPHA * bf_hi(xw.x) + acc[ai][bj][m][n][1];
                            r[2] = DN_ALPHA * bf_lo(xw.y) + acc[ai][bj][m][n][2]; r[3] = DN_ALPHA * bf_hi(xw.y) + acc[ai][bj][m][n][3];
                            *(f32x4*)(Y + o) = r; } }
        } else if (mode == EPI_UPCONV) {
            bf16_t* H = (bf16_t*)O0; const float* cw = aux;
            const int cbase = 128 * u.pn + 32 * wc + 4 * fq;
#pragma unroll
            for (int n = 0; n < 2; ++n) {
                const f32x4 wa0 = *(const f32x4*)(cw + cbase + 16 * n), wa1 = *(const f32x4*)(cw + 5632 + cbase + 16 * n), wa2 = *(const f32x4*)(cw + 2 * 5632 + cbase + 16 * n);
                const f32x4 wb0 = *(const f32x4*)(cw + 2816 + cbase + 16 * n), wb1 = *(const f32x4*)(cw + 5632 + 2816 + cbase + 16 * n), wb2 = *(const f32x4*)(cw + 2 * 5632 + 2816 + cbase + 16 * n);
#pragma unroll
                for (int ai = 0; ai < 2; ++ai) { const int tok0 = 248 * u.pm + 62 * (2 * ai + wr) - 2;
                    f32x4 pa1 = {0.f, 0.f, 0.f, 0.f}, pa2 = pa1, pb1 = pa1, pb2 = pa1;
#pragma unroll
                    for (int m = 0; m < 4; ++m) { const int rho = 16 * m + fr, tok = tok0 + rho;
                        const f32x4 za = acc[ai][0][m][n], zb = acc[ai][1][m][n]; f32x4 ra1, ra2, rb1, rb2, hv;
#pragma unroll
                        for (int e = 0; e < 4; ++e) { ra1[e] = ror1(za[e]); ra2[e] = ror2(za[e]); rb1[e] = ror1(zb[e]); rb2[e] = ror2(zb[e]); }
#pragma unroll
                        for (int e = 0; e < 4; ++e) {
                            float a1 = fr == 0 ? pa1[e] : ra1[e], a2 = fr < 2 ? pa2[e] : ra2[e], b1 = fr == 0 ? pb1[e] : rb1[e], b2 = fr < 2 ? pb2[e] : rb2[e];
                            if (tok < 1) { a1 = 0.f; b1 = 0.f; } if (tok < 2) { a2 = 0.f; b2 = 0.f; }
                            const float ua = wa2[e] * za[e] + wa1[e] * a1 + wa0[e] * a2, ub = wb2[e] * zb[e] + wb1[e] * b1 + wb0[e] * b2;
                            hv[e] = silu_f(ua) * ub; }
                        if (rho >= 2 && tok < TOK) st4(H + (size_t)tok * 2816 + cbase + 16 * n, hv);
                        pa1 = ra1; pa2 = ra2; pb1 = rb1; pb2 = rb2; }
                    asm volatile("" ::: "memory"); } }
        } else if (mode == EPI_T_HGRN || mode == EPI_T_PLAIN) {
            const bool isg = (mode == EPI_T_HGRN) && (u.pm < 4);
            bf16_t* base = (mode == EPI_T_HGRN && u.pm >= 4) ? (bf16_t*)O1 - (size_t)1024 * TOK : (bf16_t*)O0;
#pragma unroll
            for (int ai = 0; ai < 2; ++ai)
#pragma unroll
                for (int m = 0; m < 4; ++m) { const int r = row0 + ai * HALF + m * 16; const size_t ro = (size_t)r * TOK + col0; const float lb = isg ? aux[r] : 0.f;
#pragma unroll
                    for (int bj = 0; bj < 2; ++bj)
#pragma unroll
                        for (int n = 0; n < 2; ++n) { const f32x4 v = acc[ai][bj][m][n]; bf16_t* p = base + ro + bj * HALF + n * 16;
                            if (isg) { h16x4 hg;
#pragma unroll
                                for (int e = 0; e < 4; ++e) { const float sg = __builtin_amdgcn_rcpf(1.0f + __expf(-v[e])); hg[e] = (_Float16)__logf(lb + (1.0f - lb) * sg); }
                                *(h16x4*)p = hg; }
                            else st4(p, v); } }
        } else {
            int colt = u.pn * BM; bf16_t* base = (bf16_t*)O0;
            if (mode != EPI_PLAIN) { if (colt >= 1024) { base = (bf16_t*)O1; colt -= 1024; } }
            const int c0 = colt + wc * 32 + 4 * fq;
            double rf[4];
#pragma unroll
            for (int e = 0; e < 4; ++e) rf[e] = ROPE_F[4 * fq + e];
#pragma unroll
            for (int ai = 0; ai < 2; ++ai)
#pragma unroll
                for (int m = 0; m < 4; ++m) { const int r = row0 + ai * HALF + m * 16; bf16_t* rowp = base + (size_t)r * ldc + c0;
                    float cs[4], sn[4];
                    if (mode == EPI_ROPE_SPLIT && wc == 0) { const double pp = (double)pos[r];
#pragma unroll
                        for (int e = 0; e < 4; ++e) { double tt = pp * rf[e]; tt -= __builtin_floor(tt); const float tf = (float)tt; sn[e] = __builtin_amdgcn_sinf(tf); cs[e] = __builtin_amdgcn_cosf(tf); } }
#pragma unroll
                    for (int bj = 0; bj < 2; ++bj) { f32x4 v0 = acc[ai][bj][m][0], v1 = acc[ai][bj][m][1];
                        if (mode == EPI_SILU_SPLIT) {
#pragma unroll
                            for (int e = 0; e < 4; ++e) { v0[e] = silu_f(v0[e]); v1[e] = silu_f(v1[e]); } }
                        if (mode == EPI_ROPE_SPLIT && wc == 0) {
#pragma unroll
                            for (int e = 0; e < 4; ++e) { const float x1 = v0[e], x2 = v1[e]; v0[e] = x1 * cs[e] - x2 * sn[e]; v1[e] = x2 * cs[e] + x1 * sn[e]; } }
                        st4(rowp + bj * HALF, v0); st4(rowp + bj * HALF + 16, v1); } }
        }
    }
};

template <class Epi, class Sched, bool ALIGN_EPI = false, bool SP2 = false>
__device__ __forceinline__ void gemm_phase(PG8_LAS unsigned char* lds, const Gemm g, const Sched& S, const Epi& E) {
    int tid = threadIdx.x; asm volatile("" : "+v"(tid));
    const int wid = __builtin_amdgcn_readfirstlane(tid >> 6), lane = tid & 63, wr = wid >> 2, wc = wid & 3, fr = lane & 15, fq = lane >> 4;
    const int K = g.K, nt = K / BK;
    unsigned voffA[2], voffB[2];
#pragma unroll
    for (int i = 0; i < 2; ++i) { int R, C; stage_rc(tid * 16 + i * 8192, R, C); const int Rb = Epi::PERM ? ((R & ~31) + perm32(R & 31)) : R;
        voffA[i] = (unsigned)((g.amode ? (R - 2 * (R >> 6)) : R) * K + C) * 2u; voffB[i] = (unsigned)(Rb * K + C) * 2u; }
    const size_t kstep = (size_t)(BK * 2);
    const size_t hstep = (size_t)HALF * K * 2;
    const size_t tstep = 2 * hstep;  const size_t hstepA = g.amode ? (size_t)124 * K * 2 : hstep, tstepA = 2 * hstepA;
    const unsigned ldsw = (unsigned)wid * 1024u;
    const int aoff = lds_byte(wr * 64 + fr, fq * 8), boff = lds_byte(wc * 32 + fr, fq * 8);
#define PG8_SA(b, h) (((b) * 2 + (h)) * HTB)
#define PG8_SB(b, h) ((4 + (b) * 2 + (h)) * HTB)
#define PG8_STAGE(bufoff, gbase, voff) do { _Pragma("unroll") for (int _i = 0; _i < 2; ++_i) \
        __builtin_amdgcn_global_load_lds((const unsigned*)((const char*)(gbase) + (voff)[_i]), (PG8_LAS unsigned*)(lds + (bufoff) + ldsw + _i * 8192), 16, 0, 0); } while (0)
#define PG8_LDA(dst, b, h) do { _Pragma("unroll") for (int m = 0; m < 4; ++m) _Pragma("unroll") for (int k = 0; k < 2; ++k) dst[m][k] = *(const PG8_LAS bf16x8*)(lds + PG8_SA(b, h) + aoff + m * 2048 + k * 1024); } while (0)
#define PG8_LDB(dst, b, h) do { _Pragma("unroll") for (int n = 0; n < 2; ++n) _Pragma("unroll") for (int k = 0; k < 2; ++k) dst[n][k] = *(const PG8_LAS bf16x8*)(lds + PG8_SB(b, h) + boff + n * 2048 + k * 1024); } while (0)
#define PG8_MMA(ai, bj, At, Bt) do { __builtin_amdgcn_s_setprio(1); _Pragma("unroll") for (int m = 0; m < 4; ++m) _Pragma("unroll") for (int n = 0; n < 2; ++n) _Pragma("unroll") for (int k = 0; k < 2; ++k) \
        acc[ai][bj][m][n] = __builtin_amdgcn_mfma_f32_16x16x32_bf16(Bt[n][k], At[m][k], acc[ai][bj][m][n], 0, 0, 0); __builtin_amdgcn_s_setprio(0); } while (0)
#define PG8_WAIT_V(n) asm volatile("s_waitcnt vmcnt(" #n ")" ::: "memory")
#define PG8_WAIT_L(n) asm volatile("s_waitcnt lgkmcnt(" #n ")" ::: "memory")
#define PG8_BAR __builtin_amdgcn_s_barrier()
#define PG8_SCHED __builtin_amdgcn_sched_barrier(0)
    Unit cur, nxt; int ui = 0;
    if (!S.next(0, cur)) return;
    f32x4 acc[2][2][4][2];
#pragma unroll
    for (int a = 0; a < 2; ++a)
#pragma unroll
        for (int b = 0; b < 2; ++b)
#pragma unroll
            for (int m = 0; m < 4; ++m)
#pragma unroll
                for (int n = 0; n < 2; ++n) acc[a][b][m][n] = (f32x4){0.f, 0.f, 0.f, 0.f};
    bf16x8 At[4][2], B0[2][2], B1[2][2];
    const char* cA = (const char*)g.A + (size_t)cur.pm * tstepA; const char* cB = (const char*)g.Bt + (size_t)cur.pn * tstep;
    S.a_ready(cur);
    if constexpr (SP2) {
        PG8_STAGE(PG8_SB(0, 0), cB, voffB); PG8_STAGE(PG8_SB(0, 1), cB + hstep, voffB); PG8_STAGE(PG8_SA(0, 0), cA, voffA); PG8_STAGE(PG8_SA(0, 1), cA + hstepA, voffA);
        if (wr == 1) PG8_BAR;
        PG8_WAIT_V(2); PG8_BAR;
        PG8_STAGE(PG8_SB(1, 0), cB + kstep, voffB); PG8_STAGE(PG8_SA(1, 0), cA + kstep, voffA); PG8_STAGE(PG8_SB(1, 1), cB + hstep + kstep, voffB);
        PG8_WAIT_V(6); PG8_BAR;
    } else {
        PG8_STAGE(PG8_SB(0, 0), cB, voffB); PG8_STAGE(PG8_SA(0, 0), cA, voffA); PG8_STAGE(PG8_SB(0, 1), cB + hstep, voffB); PG8_STAGE(PG8_SA(0, 1), cA + hstepA, voffA);
        if (wr == 1) PG8_BAR;
        PG8_WAIT_V(4); PG8_BAR;
        PG8_STAGE(PG8_SB(1, 0), cB + kstep, voffB); PG8_STAGE(PG8_SA(1, 0), cA + kstep, voffA); PG8_STAGE(PG8_SB(1, 1), cB + hstep + kstep, voffB);
        PG8_WAIT_V(6); PG8_BAR;
    }
    for (;;) {
        const bool has_next = S.next(ui + 1, nxt);
        const char* nA = has_next ? (const char*)g.A + (size_t)nxt.pm * tstepA : cA; const char* nB = has_next ? (const char*)g.Bt + (size_t)nxt.pn * tstep : cB;
        for (int t = 0; t < nt; t += 2) {
            const bool last = (t == nt - 2);
            const char* a1 = cA + (size_t)(t + 1) * kstep;
            const char* a2 = last ? nA : cA + (size_t)(t + 2) * kstep; const char* b2 = last ? nB : cB + (size_t)(t + 2) * kstep;
            const char* a3 = a2 + kstep; const char* b3 = b2 + kstep;
            if (last && has_next) S.a_ready(nxt);
            if constexpr (SP2) {
            PG8_LDB(B0, 0, 0); PG8_LDB(B1, 0, 1); PG8_SCHED; PG8_LDA(At, 0, 0); PG8_STAGE(PG8_SA(1, 1), a1 + hstepA, voffA);
            PG8_WAIT_V(8); PG8_WAIT_L(0); PG8_BAR; PG8_MMA(0, 0, At, B0); PG8_MMA(0, 1, At, B1); PG8_BAR; PG8_SCHED;
            PG8_LDA(At, 0, 1); PG8_STAGE(PG8_SB(0, 0), b2, voffB); PG8_STAGE(PG8_SB(0, 1), b2 + hstep, voffB); PG8_STAGE(PG8_SA(0, 0), a2, voffA);
            PG8_WAIT_V(8); PG8_WAIT_L(0); PG8_BAR; PG8_MMA(1, 0, At, B0); PG8_MMA(1, 1, At, B1); PG8_BAR; PG8_SCHED;
            PG8_LDB(B0, 1, 0); PG8_LDB(B1, 1, 1); PG8_SCHED; PG8_LDA(At, 1, 0); PG8_STAGE(PG8_SA(0, 1), a2 + hstepA, voffA);
            PG8_WAIT_V(8); PG8_WAIT_L(0); PG8_BAR; PG8_MMA(0, 0, At, B0); PG8_MMA(0, 1, At, B1); PG8_BAR; PG8_SCHED;
            PG8_LDA(At, 1, 1); PG8_STAGE(PG8_SB(1, 0), b3, voffB); PG8_STAGE(PG8_SB(1, 1), b3 + hstep, voffB); PG8_STAGE(PG8_SA(1, 0), a3, voffA);
            PG8_WAIT_V(8); PG8_WAIT_L(0); PG8_BAR; PG8_MMA(1, 0, At, B0); PG8_MMA(1, 1, At, B1); PG8_BAR; PG8_SCHED;
            } else {
            PG8_LDB(B0, 0, 0); PG8_SCHED; PG8_LDA(At, 0, 0); PG8_STAGE(PG8_SA(1, 1), a1 + hstepA, voffA);
            PG8_WAIT_L(8); PG8_BAR; PG8_WAIT_L(0); PG8_MMA(0, 0, At, B0); PG8_BAR; PG8_SCHED;
            PG8_LDB(B1, 0, 1); PG8_STAGE(PG8_SB(0, 0), b2, voffB);
            PG8_BAR; PG8_WAIT_L(0); PG8_MMA(0, 1, At, B1); PG8_BAR;
            PG8_LDA(At, 0, 1); PG8_STAGE(PG8_SA(0, 0), a2, voffA);
            PG8_BAR; PG8_WAIT_L(0); PG8_MMA(1, 0, At, B0); PG8_BAR; PG8_SCHED;
            PG8_STAGE(PG8_SB(0, 1), b2 + hstep, voffB);
            PG8_WAIT_V(6); PG8_BAR; PG8_MMA(1, 1, At, B1); PG8_BAR;
            PG8_LDB(B0, 1, 0); PG8_SCHED; PG8_LDA(At, 1, 0); PG8_STAGE(PG8_SA(0, 1), a2 + hstepA, voffA);
            PG8_WAIT_L(8); PG8_BAR; PG8_WAIT_L(0); PG8_MMA(0, 0, At, B0); PG8_BAR; PG8_SCHED;
            PG8_LDB(B1, 1, 1); PG8_STAGE(PG8_SB(1, 0), b3, voffB);
            PG8_BAR; PG8_WAIT_L(0); PG8_MMA(0, 1, At, B1); PG8_BAR;
            PG8_LDA(At, 1, 1); PG8_STAGE(PG8_SA(1, 0), a3, voffA);
            PG8_BAR; PG8_WAIT_L(0); PG8_MMA(1, 0, At, B0); PG8_BAR; PG8_SCHED;
            PG8_STAGE(PG8_SB(1, 1), b3 + hstep, voffB);
            PG8_WAIT_V(6); PG8_BAR; PG8_MMA(1, 1, At, B1); PG8_BAR;
            }
        }
        if constexpr (ALIGN_EPI) { if (wr == 0) PG8_BAR; }
        if constexpr (!Epi::AFTER_DRAIN) { E(acc, cur, wr, wc, fr, fq); S.done(cur); }
        if (!has_next) break;
#pragma unroll
        for (int a = 0; a < 2; ++a)
#pragma unroll
            for (int b = 0; b < 2; ++b)
#pragma unroll
                for (int m = 0; m < 4; ++m)
#pragma unroll
                    for (int n = 0; n < 2; ++n) acc[a][b][m][n] = (f32x4){0.f, 0.f, 0.f, 0.f};
        cur = nxt; cA = nA; cB = nB; ++ui;
        if constexpr (ALIGN_EPI) { if (wr == 1) PG8_BAR; }
    }
    PG8_WAIT_V(0);
    if constexpr (!ALIGN_EPI) { if (wr == 0) PG8_BAR; }
    PG8_BAR;
    if constexpr (Epi::AFTER_DRAIN) { E.fused(acc, cur, wr, wc, fr, fq, lds, wid, lane); S.done(cur); }
#undef PG8_SA
#undef PG8_SB
#undef PG8_STAGE
#undef PG8_LDA
#undef PG8_LDB
#undef PG8_MMA
#undef PG8_WAIT_V
#undef PG8_WAIT_L
#undef PG8_BAR
#undef PG8_SCHED
}
}

#define LAS __attribute__((address_space(3)))
typedef unsigned short bf16;
typedef short bf16x8 __attribute__((ext_vector_type(8)));
typedef float f32x4 __attribute__((ext_vector_type(4)));
typedef unsigned u32x4 __attribute__((ext_vector_type(4)));
typedef unsigned u32x2 __attribute__((ext_vector_type(2)));
typedef _Float16 h16x8 __attribute__((ext_vector_type(8)));
using pg8::bf_lo; using pg8::bf_hi; using pg8::cvt_pk_bf16;

constexpr int M = 16384, D = 1024, DFF = 2816, NFF = 5632;
constexpr float LN_EPS = 1e-5f, RMS_EPS = 1e-6f;
constexpr size_t MiB = 1u << 20;
constexpr size_t WS_CNT = 0, WS_LBTAB = 4096, WS_KNMAX = 16384, WS_KMEAN = 65536, WS_QREF = 512 * 1024, WS_DEC = 1 * MiB, WS_LPART = 2 * MiB;
constexpr size_t WS_WIN = 4 * MiB, WS_WOUT = 12 * MiB, WS_WUP = 14 * MiB, WS_WDN = 25 * MiB;
constexpr size_t WS_XB = 32 * MiB, WS_L = 64 * MiB;
constexpr size_t WS_Q = WS_L, WS_GT = WS_L + 32 * MiB, WS_VT = WS_L + 64 * MiB, WS_GATE = WS_L + 96 * MiB, WS_ST = WS_L + 128 * MiB;
constexpr size_t WS_K = WS_L + 32 * MiB, WS_LIST = WS_L + 96 * MiB, WS_PART = WS_L + 104 * MiB;
constexpr size_t WS_PROJ = WS_L, WS_OGSC = WS_L + 96 * MiB;
constexpr size_t WS_H = WS_L;
constexpr size_t WS_NEED = WS_PART + 96 * MiB;
constexpr int LDS_BYTES = 147456;
constexpr size_t WS_BAR = 32 * 1024, BAR_ZERO_BYTES = 16 * 1024;
constexpr int LDS_BARST = LDS_BYTES - 16;
#ifndef DIAG_OFF
#define DIAG_OFF WS_VT
#define DIAG_ELEMS (16u << 20)
#endif
constexpr int LIST_PER_HEAD = 256 * 2016;

enum { OP_PRO = 0, OP_HG_IN, OP_HG_R1, OP_HG_R2, OP_HG_R3, OP_MB_IN, OP_MB_KMEAN, OP_MB_GATE, OP_MB_SEL, OP_MB_OWN, OP_SC_IN, OP_SC_CONV, OP_OUT, OP_LN1, OP_UP, OP_DOWN, OP_LN2, OP_CONVW, OP_DUMP, OP_DIAG1, OP_DIAG2 };
struct Params { const float* in[42]; float* out; unsigned char* ws; unsigned char prog[64]; int nprog, lo, hi, pad; };

__device__ __forceinline__ unsigned f2bf(float f) { unsigned u = __float_as_uint(f); return (u + 0x7fffu + ((u >> 16) & 1u)) >> 16; }
__device__ __forceinline__ float bf2f(unsigned short b) { return __uint_as_float((unsigned)b << 16); }
__device__ __forceinline__ bf16x8 pack8(const float (&v)[8]) { u32x4 w; w.x = cvt_pk_bf16(v[0], v[1]); w.y = cvt_pk_bf16(v[2], v[3]); w.z = cvt_pk_bf16(v[4], v[5]); w.w = cvt_pk_bf16(v[6], v[7]); return __builtin_bit_cast(bf16x8, w); }
__device__ __forceinline__ void unpack8(bf16x8 x, float (&v)[8]) { const u32x4 w = __builtin_bit_cast(u32x4, x); v[0] = bf_lo(w.x); v[1] = bf_hi(w.x); v[2] = bf_lo(w.y); v[3] = bf_hi(w.y); v[4] = bf_lo(w.z); v[5] = bf_hi(w.z); v[6] = bf_lo(w.w); v[7] = bf_hi(w.w); }
__device__ __forceinline__ float wave_sum(float v) {
#pragma unroll
    for (int o = 1; o < 64; o <<= 1) v += __shfl_xor(v, o);
    return v;
}
#define MFMA16(a, b, c) __builtin_amdgcn_mfma_f32_16x16x32_bf16((a), (b), (c), 0, 0, 0)

__device__ __forceinline__ int kind_of(int L) { return L == 1 ? 1 : (L == 2 ? 2 : 0); }
__device__ __forceinline__ int base_of(int L) { return L == 0 ? 3 : (L == 1 ? 13 : (L == 2 ? 22 : 32)); }
__device__ __forceinline__ int wout_of(int L) { return base_of(L) + (L == 1 ? 1 : 2); }

__device__ __forceinline__ void transpose_item(const float* W, int ldw, int K, int col0, int ncols, bf16* WT, int drow0, int mode, LAS float* scr, int item, int lane) {
    const int nblk = ncols / 32, kb = item / nblk, nb = item % nblk, k0 = 64 * kb, n0 = 32 * nb;
    int dr;
    if (mode == 1) { const int c = n0; dr = c < DFF ? 256 * (c / 128) + (c % 128) : 256 * ((c - DFF) / 128) + 128 + ((c - DFF) % 128); } else dr = drow0 + n0;
#pragma unroll 8
    for (int i = 0; i < 32; ++i) { const int kk = 2 * i + (lane >> 5); scr[kk * 33 + (lane & 31)] = W[(size_t)(k0 + kk) * ldw + col0 + n0 + (lane & 31)]; }
    asm volatile("s_waitcnt lgkmcnt(0)" ::: "memory");
    const int c = lane & 7;
#pragma unroll
    for (int j = 0; j < 4; ++j) { const int n = (lane >> 3) + 8 * j; const LAS float* s = scr + (8 * c) * 33 + n;
        u32x4 o; o.x = cvt_pk_bf16(s[0 * 33], s[1 * 33]); o.y = cvt_pk_bf16(s[2 * 33], s[3 * 33]); o.z = cvt_pk_bf16(s[4 * 33], s[5 * 33]); o.w = cvt_pk_bf16(s[6 * 33], s[7 * 33]);
        *(u32x4*)(WT + (size_t)(dr + n) * K + k0 + 8 * c) = o; }
    asm volatile("s_waitcnt lgkmcnt(0)" ::: "memory");
}
__device__ __forceinline__ void convert_weights(const Params& p, unsigned char* ws, int L, LAS unsigned char* lds, int gw, int NGW, int wave, int lane) {
    LAS float* scr = (LAS float*)(lds + wave * 16384);
    const int kind = kind_of(L), wo = wout_of(L);
    const float* w_in = p.in[base_of(L)]; const float* w_out = p.in[wo]; const float* w_up = p.in[wo + 3]; const float* w_dn = p.in[wo + 5];
    bf16* WIN = (bf16*)(ws + WS_WIN); bf16* WOUT = (bf16*)(ws + WS_WOUT); bf16* WUP = (bf16*)(ws + WS_WUP); bf16* WDN = (bf16*)(ws + WS_WDN);
    const int ldin = kind == 0 ? 4096 : 3072;
    const int n0 = (kind == 0 ? 1024 : 3072), n1 = (kind == 0 ? 1024 : 0), n2 = (kind == 0 ? 2048 : 0);
    const int i0 = 16 * (n0 / 32), i1 = 16 * (n1 / 32), i2 = 16 * (n2 / 32), i3 = 16 * 32, i4 = 16 * (NFF / 32), i5 = (DFF / 64) * 32;
    const int total = i0 + i1 + i2 + i3 + i4 + i5;
    for (int it = gw; it < total; it += NGW) {
        int r = it;
        if (r < i0) { transpose_item(w_in, ldin, 1024, 0, n0, WIN, 0, 0, scr, r, lane); continue; } r -= i0;
        if (r < i1) { transpose_item(w_in, ldin, 1024, 3072, n1, WIN, 1024, 0, scr, r, lane); continue; } r -= i1;
        if (r < i2) { transpose_item(w_in, ldin, 1024, 1024, n2, WIN, 2048, 0, scr, r, lane); continue; } r -= i2;
        if (r < i3) { transpose_item(w_out, 1024, 1024, 0, 1024, WOUT, 0, 0, scr, r, lane); continue; } r -= i3;
        if (r < i4) { transpose_item(w_up, NFF, 1024, 0, NFF, WUP, 0, 1, scr, r, lane); continue; } r -= i4;
        transpose_item(w_dn, 1024, DFF, 0, 1024, WDN, 0, 0, scr, r, lane);
    }
}

__device__ __forceinline__ void ln_row(const float* yrow, const float* g, const float* b, bf16* orow, float* frow, int lane) {
    const f32x4* xr = (const f32x4*)yrow + lane;
    f32x4 v[4]; float s = 0.f;
#pragma unroll
    for (int j = 0; j < 4; ++j) { v[j] = xr[64 * j]; s += (v[j].x + v[j].y) + (v[j].z + v[j].w); }
    const float mean = wave_sum(s) * (1.f / D); float s2 = 0.f;
#pragma unroll
    for (int j = 0; j < 4; ++j) { v[j] = v[j] - mean; s2 += (v[j].x * v[j].x + v[j].y * v[j].y) + (v[j].z * v[j].z + v[j].w * v[j].w); }
    const float rstd = 1.f / sqrtf(wave_sum(s2) * (1.f / D) + LN_EPS);
#pragma unroll
    for (int j = 0; j < 4; ++j) { const f32x4 gg = ((const f32x4*)g)[lane + 64 * j], bb = ((const f32x4*)b)[lane + 64 * j]; const f32x4 o = v[j] * rstd * gg + bb;
        if (orow) { u32x2 w; w.x = cvt_pk_bf16(o.x, o.y); w.y = cvt_pk_bf16(o.z, o.w); ((u32x2*)orow)[lane + 64 * j] = w; }
        if (frow) ((f32x4*)frow)[lane + 64 * j] = o; }
}

__device__ __forceinline__ void hg_prefix(const _Float16* grow, int fr, int fq, float (&g)[2][8], float (&b)[2][8], float& blast) {
    const h16x8 v0 = *(const h16x8*)(grow + 8 * fq), v1 = *(const h16x8*)(grow + 32 + 8 * fq);
    float t0 = 0.f, t1 = 0.f;
#pragma unroll
    for (int j = 0; j < 8; ++j) { g[0][j] = (float)v0[j]; t0 += g[0][j]; b[0][j] = t0; g[1][j] = (float)v1[j]; t1 += g[1][j]; b[1][j] = t1; }
    float off0 = 0.f, off1 = 0.f, sum0 = 0.f, sum1 = 0.f;
#pragma unroll
    for (int q = 0; q < 4; ++q) { const float a0 = __shfl(t0, fr + 16 * q), a1 = __shfl(t1, fr + 16 * q); if (q < fq) { off0 += a0; off1 += a1; } sum0 += a0; sum1 += a1; }
#pragma unroll
    for (int j = 0; j < 8; ++j) { b[0][j] += off0; b[1][j] += sum0 + off1; }
    blast = sum0 + sum1;
}

__device__ __forceinline__ void hg_r1(const Params& p, unsigned char* ws, int wave, int lane) {
    int bid = blockIdx.x, gdim = gridDim.x; asm volatile("" : "+s"(bid), "+s"(gdim));
    const _Float16* GT = (const _Float16*)(ws + WS_GT); const bf16* VT = (const bf16*)(ws + WS_VT); bf16* ST = (bf16*)(ws + WS_ST); float* DEC = (float*)(ws + WS_DEC);
    const int fr = lane & 15, fq = lane >> 4;
    for (int unit = bid; unit < 2048; unit += gdim) {
        const int h = unit >> 8, c = unit & 255, d = 16 * wave + fr;
        float g[2][8], b[2][8], blast;
        hg_prefix(GT + (size_t)(h * 128 + d) * M + c * 64, fr, fq, g, b, blast);
        bf16x8 afr[2];
#pragma unroll
        for (int ks = 0; ks < 2; ++ks) { float kd[8];
#pragma unroll
            for (int j = 0; j < 8; ++j) {
#if R1_VAR == 1
                kd[j] = (1.0f - __expf(g[ks][j]));
#elif R1_VAR == 2
                kd[j] = __expf(blast - b[ks][j]);
#elif R1_VAR == 3
                kd[j] = 1.0f;
#else
                kd[j] = (1.0f - __expf(g[ks][j])) * __expf(blast - b[ks][j]);
#endif
            }
            afr[ks] = pack8(kd); }
        if (fq == 0) DEC[(h * 256 + c) * 128 + d] = __expf(blast);
#pragma unroll
        for (int nt = 0; nt < 8; ++nt) { f32x4 acc = {0.f, 0.f, 0.f, 0.f};
#pragma unroll
            for (int ks = 0; ks < 2; ++ks) { const bf16x8 bfr = *(const bf16x8*)(VT + (size_t)(h * 128 + 16 * nt + fr) * M + c * 64 + 32 * ks + 8 * fq); acc = MFMA16(afr[ks], bfr, acc); }
            u32x2 w; w.x = cvt_pk_bf16(acc[0], acc[1]); w.y = cvt_pk_bf16(acc[2], acc[3]);
            *(u32x2*)(ST + ((size_t)(h * 256 + c) * 128 + 16 * nt + fr) * 128 + 16 * wave + 4 * fq) = w; }
    }
}
__device__ __forceinline__ void hg_r2(const Params& p, unsigned char* ws, int tid) {
    int bid = blockIdx.x, gdim = gridDim.x; asm volatile("" : "+s"(bid), "+s"(gdim));
    bf16* ST = (bf16*)(ws + WS_ST); const float* DEC = (const float*)(ws + WS_DEC);
    for (int e = bid * 512 + tid; e < 131072; e += gdim * 512) {
        const int h = e >> 14, r = e & 16383, d = r & 127;
        bf16* sp = ST + (size_t)h * 256 * 16384 + r; const float* dp = DEC + h * 256 * 128 + d;
        float S = 0.f;
        for (int c = 0; c < 256; c += 8) { unsigned short loc[8]; float dc[8];
#pragma unroll
            for (int i = 0; i < 8; ++i) { loc[i] = sp[(size_t)(c + i) * 16384]; dc[i] = dp[(c + i) * 128]; }
#pragma unroll
            for (int i = 0; i < 8; ++i) { sp[(size_t)(c + i) * 16384] = (bf16)f2bf(S); S = dc[i] * S + bf2f(loc[i]); } }
    }
}
__device__ __forceinline__ void hg_r3(const Params& p, unsigned char* ws, int L, LAS unsigned char* lds, int tid, int wave, int lane) {
    int bid = blockIdx.x, gdim = gridDim.x; asm volatile("" : "+s"(bid), "+s"(gdim));
    const _Float16* GT = (const _Float16*)(ws + WS_GT); const bf16* VT = (const bf16*)(ws + WS_VT); const bf16* ST = (const bf16*)(ws + WS_ST);
    const bf16* Q = (const bf16*)(ws + WS_Q); const bf16* GATE = (const bf16*)(ws + WS_GATE); bf16* OG = (bf16*)(ws + WS_Q);
    const float* norm_g = p.in[base_of(L) + 1];
    LAS float* bt = (LAS float*)lds; LAS float* red = bt + 65 * 132;
    const int fr = lane & 15, fq = lane >> 4;
    if (tid < 132) bt[tid] = 0.f;
    const int mt = wave >> 1, nh = wave & 1;
    for (int unit = bid; unit < 2048; unit += gdim) {
        const int h = unit >> 8, c = unit & 255;
        { const int d = 16 * wave + fr; float g[2][8], b[2][8], blast;
            hg_prefix(GT + (size_t)(h * 128 + d) * M + c * 64, fr, fq, g, b, blast);
#pragma unroll
            for (int ks = 0; ks < 2; ++ks)
#pragma unroll
                for (int j = 0; j < 8; ++j) bt[(32 * ks + 8 * fq + j + 1) * 132 + d] = b[ks][j]; }
        __syncthreads();
        const int t = 16 * mt + fr; const size_t tok = (size_t)c * 64 + t;
        bf16x8 qtil[4], qhat[4]; float Rr[4][8];
#pragma unroll
        for (int ks = 0; ks < 4; ++ks) { float qf[8], bq[8], a[8], a2[8];
            unpack8(*(const bf16x8*)(Q + tok * 1024 + h * 128 + 32 * ks + 8 * fq), qf);
            const f32x4 b0 = *(const LAS f32x4*)(bt + (t + 1) * 132 + 32 * ks + 8 * fq), b1 = *(const LAS f32x4*)(bt + (t + 1) * 132 + 32 * ks + 8 * fq + 4);
            const f32x4 r0 = *(const LAS f32x4*)(bt + (16 * mt) * 132 + 32 * ks + 8 * fq), r1 = *(const LAS f32x4*)(bt + (16 * mt) * 132 + 32 * ks + 8 * fq + 4);
#pragma unroll
            for (int j = 0; j < 4; ++j) { bq[j] = b0[j]; bq[4 + j] = b1[j]; Rr[ks][j] = r0[j]; Rr[ks][4 + j] = r1[j]; }
#pragma unroll
            for (int j = 0; j < 8; ++j) { a[j] = qf[j] * __expf(bq[j]); a2[j] = qf[j] * __expf(bq[j] - Rr[ks][j]); }
            qtil[ks] = pack8(a); qhat[ks] = pack8(a2); }
        f32x4 o[4];
#pragma unroll
        for (int n = 0; n < 4; ++n) { o[n] = (f32x4){0.f, 0.f, 0.f, 0.f};
#pragma unroll
            for (int ks = 0; ks < 4; ++ks) { const bf16x8 sfr = *(const bf16x8*)(ST + ((size_t)(h * 256 + c) * 128 + 16 * (4 * nh + n) + fr) * 128 + 32 * ks + 8 * fq); o[n] = MFMA16(sfr, qtil[ks], o[n]); } }
        unsigned pk[4][2];
#pragma unroll
        for (int i = 0; i < 4; ++i) {
            if (i <= mt) { f32x4 sc = {0.f, 0.f, 0.f, 0.f}; const int s = 16 * i + fr;
#pragma unroll
                for (int ks = 0; ks < 4; ++ks) { float kt[8];
                    const f32x4 b0 = *(const LAS f32x4*)(bt + (s + 1) * 132 + 32 * ks + 8 * fq), b1 = *(const LAS f32x4*)(bt + (s + 1) * 132 + 32 * ks + 8 * fq + 4);
                    const f32x4 m0 = *(const LAS f32x4*)(bt + s * 132 + 32 * ks + 8 * fq), m1 = *(const LAS f32x4*)(bt + s * 132 + 32 * ks + 8 * fq + 4);
#pragma unroll
                    for (int j = 0; j < 4; ++j) { kt[j] = (1.0f - __expf(b0[j] - m0[j])) * __expf(Rr[ks][j] - b0[j]); kt[4 + j] = (1.0f - __expf(b1[j] - m1[j])) * __expf(Rr[ks][4 + j] - b1[j]); }
                    sc = MFMA16(pack8(kt), qhat[ks], sc); }
                if (i == mt) {
#pragma unroll
                    for (int j = 0; j < 4; ++j) if (4 * fq + j > fr) sc[j] = 0.f; }
                pk[i][0] = cvt_pk_bf16(sc[0], sc[1]); pk[i][1] = cvt_pk_bf16(sc[2], sc[3]);
            } else { pk[i][0] = 0u; pk[i][1] = 0u; } }
#pragma unroll
        for (int kk = 0; kk < 2; ++kk) if (2 * kk <= mt) {
            u32x4 pw; pw.x = pk[2 * kk][0]; pw.y = pk[2 * kk][1]; pw.z = pk[2 * kk + 1][0]; pw.w = pk[2 * kk + 1][1]; const bf16x8 pf = __builtin_bit_cast(bf16x8, pw);
#pragma unroll
            for (int n = 0; n < 4; ++n) { const bf16* vrow = VT + (size_t)(h * 128 + 16 * (4 * nh + n) + fr) * M + c * 64 + 32 * kk + 4 * fq;
                const u32x2 lo = *(const u32x2*)vrow, hi = *(const u32x2*)(vrow + 16); u32x4 vw; vw.x = lo.x; vw.y = lo.y; vw.z = hi.x; vw.w = hi.y;
                o[n] = MFMA16(__builtin_bit_cast(bf16x8, vw), pf, o[n]); } }
        float ss = 0.f;
#pragma unroll
        for (int n = 0; n < 4; ++n) ss += (o[n][0] * o[n][0] + o[n][1] * o[n][1]) + (o[n][2] * o[n][2] + o[n][3] * o[n][3]);
        ss += __shfl_xor(ss, 16); ss += __shfl_xor(ss, 32);
        if (fq == 0) red[wave * 16 + fr] = ss;
        __syncthreads();
        const float rstd = 1.0f / sqrtf((ss + red[(wave ^ 1) * 16 + fr]) * (1.0f / 128.0f) + RMS_EPS);
#pragma unroll
        for (int n = 0; n < 4; ++n) { const int v0 = h * 128 + 16 * (4 * nh + n) + 4 * fq; const u32x2 gw = *(const u32x2*)(GATE + tok * 1024 + v0); const f32x4 ng = *(const f32x4*)(norm_g + v0);
            u32x2 w; w.x = cvt_pk_bf16(o[n][0] * rstd * ng[0] * bf_lo(gw.x), o[n][1] * rstd * ng[1] * bf_hi(gw.x)); w.y = cvt_pk_bf16(o[n][2] * rstd * ng[2] * bf_lo(gw.y), o[n][3] * rstd * ng[3] * bf_hi(gw.y));
            *(u32x2*)(OG + tok * 1024 + v0) = w; }
    }
    __syncthreads();
}

constexpr int KS_STRIDE = 272, VS_STRIDE = 528, KS_BYTES = 256 * KS_STRIDE, VS_BYTES = 128 * VS_STRIDE, PRE_OFF = KS_BYTES + VS_BYTES;
constexpr float ATT_SC2 = 0.08838834764831845f * 1.4426950408889634f;
__device__ __forceinline__ int list_off(int n) { return 256 * (63 * n - (n * (n - 1)) / 2); }
__device__ __forceinline__ void mb_stage(const bf16* K, const bf16* VT, int h, int n, LAS unsigned char* lds, int tid) {
#pragma unroll
    for (int i = 0; i < 8; ++i) { const int row = (tid >> 4) + 32 * i, ch = tid & 15; *(LAS u32x4*)(lds + row * KS_STRIDE + ch * 16) = *(const u32x4*)(K + (size_t)(256 * n + row) * 1024 + h * 128 + 8 * ch); }
#pragma unroll
    for (int i = 0; i < 8; ++i) { const int row = (tid >> 5) + 16 * i, ch = tid & 31; *(LAS u32x4*)(lds + KS_BYTES + row * VS_STRIDE + ch * 16) = *(const u32x4*)(VT + (size_t)(h * 128 + row) * M + 256 * n + 8 * ch); }
}
__device__ __forceinline__ void attn_group(LAS const unsigned char* lds, const bf16* qrow, bool valid, float ref2, int nkt, bool causal, int qpos, int fr, int fq, f32x4 (&o)[8], float& l) {
    bf16x8 qf[4];
#pragma unroll
    for (int ks = 0; ks < 4; ++ks) qf[ks] = valid ? *(const bf16x8*)(qrow + 32 * ks + 8 * fq) : (bf16x8){0, 0, 0, 0, 0, 0, 0, 0};
    unsigned pk[16][2]; float lsum = 0.f;
#pragma unroll
    for (int kt = 0; kt < 16; ++kt) {
        if (kt < nkt) { f32x4 s = {0.f, 0.f, 0.f, 0.f};
#pragma unroll
            for (int ks = 0; ks < 4; ++ks) { const bf16x8 kf = *(const LAS bf16x8*)(lds + (16 * kt + fr) * KS_STRIDE + (32 * ks + 8 * fq) * 2); s = MFMA16(kf, qf[ks], s); }
            float pv[4];
#pragma unroll
            for (int j = 0; j < 4; ++j) { pv[j] = __builtin_amdgcn_exp2f(s[j] * ATT_SC2 - ref2); if (causal && (16 * kt + 4 * fq + j > qpos)) pv[j] = 0.f; lsum += pv[j]; }
            pk[kt][0] = cvt_pk_bf16(pv[0], pv[1]); pk[kt][1] = cvt_pk_bf16(pv[2], pv[3]);
        } else { pk[kt][0] = 0u; pk[kt][1] = 0u; } }
#pragma unroll
    for (int dt = 0; dt < 8; ++dt) o[dt] = (f32x4){0.f, 0.f, 0.f, 0.f};
#pragma unroll
    for (int kk = 0; kk < 8; ++kk) if (2 * kk < nkt) {
        u32x4 pw; pw.x = pk[2 * kk][0]; pw.y = pk[2 * kk][1]; pw.z = pk[2 * kk + 1][0]; pw.w = pk[2 * kk + 1][1]; const bf16x8 pf = __builtin_bit_cast(bf16x8, pw);
#pragma unroll
        for (int dt = 0; dt < 8; ++dt) { LAS const unsigned char* vp = lds + KS_BYTES + (16 * dt + fr) * VS_STRIDE + (32 * kk + 4 * fq) * 2;
            const u32x2 lo = *(const LAS u32x2*)vp, hi = *(const LAS u32x2*)(vp + 32); u32x4 vw; vw.x = lo.x; vw.y = lo.y; vw.z = hi.x; vw.w = hi.y;
            o[dt] = MFMA16(__builtin_bit_cast(bf16x8, vw), pf, o[dt]); } }
    lsum += __shfl_xor(lsum, 16); lsum += __shfl_xor(lsum, 32); l = lsum;
}
__device__ __forceinline__ void mb_kmean(const Params& p, unsigned char* ws, LAS unsigned char* lds, int tid, int wave, int lane) {
    int bid = blockIdx.x, gdim = gridDim.x; asm volatile("" : "+s"(bid), "+s"(gdim));
    const bf16* K = (const bf16*)(ws + WS_K); float* KMEAN = (float*)(ws + WS_KMEAN); float* KNMAX = (float*)(ws + WS_KNMAX);
    LAS float* part = (LAS float*)lds; LAS float* mx = part + 8 * 128;
    for (int unit = bid; unit < 512; unit += gdim) { const int h = unit >> 6, n = unit & 63;
        float s0 = 0.f, s1 = 0.f, rm = 0.f;
        for (int r = wave; r < 256; r += 8) { const unsigned w = *(const unsigned*)(K + (size_t)(256 * n + r) * 1024 + h * 128 + 2 * lane); const float x0 = bf_lo(w), x1 = bf_hi(w);
            s0 += x0; s1 += x1; rm = fmaxf(rm, wave_sum(x0 * x0 + x1 * x1)); }
        part[wave * 128 + 2 * lane] = s0; part[wave * 128 + 2 * lane + 1] = s1; if (lane == 0) mx[wave] = rm;
        __syncthreads();
        if (tid < 128) { float s = 0.f;
#pragma unroll
            for (int w = 0; w < 8; ++w) s += part[w * 128 + tid];
            KMEAN[(size_t)unit * 128 + tid] = s * (1.0f / 256.0f); }
        if (tid == 0) { float m = 0.f;
#pragma unroll
            for (int w = 0; w < 8; ++w) m = fmaxf(m, mx[w]);
            KNMAX[unit] = m; }
        __syncthreads(); }
}
__device__ __forceinline__ void mb_gate(const Params& p, unsigned char* ws, LAS unsigned char* lds, int tid) {
    int bid = blockIdx.x, gdim = gridDim.x; asm volatile("" : "+s"(bid), "+s"(gdim));
    const bf16* Q = (const bf16*)(ws + WS_Q); const float* KMEAN = (const float*)(ws + WS_KMEAN); const float* KNMAX = (const float*)(ws + WS_KNMAX);
    int* CNT = (int*)(ws + WS_CNT); unsigned short* LIST = (unsigned short*)(ws + WS_LIST); float* QREF = (float*)(ws + WS_QREF);
    LAS float* km = (LAS float*)lds; LAS float* kn = km + 64 * 128;
    for (int item = bid; item < 256; item += gdim) { const int h = item >> 5, s = (item & 31) * 512 + tid, blk = s >> 8;
        __syncthreads();
        for (int i = tid; i < 64 * 128 / 4; i += 512) ((LAS f32x4*)km)[i] = ((const f32x4*)(KMEAN + (size_t)h * 64 * 128))[i];
        if (tid < 64) kn[tid] = KNMAX[h * 64 + tid];
        __syncthreads();
        unsigned qp[64]; float qq = 0.f;
#pragma unroll
        for (int ch = 0; ch < 16; ++ch) { const u32x4 w = *(const u32x4*)(Q + (size_t)s * 1024 + h * 128 + 8 * ch); qp[4 * ch] = w.x; qp[4 * ch + 1] = w.y; qp[4 * ch + 2] = w.z; qp[4 * ch + 3] = w.w; }
#pragma unroll
        for (int i = 0; i < 64; ++i) { const float x0 = bf_lo(qp[i]), x1 = bf_hi(qp[i]); qq += x0 * x0 + x1 * x1; }
        float kmax = 0.f;
#pragma unroll 8
        for (int n = 0; n < 64; ++n) kmax = fmaxf(kmax, kn[n]);
        QREF[(size_t)s * 8 + h] = sqrtf(qq) * sqrtf(kmax) * ATT_SC2;
        float b0 = -3.0e38f, b1 = -3.0e38f, b2 = -3.0e38f; int i0 = 0, i1 = 0, i2 = 0;
#pragma unroll 1
        for (int n = 0; n < blk; ++n) { float d0 = 0.f, d1 = 0.f, d2 = 0.f, d3 = 0.f;
#pragma unroll
            for (int c8 = 0; c8 < 4; ++c8) {
#pragma unroll
                for (int c4 = 8 * c8; c4 < 8 * c8 + 8; ++c4) { const f32x4 k4 = *(const LAS f32x4*)(km + n * 128 + 4 * c4);
                    d0 += bf_lo(qp[2 * c4]) * k4[0]; d1 += bf_hi(qp[2 * c4]) * k4[1]; d2 += bf_lo(qp[2 * c4 + 1]) * k4[2]; d3 += bf_hi(qp[2 * c4 + 1]) * k4[3]; }
                asm volatile("" ::: "memory"); }
            const float v = (d0 + d1) + (d2 + d3);
            if (v > b0) { b2 = b1; i2 = i1; b1 = b0; i1 = i0; b0 = v; i0 = n; } else if (v > b1) { b2 = b1; i2 = i1; b1 = v; i1 = n; } else if (v > b2) { b2 = v; i2 = n; } }
#pragma unroll
        for (int r = 0; r < 3; ++r) { if (r < blk) { const int bi = r == 0 ? i0 : (r == 1 ? i1 : i2);
                const int pos = atomicAdd(&CNT[h * 64 + bi], 1);
                LIST[(size_t)h * LIST_PER_HEAD + list_off(bi) + pos] = (unsigned short)(s | (r << 14)); } }
    }
    __syncthreads();
}
__device__ __forceinline__ void mb_sel(const Params& p, unsigned char* ws, LAS unsigned char* lds, int tid, int wave, int lane) {
    int bid = blockIdx.x, gdim = gridDim.x; asm volatile("" : "+s"(bid), "+s"(gdim));
    const bf16* Q = (const bf16*)(ws + WS_Q); const bf16* K = (const bf16*)(ws + WS_K); const bf16* VT = (const bf16*)(ws + WS_VT);
    const int* CNT = (const int*)(ws + WS_CNT); const unsigned short* LIST = (const unsigned short*)(ws + WS_LIST); const float* QREF = (const float*)(ws + WS_QREF);
    bf16* PART = (bf16*)(ws + WS_PART); float* LPART = (float*)(ws + WS_LPART);
    LAS int* pre = (LAS int*)(lds + PRE_OFF); LAS int* wtot = pre + 520;
    const int fr = lane & 15, fq = lane >> 4;
    { const int tl = (CNT[tid] + 127) >> 7; int x = tl;
#pragma unroll
        for (int o = 1; o < 64; o <<= 1) { const int y = __shfl_up(x, o); if (lane >= o) x += y; }
        if (lane == 63) wtot[wave] = x;
        __syncthreads();
        int add = 0;
#pragma unroll
        for (int w = 0; w < 8; ++w) if (w < wave) add += wtot[w];
        pre[tid + 1] = x + add; if (tid == 0) pre[0] = 0;
        __syncthreads(); }
    const int T = pre[512];
    const int lo = (int)(((long)T * bid) / gdim), hi = (int)(((long)T * (bid + 1)) / gdim);
    int cur = -1;
    for (int it = lo; it < hi; ++it) {
        int a = 0, b = 511;
        while (a < b) { const int mid = (a + b + 1) >> 1; if (pre[mid] <= it) a = mid; else b = mid - 1; }
        const int hn = a, h = hn >> 6, n = hn & 63, tile = it - pre[hn];
        if (hn != cur) { __syncthreads(); mb_stage(K, VT, h, n, lds, tid); __syncthreads(); cur = hn; }
        const int cnt = CNT[hn], e0 = (tile * 8 + wave) * 16;
        if (e0 < cnt) { const int idx = e0 + fr; const bool valid = idx < cnt;
            const unsigned ent = valid ? LIST[(size_t)h * LIST_PER_HEAD + list_off(n) + idx] : 0u; const int s = ent & 0x3fff, slot = ent >> 14;
            f32x4 o[8]; float l;
            attn_group(lds, Q + (size_t)s * 1024 + h * 128, valid, QREF[(size_t)s * 8 + h], 16, false, 0, fr, fq, o, l);
            if (valid) { bf16* pp = PART + ((size_t)slot * M + s) * 1024 + h * 128 + 4 * fq;
#pragma unroll
                for (int dt = 0; dt < 8; ++dt) { u32x2 w; w.x = cvt_pk_bf16(o[dt][0], o[dt][1]); w.y = cvt_pk_bf16(o[dt][2], o[dt][3]); *(u32x2*)(pp + 16 * dt) = w; }
                if (fq == 0) LPART[((size_t)slot * M + s) * 8 + h] = l; } }
    }
    __syncthreads();
}
__device__ __forceinline__ void mb_own(const Params& p, unsigned char* ws, LAS unsigned char* lds, int tid, int wave, int lane) {
    int bid = blockIdx.x, gdim = gridDim.x; asm volatile("" : "+s"(bid), "+s"(gdim));
    const bf16* Q = (const bf16*)(ws + WS_Q); const bf16* K = (const bf16*)(ws + WS_K); const bf16* VT = (const bf16*)(ws + WS_VT);
    const float* QREF = (const float*)(ws + WS_QREF); const bf16* PART = (const bf16*)(ws + WS_PART); const float* LPART = (const float*)(ws + WS_LPART); bf16* OG = (bf16*)(ws + WS_Q);
    const int fr = lane & 15, fq = lane >> 4;
    for (int unit = bid; unit < 512; unit += gdim) { const int h = unit >> 6, b = unit & 63;
        __syncthreads(); mb_stage(K, VT, h, b, lds, tid); __syncthreads();
        const int nsl = b < 3 ? b : 3;
#pragma unroll 1
        for (int gi = 0; gi < 2; ++gi) { const int g = gi ? 15 - wave : wave, s = 256 * b + 16 * g + fr;
            f32x4 o[8]; float l;
            attn_group(lds, Q + (size_t)s * 1024 + h * 128, true, QREF[(size_t)s * 8 + h], g + 1, true, 16 * g + fr, fr, fq, o, l);
            for (int j = 0; j < nsl; ++j) { const bf16* pp = PART + ((size_t)j * M + s) * 1024 + h * 128 + 4 * fq; l += LPART[((size_t)j * M + s) * 8 + h];
#pragma unroll
                for (int dt = 0; dt < 8; ++dt) { const u32x2 w = *(const u32x2*)(pp + 16 * dt); o[dt][0] += bf_lo(w.x); o[dt][1] += bf_hi(w.x); o[dt][2] += bf_lo(w.y); o[dt][3] += bf_hi(w.y); } }
            const float inv = 1.0f / l; bf16* op = OG + (size_t)s * 1024 + h * 128 + 4 * fq;
#pragma unroll
            for (int dt = 0; dt < 8; ++dt) { u32x2 w; w.x = cvt_pk_bf16(o[dt][0] * inv, o[dt][1] * inv); w.y = cvt_pk_bf16(o[dt][2] * inv, o[dt][3] * inv); *(u32x2*)(op + 16 * dt) = w; } }
    }
    __syncthreads();
}
__device__ __forceinline__ void sc_conv(const Params& p, unsigned char* ws, int L, int tid) {
    int bid = blockIdx.x, gdim = gridDim.x; asm volatile("" : "+s"(bid), "+s"(gdim));
    const bf16* PROJ = (const bf16*)(ws + WS_PROJ); bf16* OG = (bf16*)(ws + WS_OGSC); const float* cw = p.in[base_of(L) + 1];
    for (int idx = bid * 512 + tid; idx < M * 128; idx += gdim * 512) { const int t = idx >> 7, c = (idx & 127) * 8;
        float accv[8];
#pragma unroll
        for (int j = 0; j < 8; ++j) accv[j] = 0.f;
#pragma unroll
        for (int k = 0; k < 3; ++k) { const int tt = t - 2 + k; if (tt >= 0) { float cgv[8], hv[8]; unpack8(*(const bf16x8*)(PROJ + (size_t)tt * 3072 + 1024 + c), cgv); unpack8(*(const bf16x8*)(PROJ + (size_t)tt * 3072 + 2048 + c), hv);
                const f32x4 w0 = *(const f32x4*)(cw + k * 1024 + c), w1 = *(const f32x4*)(cw + k * 1024 + c + 4);
#pragma unroll
                for (int j = 0; j < 4; ++j) { accv[j] += w0[j] * cgv[j] * hv[j]; accv[4 + j] += w1[j] * cgv[4 + j] * hv[4 + j]; } } }
        float bg[8]; unpack8(*(const bf16x8*)(PROJ + (size_t)t * 3072 + c), bg);
#pragma unroll
        for (int j = 0; j < 8; ++j) accv[j] *= bg[j];
        *(bf16x8*)(OG + (size_t)t * 1024 + c) = pack8(accv); }
}

#define XB_TMO      128
#define XB_XCNT(j)  (256  + 64 * (j))
#define XB_XSUB(j)  (1280 + 64 * (j))
#define XB_XGEN(j)  (2304 + 64 * (j))
#define XB_TOP      3328
#define XB_TOPGEN   3392
#define XCD_BAR_WORDS 3456
#define XB_SPIN_CAP (1u << 18)

__device__ __forceinline__ unsigned xb_ld(unsigned* p)              { return __hip_atomic_load(p, __ATOMIC_RELAXED, __HIP_MEMORY_SCOPE_AGENT); }
__device__ __forceinline__ unsigned xb_add(unsigned* p, unsigned v) { return __hip_atomic_fetch_add(p, v, __ATOMIC_RELAXED, __HIP_MEMORY_SCOPE_AGENT); }
__device__ __forceinline__ unsigned xb_xcc_id() { return (unsigned)__builtin_amdgcn_s_getreg((3 << 11) | 20) & 0xFu; }
#define XB_SPIN(cond, bar) do { unsigned _sp = 0; while (cond) { __builtin_amdgcn_s_sleep(1); \
    if ((++_sp & 255u) == 0u) { if (xb_ld(&(bar)[XB_TMO])) break; if (_sp > XB_SPIN_CAP) { atomicAdd(&(bar)[XB_TMO], 1u); break; } } } } while (0)

struct XcdBarrier {
    unsigned* bar; unsigned x;
    volatile LAS unsigned* st;
};

__device__ __forceinline__ XcdBarrier xcd_barrier_post(unsigned* bar, volatile LAS unsigned* st) {
    XcdBarrier b; b.bar = bar; b.x = xb_xcc_id(); b.st = st;
    if (threadIdx.x == 0) (void)xb_add(&bar[XB_XCNT(b.x)], 1u);
    return b;
}
__device__ __forceinline__ void xcd_barrier_complete(unsigned* bar, unsigned x, unsigned& nloc, unsigned& nx) {
    const unsigned G = gridDim.x * gridDim.y * gridDim.z;
    unsigned sum, cnt, mine, sp = 0u;
    for (;;) {
        sum = 0u; cnt = 0u; mine = 0u;
#pragma unroll
        for (unsigned j = 0; j < 16; ++j) { const unsigned c = xb_ld(&bar[XB_XCNT(j)]); sum += c; cnt += (c > 0u) ? 1u : 0u; mine = (j == x) ? c : mine; }
        if (sum == G) break;
        __builtin_amdgcn_s_sleep(1);
        if ((++sp & 255u) == 0u) { if (xb_ld(&bar[XB_TMO])) break; if (sp > XB_SPIN_CAP) { atomicAdd(&bar[XB_TMO], 1u); break; } }
    }
    nloc = mine > 0u ? mine : 1u; nx = cnt > 0u ? cnt : 1u;
}

__device__ __forceinline__ void xcd_barrier(const XcdBarrier& b) {
    asm volatile("s_waitcnt vmcnt(0)" ::: "memory");
    __syncthreads();
    if (threadIdx.x == 0) {
        unsigned* bar = b.bar;
        __builtin_amdgcn_s_waitcnt(0);
        unsigned nloc = b.st[0], nx = b.st[1];
        if (nloc == 0u) { xcd_barrier_complete(bar, b.x, nloc, nx); b.st[0] = nloc; b.st[1] = nx; }
        const unsigned old = xb_add(&bar[XB_XSUB(b.x)], 1u);
        const unsigned gen = old / nloc;
        if (old + 1u == (gen + 1u) * nloc) {
            __builtin_amdgcn_fence(__ATOMIC_RELEASE, "agent");
            asm volatile("s_waitcnt vmcnt(0)" ::: "memory");
            const unsigned og = xb_add(&bar[XB_TOP], 1u);
            const unsigned tg = og / nx;
            if (og + 1u == (tg + 1u) * nx) xb_add(&bar[XB_TOPGEN], 1u);
            else XB_SPIN(xb_ld(&bar[XB_TOPGEN]) == tg, bar);
            __builtin_amdgcn_fence(__ATOMIC_ACQUIRE, "agent");
            xb_add(&bar[XB_XGEN(b.x)], 1u);
            asm volatile("s_waitcnt vmcnt(0)" ::: "memory");
        } else {
            XB_SPIN(xb_ld(&bar[XB_XGEN(b.x)]) == gen, bar);
            __builtin_amdgcn_fence(__ATOMIC_ACQUIRE, "agent");
            asm volatile("s_waitcnt vmcnt(0)" ::: "memory");
        }
    }
    __syncthreads();
}


__global__ void __launch_bounds__(512, 2) mk_fwd(Params p) {
    extern __shared__ __attribute__((aligned(16))) unsigned char lds_raw[];
    LAS unsigned char* lds = (LAS unsigned char*)lds_raw;
    const int G = gridDim.x;
    if (threadIdx.x < 4) ((LAS unsigned*)(lds + LDS_BARST))[threadIdx.x] = 0u;
    __syncthreads();
    if (p.hi - p.lo > 1) (void)xcd_barrier_post((unsigned*)(p.ws + WS_BAR), (volatile LAS unsigned*)(lds + LDS_BARST));
#define GRID_BAR() do { unsigned char* wsb = p.ws; asm volatile("" : "+s"(wsb)); XcdBarrier xb_; xb_.bar = (unsigned*)(wsb + WS_BAR); xb_.x = xb_xcc_id(); xb_.st = (volatile LAS unsigned*)(lds + LDS_BARST); xcd_barrier(xb_); } while (0)
#define FRESH() unsigned char* ws = p.ws; float* Y = p.out; int zero = 0; int tid = threadIdx.x; int bid = blockIdx.x, gdim = gridDim.x; asm volatile("" : "+s"(ws), "+s"(Y), "+s"(zero), "+v"(tid), "+s"(bid), "+s"(gdim)); \
        const int lane = tid & 63, wave = __builtin_amdgcn_readfirstlane(tid >> 6), gw = bid * 8 + wave, NGW = gdim * 8; bf16* XB = (bf16*)(ws + WS_XB); (void)lane; (void)gw; (void)NGW; (void)XB; (void)Y; (void)zero;
    for (int pi = p.lo; pi < p.hi; ++pi) {
        const int pw = __builtin_amdgcn_readfirstlane((int)p.prog[pi]); const int op = pw & 31, L = pw >> 5;
        if (op == OP_PRO) { FRESH();
            const float* x = p.in[zero];
            for (size_t i = (size_t)bid * 512 + tid; i < (size_t)M * D / 8; i += (size_t)gdim * 512) { const f32x4 a = ((const f32x4*)x)[2 * i], b = ((const f32x4*)x)[2 * i + 1];
                u32x4 w; w.x = cvt_pk_bf16(a.x, a.y); w.y = cvt_pk_bf16(a.z, a.w); w.z = cvt_pk_bf16(b.x, b.y); w.w = cvt_pk_bf16(b.z, b.w); ((u32x4*)XB)[i] = w; }
            if (bid == 0 && tid == 0) *(unsigned*)(ws + 3 * 1024) = 0u;
            if (bid == 0) { const float* lbp = p.in[2 + zero]; float* LB = (float*)(ws + WS_LBTAB);
                for (int c = tid; c < 1024; c += 512) { const float a0 = lbp[c], a1 = lbp[1024 + c], a2 = lbp[2048 + c], a3 = lbp[3072 + c]; const float mx = fmaxf(fmaxf(a0, a1), fmaxf(a2, a3));
                    const float e0 = __expf(a0 - mx), e1 = __expf(a1 - mx), e2 = __expf(a2 - mx), e3 = __expf(a3 - mx); const float inv = 1.0f / (e0 + e1 + e2 + e3);
                    LB[c] = 0.f; LB[1024 + c] = (e1 + e2 + e3) * inv; } }
            convert_weights(p, ws, 0, lds, gw, NGW, wave, lane);
        } else if (op == OP_HG_IN || op == OP_MB_IN || op == OP_SC_IN || op == OP_OUT || op == OP_UP || op == OP_DOWN) {
            FRESH(); const int nsub = (op == OP_HG_IN || op == OP_MB_IN) ? 2 : 1;
            if (op == OP_MB_IN && bid == 0) ((int*)(ws + WS_CNT))[tid] = 0;
            for (int subx = 0; subx < nsub * (1 + DUP_GEMM); ++subx) { const int sub = subx % nsub;
                pg8::Gemm g; pg8::Epi E; int nM, nN; g.M = M; g.amode = 0; E.aux = nullptr; E.pos = nullptr; E.O1 = nullptr; E.ldc = 1024;
                bf16* WIN = (bf16*)(ws + WS_WIN);
                if (op == OP_HG_IN) {
                    if (sub == 0) { g.A = XB; g.Bt = WIN; g.N = 2048; g.K = 1024; nM = 64; nN = 8; E.mode = pg8::EPI_SILU_SPLIT; E.O0 = ws + WS_Q; E.O1 = ws + WS_GATE; }
                    else { g.A = WIN + (size_t)2048 * 1024; g.Bt = XB; g.N = M; g.K = 1024; nM = 8; nN = 64; E.mode = pg8::EPI_T_HGRN; E.O0 = ws + WS_GT; E.O1 = ws + WS_VT; E.aux = (const float*)(ws + WS_LBTAB) + (L == 0 ? 0 : 1024); }
                } else if (op == OP_MB_IN) {
                    if (sub == 0) { g.A = XB; g.Bt = WIN; g.N = 2048; g.K = 1024; nM = 64; nN = 8; E.mode = pg8::EPI_ROPE_SPLIT; E.O0 = ws + WS_Q; E.O1 = ws + WS_K; E.pos = (const int*)p.in[1 + zero]; }
                    else { g.A = WIN + (size_t)2048 * 1024; g.Bt = XB; g.N = M; g.K = 1024; nM = 4; nN = 64; E.mode = pg8::EPI_T_PLAIN; E.O0 = ws + WS_VT; }
                } else if (op == OP_SC_IN) { g.A = XB; g.Bt = WIN; g.N = 3072; g.K = 1024; nM = 64; nN = 12; E.mode = pg8::EPI_PLAIN; E.O0 = ws + WS_PROJ; E.ldc = 3072;
                } else if (op == OP_OUT) { g.A = (const bf16*)(ws + (kind_of(L) == 2 ? WS_OGSC : WS_Q)); g.Bt = (const bf16*)(ws + WS_WOUT); g.N = 1024; g.K = 1024; nM = 64; nN = 4; E.mode = pg8::EPI_RES; E.O0 = Y; E.O1 = XB;
                } else if (op == OP_UP) { g.A = XB - (size_t)2 * 1024; g.Bt = (const bf16*)(ws + WS_WUP); g.N = NFF; g.K = 1024; g.amode = 1; nM = 67; nN = 22; E.mode = pg8::EPI_UPCONV; E.O0 = ws + WS_H; E.aux = p.in[wout_of(L) + 4];
                } else { g.A = (const bf16*)(ws + WS_H); g.Bt = (const bf16*)(ws + WS_WDN); g.N = 1024; g.K = DFF; nM = 64; nN = 4; E.mode = pg8::EPI_RES; E.O0 = Y; E.O1 = XB; }
                pg8::StaticOrder S; S.init(nM, nN, gdim, bid);
                pg8::gemm_phase<pg8::Epi, pg8::StaticOrder, true, true>(lds, g, S, E);
            }
        } else if (op == OP_HG_R1) { FRESH(); hg_r1(p, ws, wave, lane);
        } else if (op == OP_HG_R2) { FRESH(); hg_r2(p, ws, tid);
        } else if (op == OP_HG_R3) { FRESH(); hg_r3(p, ws, L, lds, tid, wave, lane);
        } else if (op == OP_MB_KMEAN) { FRESH(); mb_kmean(p, ws, lds, tid, wave, lane);
        } else if (op == OP_MB_GATE) { FRESH(); mb_gate(p, ws, lds, tid);
        } else if (op == OP_MB_SEL) { FRESH(); mb_sel(p, ws, lds, tid, wave, lane);
        } else if (op == OP_MB_OWN) { FRESH(); mb_own(p, ws, lds, tid, wave, lane);
        } else if (op == OP_SC_CONV) { FRESH(); sc_conv(p, ws, L, tid);
        } else if (op == OP_LN1 || op == OP_LN2) { FRESH();
            const int wo = wout_of(L); const float* gg = p.in[wo + (op == OP_LN1 ? 1 : 6)]; const float* bb = p.in[wo + (op == OP_LN1 ? 2 : 7)];
            const bool fin = (op == OP_LN2 && L == 3);
            for (int r = gw; r < M; r += NGW) ln_row(Y + (size_t)r * D, gg, bb, fin ? nullptr : XB + (size_t)r * D, fin ? Y + (size_t)r * D : nullptr, lane);
            if (op == OP_LN2 && L < 3) convert_weights(p, ws, L + 1, lds, gw, NGW, wave, lane);
        }
        else if (op == OP_CONVW) { FRESH(); convert_weights(p, ws, L, lds, gw, NGW, wave, lane); }
        else if (op == OP_DIAG1) { FRESH(); const unsigned short* R = (const unsigned short*)(ws + DIAG_OFF); unsigned bad = 0;
            for (size_t i = (size_t)bid * 512 + tid; i < (size_t)DIAG_ELEMS; i += (size_t)gdim * 512) { const unsigned short v = R[i]; if ((v & 0x7f80u) == 0x7f80u) bad = 1; }
            if (bad) atomicOr((unsigned*)(ws + 3 * 1024), 1u); }
        else if (op == OP_DIAG2) { FRESH(); const float A = (*(const unsigned*)(ws + 3 * 1024)) ? 3.0f : 0.0f; for (size_t i = (size_t)bid * 512 + tid; i < (size_t)M * D; i += (size_t)gdim * 512) Y[i] = A; }
        else if (op == OP_DUMP) { FRESH(); for (size_t i = (size_t)bid * 512 + tid; i < (size_t)M * D; i += (size_t)gdim * 512) Y[i] = bf2f(XB[i]); }
        if (pi + 1 < p.hi) {
            if (p.nprog < 0) cg::this_grid().sync();
            GRID_BAR();
#if DUP_SYNC
            GRID_BAR();
#endif
        }
    }
}

extern "C" void kernel_launch(void* const* d_in, const int* in_sizes, int n_in, void* d_out, int out_size, void* d_ws, size_t ws_size, hipStream_t stream) {
    static int grid = 0;
    if (grid == 0) {
        if (n_in != 42 || out_size != M * D || ws_size < WS_NEED) { fprintf(stderr, "kernel_launch: unexpected shapes (n_in %d out %d ws %zu need %zu)\n", n_in, out_size, ws_size, (size_t)WS_NEED); grid = -1; return; }
        int dev = 0, cus = 0, per_cu = 0;
        hipGetDevice(&dev); hipDeviceGetAttribute(&cus, hipDeviceAttributeMultiprocessorCount, dev);
        hipFuncSetAttribute((const void*)mk_fwd, hipFuncAttributeMaxDynamicSharedMemorySize, LDS_BYTES);
        hipOccupancyMaxActiveBlocksPerMultiprocessor(&per_cu, (const void*)mk_fwd, 512, LDS_BYTES);
        (void)hipGetLastError();
        if (per_cu < 1) per_cu = 1;
        grid = cus * 1;
        if (grid > 256) grid = 256;
    }
    if (grid < 0) return;
    Params p{};
    for (int i = 0; i < 42; ++i) p.in[i] = (const float*)d_in[i];
    p.out = (float*)d_out; p.ws = (unsigned char*)d_ws;
    int n = 0;
    p.prog[n++] = OP_PRO;
#ifndef DBG_MIX
#define DBG_MIX 15
#endif
#ifndef DBG_FFN
#define DBG_FFN 15
#endif
    bool have_w = true, out_done = false;
    for (int L = 0; L < 4; ++L) { const int k = L % 3; const unsigned char lb = (unsigned char)(L << 5);
        const bool mix = (DBG_MIX >> L) & 1, ffn = (DBG_FFN >> L) & 1;
        if (!have_w && (mix || ffn)) { p.prog[n++] = lb | OP_CONVW; have_w = true; }
        if (mix) {
            if (k == 0) { p.prog[n++] = lb | OP_HG_IN;
#ifndef DBG_SKIPR
#define DBG_SKIPR 0
#endif
                if (!(DBG_SKIPR & 1)) p.prog[n++] = lb | OP_HG_R1;
#ifdef DBG_DIAG_AFTER_R1
                p.prog[n++] = OP_DIAG1; p.prog[n++] = OP_DIAG2; goto prog_done;
#endif
 if (!(DBG_SKIPR & 2)) p.prog[n++] = lb | OP_HG_R2; if (!(DBG_SKIPR & 4)) p.prog[n++] = lb | OP_HG_R3; }
            else if (k == 1) { p.prog[n++] = lb | OP_MB_IN; p.prog[n++] = lb | OP_MB_KMEAN; p.prog[n++] = lb | OP_MB_GATE; p.prog[n++] = lb | OP_MB_SEL; p.prog[n++] = lb | OP_MB_OWN; }
            else { p.prog[n++] = lb | OP_SC_IN; p.prog[n++] = lb | OP_SC_CONV; }
            p.prog[n++] = lb | OP_OUT; p.prog[n++] = lb | OP_LN1; }
        if (ffn) { p.prog[n++] = lb | OP_UP; p.prog[n++] = lb | OP_DOWN; p.prog[n++] = lb | OP_LN2; out_done = (L == 3); }
        else have_w = false; }
    if (!out_done) p.prog[n++] = OP_DUMP;
prog_done:
    p.nprog = n;
#if ONE_LAUNCH
    p.lo = 0; p.hi = n;
    if (hipMemsetAsync((char*)d_ws + WS_BAR, 0, BAR_ZERO_BYTES, stream) != hipSuccess) { fprintf(stderr, "memset of barrier words failed\n"); return; }
    void* args[] = {&p};
    hipError_t e = hipLaunchCooperativeKernel((const void*)mk_fwd, dim3(grid), dim3(512), args, LDS_BYTES, stream);
    if (e != hipSuccess) fprintf(stderr, "cooperative launch failed: %s (grid %d)\n", hipGetErrorString(e), grid);
#else
    for (int i = 0; i < n; ++i) { p.lo = i; p.hi = i + 1; hipLaunchKernelGGL(mk_fwd, dim3(grid), dim3(512), LDS_BYTES, stream, p); }
#endif
}
```

```cpp
#include <hip/hip_runtime.h>
#include <hip/hip_cooperative_groups.h>
#include <cstdio>
#include <cstdint>
namespace cg = cooperative_groups;

#ifndef ONE_LAUNCH
#define ONE_LAUNCH 1
#endif
#define DBG_SKIPR 0
#define R1_VAR 0
#ifndef DUP_SYNC
#define DUP_SYNC 0
#endif
#ifndef DUP_GEMM
#define DUP_GEMM 0
#endif

namespace pg8 {
#define PG8_LAS __attribute__((address_space(3)))
typedef unsigned short bf16_t;
typedef short bf16x8 __attribute__((ext_vector_type(8)));
typedef float f32x4 __attribute__((ext_vector_type(4)));
typedef unsigned u32x4 __attribute__((ext_vector_type(4)));
constexpr int BM = 256, BK = 64, HALF = 128, HTB = HALF * BK * 2  , STAGE_BYTES = 8 * HTB, NXCD = 8, WGM = 8;

__host__ __device__ __forceinline__ int lds_byte(int r, int c) { const int st = (r >> 4) * 2 + (c >> 5), rr = r & 15, cc = c & 31, ob = rr * 64 + cc * 2; return st * 1024 + (ob ^ (((ob >> 9) & 1) << 5)); }
__host__ __device__ __forceinline__ void stage_rc(int b, int& R, int& C) { const int st = b / 1024, sb = b % 1024, swz = sb ^ (((sb >> 9) & 1) << 5); R = (st >> 1) * 16 + swz / 64; C = (st & 1) * 32 + (swz % 64) / 2; }
__host__ __device__ __forceinline__ int perm32(int rho) { const int n = rho >> 4, i = rho & 15; return 8 * (i >> 2) + 4 * n + (i & 3); }

struct Unit { int pm, pn; };
struct Gemm { const bf16_t* A; const bf16_t* Bt; int M, N, K, amode; };

typedef float f32x2_t __attribute__((ext_vector_type(2))); typedef __bf16 bf16x2_t __attribute__((ext_vector_type(2)));
__device__ __forceinline__ unsigned cvt_pk_bf16(float lo, float hi) { f32x2_t v = {lo, hi}; bf16x2_t b = __builtin_convertvector(v, bf16x2_t); return __builtin_bit_cast(unsigned, b); }

struct StaticOrder {
    int nM, nN, nwg, G, c;
    __host__ __device__ void init(int nM_, int nN_, int G_, int c_) { nM = nM_; nN = nN_; nwg = nM * nN; G = G_; c = c_; }
    __host__ __device__ bool next(int i, Unit& u) const {
        const long L = (long)i * G + c; if (L >= nwg) return false;
        int wgid = (int)L; { const int q = nwg / NXCD, r = nwg % NXCD, xcd = wgid % NXCD, off = wgid / NXCD; wgid = (xcd < r ? xcd * (q + 1) : r * (q + 1) + (xcd - r) * q) + off; }
        const int nig = WGM * nN, gid = wgid / nig, fm = gid * WGM, gsz = (nM - fm) < WGM ? (nM - fm) : WGM;
        u.pm = fm + ((wgid % nig) % gsz); u.pn = (wgid % nig) / gsz; return true;
    }
    __device__ __forceinline__ void a_ready(const Unit&) const {}
    __device__ __forceinline__ void done(const Unit&) const {}
};

typedef unsigned u32x2 __attribute__((ext_vector_type(2)));
typedef _Float16 h16x4 __attribute__((ext_vector_type(4)));
__device__ __forceinline__ float bf_lo(unsigned w) { return __uint_as_float(w << 16); }
__device__ __forceinline__ float bf_hi(unsigned w) { return __uint_as_float(w & 0xffff0000u); }
__device__ __forceinline__ float silu_f(float x) { return x * __builtin_amdgcn_rcpf(1.0f + __builtin_amdgcn_exp2f(-1.4426950408889634f * x)); }
__device__ __forceinline__ float ror1(float x) { return __int_as_float(__builtin_amdgcn_update_dpp(0, __float_as_int(x), 0x121, 0xF, 0xF, false)); }
__device__ __forceinline__ float ror2(float x) { return __int_as_float(__builtin_amdgcn_update_dpp(0, __float_as_int(x), 0x122, 0xF, 0xF, false)); }
__device__ const double ROPE_F[16] = {0.15915494309189535, 0.070086521587798503, 0.03086376340470123, 0.013591370636193905, 0.0059851857127137054, 0.002635675898667414, 0.001160663641240061, 0.00051111750453754386,
    0.00022507907903927653, 9.9117309369019355e-05, 4.3647952792802891e-05, 1.9221100684944863e-05, 8.4643308082414014e-06, 3.7274086019153519e-06, 1.6414262627950345e-06, 7.2282930688328648e-07};
constexpr int TOK = 16384;
constexpr float DN_ALPHA = 1.6817928305074290f;
enum { EPI_SILU_SPLIT = 0, EPI_PLAIN = 1, EPI_ROPE_SPLIT = 2, EPI_T_HGRN = 3, EPI_T_PLAIN = 4, EPI_RES = 5, EPI_UPCONV = 6 };
struct Epi {
    static constexpr bool PERM = false, AFTER_DRAIN = false;
    int mode, ldc; void* O0; void* O1; const float* aux; const int* pos;
    __device__ __forceinline__ void st4(bf16_t* p, f32x4 v) const { u32x2 w; w.x = cvt_pk_bf16(v[0], v[1]); w.y = cvt_pk_bf16(v[2], v[3]); *(u32x2*)p = w; }
    __device__ __forceinline__ void operator()(const f32x4 (&acc)[2][2][4][2], const Unit& u, int wr, int wc, int fr, int fq) const {
        const int row0 = u.pm * BM + wr * 64 + fr, col0 = u.pn * BM + wc * 32 + 4 * fq;
        if (mode == EPI_RES) {
            float* Y = (float*)O0; const bf16_t* XB = (const bf16_t*)O1;
#pragma unroll
            for (int ai = 0; ai < 2; ++ai)
#pragma unroll
                for (int m = 0; m < 4; ++m) { const size_t ro = (size_t)(row0 + ai * HALF + m * 16) * 1024 + col0;
#pragma unroll
                    for (int bj = 0; bj < 2; ++bj)
#pragma unroll
                        for (int n = 0; n < 2; ++n) { const size_t o = ro + bj * HALF + n * 16; const u32x2 xw = *(const u32x2*)(XB + o);
                            f32x4 r; r[0] = DN_ALPHA * bf_lo(xw.x) + acc[ai][bj][m][n][0]; r[1] = DN_ALPHA * bf_hi(xw.x) + acc[ai][bj][m][n][1];
                            r[2] = DN_ALPHA * bf_lo(xw.y) + acc[ai][bj][m][n][2]; r[3] = DN_ALPHA * bf_hi(xw.y) + acc[ai][bj][m][n][3];
                            *(f32x4*)(Y + o) = r; } }
        } else if (mode == EPI_UPCONV) {
            bf16_t* H = (bf16_t*)O0; const float* cw = aux;
            const int cbase = 128 * u.pn + 32 * wc + 4 * fq;
#pragma unroll
            for (int n = 0; n < 2; ++n) {
                const f32x4 wa0 = *(const f32x4*)(cw + cbase + 16 * n), wa1 = *(const f32x4*)(cw + 5632 + cbase + 16 * n), wa2 = *(const f32x4*)(cw + 2 * 5632 + cbase + 16 * n);
                const f32x4 wb0 = *(const f32x4*)(cw + 2816 + cbase + 16 * n), wb1 = *(const f32x4*)(cw + 5632 + 2816 + cbase + 16 * n), wb2 = *(const f32x4*)(cw + 2 * 5632 + 2816 + cbase + 16 * n);
#pragma unroll
                for (int ai = 0; ai < 2; ++ai) { const int tok0 = 248 * u.pm + 62 * (2 * ai + wr) - 2;
                    f32x4 pa1 = {0.f, 0.f, 0.f, 0.f}, pa2 = pa1, pb1 = pa1, pb2 = pa1;
#pragma unroll
                    for (int m = 0; m < 4; ++m) { const int rho = 16 * m + fr, tok = tok0 + rho;
                        const f32x4 za = acc[ai][0][m][n], zb = acc[ai][1][m][n]; f32x4 ra1, ra2, rb1, rb2, hv;
#pragma unroll
                        for (int e = 0; e < 4; ++e) { ra1[e] = ror1(za[e]); ra2[e] = ror2(za[e]); rb1[e] = ror1(zb[e]); rb2[e] = ror2(zb[e]); }
#pragma unroll
                        for (int e = 0; e < 4; ++e) {
                            float a1 = fr == 0 ? pa1[e] : ra1[e], a2 = fr < 2 ? pa2[e] : ra2[e], b1 = fr == 0 ? pb1[e] : rb1[e], b2 = fr < 2 ? pb2[e] : rb2[e];
                            if (tok < 1) { a1 = 0.f; b1 = 0.f; } if (tok < 2) { a2 = 0.f; b2 = 0.f; }
                            const float ua = wa2[e] * za[e] + wa1[e] * a1 + wa0[e] * a2, ub = wb2[e] * zb[e] + wb1[e] * b1 + wb0[e] * b2;
                            hv[e] = silu_f(ua) * ub; }
                        if (rho >= 2 && tok < TOK) st4(H + (size_t)tok * 2816 + cbase + 16 * n, hv);
                        pa1 = ra1; pa2 = ra2; pb1 = rb1; pb2 = rb2; }
                    asm volatile("" ::: "memory"); } }
        } else if (mode == EPI_T_HGRN || mode == EPI_T_PLAIN) {
            const bool isg = (mode == EPI_T_HGRN) && (u.pm < 4);
            bf16_t* base = (mode == EPI_T_HGRN && u.pm >= 4) ? (bf16_t*)O1 - (size_t)1024 * TOK : (bf16_t*)O0;
#pragma unroll
            for (int ai = 0; ai < 2; ++ai)
#pragma unroll
                for (int m = 0; m < 4; ++m) { const int r = row0 + ai * HALF + m * 16; const size_t ro = (size_t)r * TOK + col0; const float lb = isg ? aux[r] : 0.f;
#pragma unroll
                    for (int bj = 0; bj < 2; ++bj)
#pragma unroll
                        for (int n = 0; n < 2; ++n) { const f32x4 v = acc[ai][bj][m][n]; bf16_t* p = base + ro + bj * HALF + n * 16;
                            if (isg) { h16x4 hg;
#pragma unroll
                                for (int e = 0; e < 4; ++e) { const float sg = __builtin_amdgcn_rcpf(1.0f + __expf(-v[e])); hg[e] = (_Float16)__logf(lb + (1.0f - lb) * sg); }
                                *(h16x4*)p = hg; }
                            else st4(p, v); } }
        } else {
            int colt = u.pn * BM; bf16_t* base = (bf16_t*)O0;
            if (mode != EPI_PLAIN) { if (colt >= 1024) { base = (bf16_t*)O1; colt -= 1024; } }
            const int c0 = colt + wc * 32 + 4 * fq;
            double rf[4];
#pragma unroll
            for (int e = 0; e < 4; ++e) rf[e] = ROPE_F[4 * fq + e];
#pragma unroll
            for (int ai = 0; ai < 2; ++ai)
#pragma unroll
                for (int m = 0; m < 4; ++m) { const int r = row0 + ai * HALF + m * 16; bf16_t* rowp = base + (size_t)r * ldc + c0;
                    float cs[4], sn[4];
                    if (mode == EPI_ROPE_SPLIT && wc == 0) { const double pp = (double)pos[r];
#pragma unroll
                        for (int e = 0; e < 4; ++e) { double tt = pp * rf[e]; tt -= __builtin_floor(tt); const float tf = (float)tt; sn[e] = __builtin_amdgcn_sinf(tf); cs[e] = __builtin_amdgcn_cosf(tf); } }
#pragma unroll
                    for (int bj = 0; bj < 2; ++bj) { f32x4 v0 = acc[ai][bj][m][0], v1 = acc[ai][bj][m][1];
                        if (mode == EPI_SILU_SPLIT) {
#pragma unroll
                            for (int e = 0; e < 4; ++e) { v0[e] = silu_f(v0[e]); v1[e] = silu_f(v1[e]); } }
                        if (mode == EPI_ROPE_SPLIT && wc == 0) {
#pragma unroll
                            for (int e = 0; e < 4; ++e) { const float x1 = v0[e], x2 = v1[e]; v0[e] = x1 * cs[e] - x2 * sn[e]; v1[e] = x2 * cs[e] + x1 * sn[e]; } }
                        st4(rowp + bj * HALF, v0); st4(rowp + bj * HALF + 16, v1); } }
        }
    }
};

template <class Epi, class Sched, bool ALIGN_EPI = false, bool SP2 = false>
__device__ __forceinline__ void gemm_phase(PG8_LAS unsigned char* lds, const Gemm g, const Sched& S, const Epi& E) {
    int tid = threadIdx.x; asm volatile("" : "+v"(tid));
    const int wid = __builtin_amdgcn_readfirstlane(tid >> 6), lane = tid & 63, wr = wid >> 2, wc = wid & 3, fr = lane & 15, fq = lane >> 4;
    const int K = g.K, nt = K / BK;
    unsigned voffA[2], voffB[2];
#pragma unroll
    for (int i = 0; i < 2; ++i) { int R, C; stage_rc(tid * 16 + i * 8192, R, C); const int Rb = Epi::PERM ? ((R & ~31) + perm32(R & 31)) : R;
        voffA[i] = (unsigned)((g.amode ? (R - 2 * (R >> 6)) : R) * K + C) * 2u; voffB[i] = (unsigned)(Rb * K + C) * 2u; }
    const size_t kstep = (size_t)(BK * 2);
    const size_t hstep = (size_t)HALF * K * 2;
    const size_t tstep = 2 * hstep;  const size_t hstepA = g.amode ? (size_t)124 * K * 2 : hstep, tstepA = 2 * hstepA;
    const unsigned ldsw = (unsigned)wid * 1024u;
    const int aoff = lds_byte(wr * 64 + fr, fq * 8), boff = lds_byte(wc * 32 + fr, fq * 8);
#define PG8_SA(b, h) (((b) * 2 + (h)) * HTB)
#define PG8_SB(b, h) ((4 + (b) * 2 + (h)) * HTB)
#define PG8_STAGE(bufoff, gbase, voff) do { _Pragma("unroll") for (int _i = 0; _i < 2; ++_i) \
        __builtin_amdgcn_global_load_lds((const unsigned*)((const char*)(gbase) + (voff)[_i]), (PG8_LAS unsigned*)(lds + (bufoff) + ldsw + _i * 8192), 16, 0, 0); } while (0)
#define PG8_LDA(dst, b, h) do { _Pragma("unroll") for (int m = 0; m < 4; ++m) _Pragma("unroll") for (int k = 0; k < 2; ++k) dst[m][k] = *(const PG8_LAS bf16x8*)(lds + PG8_SA(b, h) + aoff + m * 2048 + k * 1024); } while (0)
#define PG8_LDB(dst, b, h) do { _Pragma("unroll") for (int n = 0; n < 2; ++n) _Pragma("unroll") for (int k = 0; k < 2; ++k) dst[n][k] = *(const PG8_LAS bf16x8*)(lds + PG8_SB(b, h) + boff + n * 2048 + k * 1024); } while (0)
#define PG8_MMA(ai, bj, At, Bt) do { __builtin_amdgcn_s_setprio(1); _Pragma("unroll") for (int m = 0; m < 4; ++m) _Pragma("unroll") for (int n = 0; n < 2; ++n) _Pragma("unroll") for (int k = 0; k < 2; ++k) \
        acc[ai][bj][m][n] = __builtin_amdgcn_mfma_f32_16x16x32_bf16(Bt[n][k], At[m][k], acc[ai][bj][m][n], 0, 0, 0); __builtin_amdgcn_s_setprio(0); } while (0)
#define PG8_WAIT_V(n) asm volatile("s_waitcnt vmcnt(" #n ")" ::: "memory")
#define PG8_WAIT_L(n) asm volatile("s_waitcnt lgkmcnt(" #n ")" ::: "memory")
#define PG8_BAR __builtin_amdgcn_s_barrier()
#define PG8_SCHED __builtin_amdgcn_sched_barrier(0)
    Unit cur, nxt; int ui = 0;
    if (!S.next(0, cur)) return;
    f32x4 acc[2][2][4][2];
#pragma unroll
    for (int a = 0; a < 2; ++a)
#pragma unroll
        for (int b = 0; b < 2; ++b)
#pragma unroll
            for (int m = 0; m < 4; ++m)
#pragma unroll
                for (int n = 0; n < 2; ++n) acc[a][b][m][n] = (f32x4){0.f, 0.f, 0.f, 0.f};
    bf16x8 At[4][2], B0[2][2], B1[2][2];
    const char* cA = (const char*)g.A + (size_t)cur.pm * tstepA; const char* cB = (const char*)g.Bt + (size_t)cur.pn * tstep;
    S.a_ready(cur);
    if constexpr (SP2) {
        PG8_STAGE(PG8_SB(0, 0), cB, voffB); PG8_STAGE(PG8_SB(0, 1), cB + hstep, voffB); PG8_STAGE(PG8_SA(0, 0), cA, voffA); PG8_STAGE(PG8_SA(0, 1), cA + hstepA, voffA);
        if (wr == 1) PG8_BAR;
        PG8_WAIT_V(2); PG8_BAR;
        PG8_STAGE(PG8_SB(1, 0), cB + kstep, voffB); PG8_STAGE(PG8_SA(1, 0), cA + kstep, voffA); PG8_STAGE(PG8_SB(1, 1), cB + hstep + kstep, voffB);
        PG8_WAIT_V(6); PG8_BAR;
    } else {
        PG8_STAGE(PG8_SB(0, 0), cB, voffB); PG8_STAGE(PG8_SA(0, 0), cA, voffA); PG8_STAGE(PG8_SB(0, 1), cB + hstep, voffB); PG8_STAGE(PG8_SA(0, 1), cA + hstepA, voffA);
        if (wr == 1) PG8_BAR;
        PG8_WAIT_V(4); PG8_BAR;
        PG8_STAGE(PG8_SB(1, 0), cB + kstep, voffB); PG8_STAGE(PG8_SA(1, 0), cA + kstep, voffA); PG8_STAGE(PG8_SB(1, 1), cB + hstep + kstep, voffB);
        PG8_WAIT_V(6); PG8_BAR;
    }
    for (;;) {
        const bool has_next = S.next(ui + 1, nxt);
        const char* nA = has_next ? (const char*)g.A + (size_t)nxt.pm * tstepA : cA; const char* nB = has_next ? (const char*)g.Bt + (size_t)nxt.pn * tstep : cB;
        for (int t = 0; t < nt; t += 2) {
            const bool last = (t == nt - 2);
            const char* a1 = cA + (size_t)(t + 1) * kstep;
            const char* a2 = last ? nA : cA + (size_t)(t + 2) * kstep; const char* b2 = last ? nB : cB + (size_t)(t + 2) * kstep;
            const char* a3 = a2 + kstep; const char* b3 = b2 + kstep;
            if (last && has_next) S.a_ready(nxt);
            if constexpr (SP2) {
            PG8_LDB(B0, 0, 0); PG8_LDB(B1, 0, 1); PG8_SCHED; PG8_LDA(At, 0, 0); PG8_STAGE(PG8_SA(1, 1), a1 + hstepA, voffA);
            PG8_WAIT_V(8); PG8_WAIT_L(0); PG8_BAR; PG8_MMA(0, 0, At, B0); PG8_MMA(0, 1, At, B1); PG8_BAR; PG8_SCHED;
            PG8_LDA(At, 0, 1); PG8_STAGE(PG8_SB(0, 0), b2, voffB); PG8_STAGE(PG8_SB(0, 1), b2 + hstep, voffB); PG8_STAGE(PG8_SA(0, 0), a2, voffA);
            PG8_WAIT_V(8); PG8_WAIT_L(0); PG8_BAR; PG8_MMA(1, 0, At, B0); PG8_MMA(1, 1, At, B1); PG8_BAR; PG8_SCHED;
            PG8_LDB(B0, 1, 0); PG8_LDB(B1, 1, 1); PG8_SCHED; PG8_LDA(At, 1, 0); PG8_STAGE(PG8_SA(0, 1), a2 + hstepA, voffA);
            PG8_WAIT_V(8); PG8_WAIT_L(0); PG8_BAR; PG8_MMA(0, 0, At, B0); PG8_MMA(0, 1, At, B1); PG8_BAR; PG8_SCHED;
            PG8_LDA(At, 1, 1); PG8_STAGE(PG8_SB(1, 0), b3, voffB); PG8_STAGE(PG8_SB(1, 1), b3 + hstep, voffB); PG8_STAGE(PG8_SA(1, 0), a3, voffA);
            PG8_WAIT_V(8); PG8_WAIT_L(0); PG8_BAR; PG8_MMA(1, 0, At, B0); PG8_MMA(1, 1, At, B1); PG8_BAR; PG8_SCHED;
            } else {
            PG8_LDB(B0, 0, 0); PG8_SCHED; PG8_LDA(At, 0, 0); PG8_STAGE(PG8_SA(1, 1), a1 + hstepA, voffA);
            PG8_WAIT_L(8); PG8_BAR; PG8_WAIT_L(0); PG8_MMA(0, 0, At, B0); PG8_BAR; PG8_SCHED;
            PG8_LDB(B1, 0, 1); PG8_STAGE(PG8_SB(0, 0), b2, voffB);
            PG8_BAR; PG8_WAIT_L(0); PG8_MMA(0, 1, At, B1); PG8_BAR;
            PG8_LDA(At, 0, 1); PG8_STAGE(PG8_SA(0, 0), a2, voffA);
            PG8_BAR; PG8_WAIT_L(0); PG8_MMA(1, 0, At, B0); PG8_BAR; PG8_SCHED;
            PG8_STAGE(PG8_SB(0, 1), b2 + hstep, voffB);
            PG8_WAIT_V(6); PG8_BAR; PG8_MMA(1, 1, At, B1); PG8_BAR;
            PG8_LDB(B0, 1, 0); PG8_SCHED; PG8_LDA(At, 1, 0); PG8_STAGE(PG8_SA(0, 1), a2 + hstepA, voffA);
            PG8_WAIT_L(8); PG8_BAR; PG8_WAIT_L(0); PG8_MMA(0, 0, At, B0); PG8_BAR; PG8_SCHED;
            PG8_LDB(B1, 1, 1); PG8_STAGE(PG8_SB(1, 0), b3, voffB);
            PG8_BAR; PG8_WAIT_L(0); PG8_MMA(0, 1, At, B1); PG8_BAR;
            PG8_LDA(At, 1, 1); PG8_STAGE(PG8_SA(1, 0), a3, voffA);
            PG8_BAR; PG8_WAIT_L(0); PG8_MMA(1, 0, At, B0); PG8_BAR; PG8_SCHED;
            PG8_STAGE(PG8_SB(1, 1), b3 + hstep, voffB);
            PG8_WAIT_V(6); PG8_BAR; PG8_MMA(1, 1, At, B1); PG8_BAR;
            }
        }
        if constexpr (ALIGN_EPI) { if (wr == 0) PG8_BAR; }
        if constexpr (!Epi::AFTER_DRAIN) { E(acc, cur, wr, wc, fr, fq); S.done(cur); __builtin_amdgcn_s_waitcnt(0x0F70); }
        if (!has_next) break;
#pragma unroll
        for (int a = 0; a < 2; ++a)
#pragma unroll
            for (int b = 0; b < 2; ++b)
#pragma unroll
                for (int m = 0; m < 4; ++m)
#pragma unroll
                    for (int n = 0; n < 2; ++n) acc[a][b][m][n] = (f32x4){0.f, 0.f, 0.f, 0.f};
        cur = nxt; cA = nA; cB = nB; ++ui;
        if constexpr (ALIGN_EPI) { if (wr == 1) PG8_BAR; }
    }
    PG8_WAIT_V(0);
    if constexpr (!ALIGN_EPI) { if (wr == 0) PG8_BAR; }
    PG8_BAR;
    if constexpr (Epi::AFTER_DRAIN) { E.fused(acc, cur, wr, wc, fr, fq, lds, wid, lane); S.done(cur); }
#undef PG8_SA
#undef PG8_SB
#undef PG8_STAGE
#undef PG8_LDA
#undef PG8_LDB
#undef PG8_MMA
#undef PG8_WAIT_V
#undef PG8_WAIT_L
#undef PG8_BAR
#undef PG8_SCHED
}
}

#define LAS __attribute__((address_space(3)))
typedef unsigned short bf16;
typedef short bf16x8 __attribute__((ext_vector_type(8)));
typedef float f32x4 __attribute__((ext_vector_type(4)));
typedef unsigned u32x4 __attribute__((ext_vector_type(4)));
typedef unsigned u32x2 __attribute__((ext_vector_type(2)));
typedef _Float16 h16x8 __attribute__((ext_vector_type(8)));
using pg8::bf_lo; using pg8::bf_hi; using pg8::cvt_pk_bf16;

constexpr int M = 16384, D = 1024, DFF = 2816, NFF = 5632;
constexpr float LN_EPS = 1e-5f, RMS_EPS = 1e-6f;
constexpr size_t MiB = 1u << 20;
constexpr size_t WS_CNT = 0, WS_LBTAB = 4096, WS_KNMAX = 16384, WS_KMEAN = 65536, WS_QREF = 512 * 1024, WS_DEC = 1 * MiB, WS_LPART = 2 * MiB;
constexpr size_t WS_WIN = 4 * MiB, WS_WOUT = 12 * MiB, WS_WUP = 14 * MiB, WS_WDN = 25 * MiB;
constexpr size_t WS_XB = 32 * MiB, WS_L = 64 * MiB;
constexpr size_t WS_Q = WS_L, WS_GT = WS_L + 32 * MiB, WS_VT = WS_L + 64 * MiB, WS_GATE = WS_L + 96 * MiB, WS_ST = WS_L + 128 * MiB;
constexpr size_t WS_K = WS_L + 32 * MiB, WS_LIST = WS_L + 96 * MiB, WS_PART = WS_L + 104 * MiB;
constexpr size_t WS_PROJ = WS_L, WS_OGSC = WS_L + 96 * MiB;
constexpr size_t WS_H = WS_L;
constexpr size_t WS_NEED = WS_PART + 96 * MiB;
constexpr int LDS_BYTES = 147456;
constexpr size_t WS_BAR = 32 * 1024, BAR_ZERO_BYTES = 16 * 1024;
constexpr int LDS_BARST = LDS_BYTES - 16;
#ifndef DIAG_OFF
#define DIAG_OFF WS_VT
#define DIAG_ELEMS (16u << 20)
#endif
constexpr int LIST_PER_HEAD = 256 * 2016;

enum { OP_PRO = 0, OP_HG_IN, OP_HG_R1, OP_HG_R2, OP_HG_R3, OP_MB_IN, OP_MB_KMEAN, OP_MB_GATE, OP_MB_SEL, OP_MB_OWN, OP_SC_IN, OP_SC_CONV, OP_OUT, OP_LN1, OP_UP, OP_DOWN, OP_LN2, OP_CONVW, OP_DUMP, OP_DIAG1, OP_DIAG2 };
struct Params { const float* in[42]; float* out; unsigned char* ws; unsigned char prog[64]; int nprog, lo, hi, pad; };

template <class T> __device__ __forceinline__ T* as_global(T* q) { return (T*)(__attribute__((address_space(1))) T*)q; }
__device__ __forceinline__ unsigned f2bf(float f) { unsigned u = __float_as_uint(f); return (u + 0x7fffu + ((u >> 16) & 1u)) >> 16; }
__device__ __forceinline__ float bf2f(unsigned short b) { return __uint_as_float((unsigned)b << 16); }
__device__ __forceinline__ bf16x8 pack8(const float (&v)[8]) { u32x4 w; w.x = cvt_pk_bf16(v[0], v[1]); w.y = cvt_pk_bf16(v[2], v[3]); w.z = cvt_pk_bf16(v[4], v[5]); w.w = cvt_pk_bf16(v[6], v[7]); return __builtin_bit_cast(bf16x8, w); }
__device__ __forceinline__ void unpack8(bf16x8 x, float (&v)[8]) { const u32x4 w = __builtin_bit_cast(u32x4, x); v[0] = bf_lo(w.x); v[1] = bf_hi(w.x); v[2] = bf_lo(w.y); v[3] = bf_hi(w.y); v[4] = bf_lo(w.z); v[5] = bf_hi(w.z); v[6] = bf_lo(w.w); v[7] = bf_hi(w.w); }
__device__ __forceinline__ float wave_sum(float v) {
#pragma unroll
    for (int o = 1; o < 64; o <<= 1) v += __shfl_xor(v, o);
    return v;
}
#define MFMA16(a, b, c) __builtin_amdgcn_mfma_f32_16x16x32_bf16((a), (b), (c), 0, 0, 0)

__device__ __forceinline__ int kind_of(int L) { return L == 1 ? 1 : (L == 2 ? 2 : 0); }
__device__ __forceinline__ int base_of(int L) { return L == 0 ? 3 : (L == 1 ? 13 : (L == 2 ? 22 : 32)); }
__device__ __forceinline__ int wout_of(int L) { return base_of(L) + (L == 1 ? 1 : 2); }

__device__ __forceinline__ void transpose_item(const float* W, int ldw, int K, int col0, int ncols, bf16* WT, int drow0, int mode, LAS float* scr, int item, int lane) {
    const int nblk = ncols / 32, kb = item / nblk, nb = item % nblk, k0 = 64 * kb, n0 = 32 * nb;
    int dr;
    if (mode == 1) { const int c = n0; dr = c < DFF ? 256 * (c / 128) + (c % 128) : 256 * ((c - DFF) / 128) + 128 + ((c - DFF) % 128); } else dr = drow0 + n0;
#pragma unroll 8
    for (int i = 0; i < 32; ++i) { const int kk = 2 * i + (lane >> 5); scr[kk * 33 + (lane & 31)] = W[(size_t)(k0 + kk) * ldw + col0 + n0 + (lane & 31)]; }
    asm volatile("s_waitcnt lgkmcnt(0)" ::: "memory");
    const int c = lane & 7;
#pragma unroll
    for (int j = 0; j < 4; ++j) { const int n = (lane >> 3) + 8 * j; const LAS float* s = scr + (8 * c) * 33 + n;
        u32x4 o; o.x = cvt_pk_bf16(s[0 * 33], s[1 * 33]); o.y = cvt_pk_bf16(s[2 * 33], s[3 * 33]); o.z = cvt_pk_bf16(s[4 * 33], s[5 * 33]); o.w = cvt_pk_bf16(s[6 * 33], s[7 * 33]);
        *(u32x4*)(WT + (size_t)(dr + n) * K + k0 + 8 * c) = o; }
    asm volatile("s_waitcnt lgkmcnt(0)" ::: "memory");
}
__device__ __forceinline__ void convert_weights(const Params& p, unsigned char* ws, int L, LAS unsigned char* lds, int gw, int NGW, int wave, int lane) {
    LAS float* scr = (LAS float*)(lds + wave * 16384);
    const int kind = kind_of(L), wo = wout_of(L);
    const float* w_in = as_global(p.in[base_of(L)]); const float* w_out = as_global(p.in[wo]); const float* w_up = as_global(p.in[wo + 3]); const float* w_dn = as_global(p.in[wo + 5]);
    bf16* WIN = (bf16*)(ws + WS_WIN); bf16* WOUT = (bf16*)(ws + WS_WOUT); bf16* WUP = (bf16*)(ws + WS_WUP); bf16* WDN = (bf16*)(ws + WS_WDN);
    const int ldin = kind == 0 ? 4096 : 3072;
    const int n0 = (kind == 0 ? 1024 : 3072), n1 = (kind == 0 ? 1024 : 0), n2 = (kind == 0 ? 2048 : 0);
    const int i0 = 16 * (n0 / 32), i1 = 16 * (n1 / 32), i2 = 16 * (n2 / 32), i3 = 16 * 32, i4 = 16 * (NFF / 32), i5 = (DFF / 64) * 32;
    const int total = i0 + i1 + i2 + i3 + i4 + i5;
    for (int it = gw; it < total; it += NGW) {
        int r = it;
        if (r < i0) { transpose_item(w_in, ldin, 1024, 0, n0, WIN, 0, 0, scr, r, lane); continue; } r -= i0;
        if (r < i1) { transpose_item(w_in, ldin, 1024, 3072, n1, WIN, 1024, 0, scr, r, lane); continue; } r -= i1;
        if (r < i2) { transpose_item(w_in, ldin, 1024, 1024, n2, WIN, 2048, 0, scr, r, lane); continue; } r -= i2;
        if (r < i3) { transpose_item(w_out, 1024, 1024, 0, 1024, WOUT, 0, 0, scr, r, lane); continue; } r -= i3;
        if (r < i4) { transpose_item(w_up, NFF, 1024, 0, NFF, WUP, 0, 1, scr, r, lane); continue; } r -= i4;
        transpose_item(w_dn, 1024, DFF, 0, 1024, WDN, 0, 0, scr, r, lane);
    }
}

__device__ __forceinline__ void ln_row(const float* yrow, const float* g, const float* b, bf16* orow, float* frow, int lane) {
    const f32x4* xr = (const f32x4*)yrow + lane;
    f32x4 v[4]; float s = 0.f;
#pragma unroll
    for (int j = 0; j < 4; ++j) { v[j] = xr[64 * j]; s += (v[j].x + v[j].y) + (v[j].z + v[j].w); }
    const float mean = wave_sum(s) * (1.f / D); float s2 = 0.f;
#pragma unroll
    for (int j = 0; j < 4; ++j) { v[j] = v[j] - mean; s2 += (v[j].x * v[j].x + v[j].y * v[j].y) + (v[j].z * v[j].z + v[j].w * v[j].w); }
    const float rstd = 1.f / sqrtf(wave_sum(s2) * (1.f / D) + LN_EPS);
#pragma unroll
    for (int j = 0; j < 4; ++j) { const f32x4 gg = ((const f32x4*)g)[lane + 64 * j], bb = ((const f32x4*)b)[lane + 64 * j]; const f32x4 o = v[j] * rstd * gg + bb;
        if (orow) { u32x2 w; w.x = cvt_pk_bf16(o.x, o.y); w.y = cvt_pk_bf16(o.z, o.w); ((u32x2*)orow)[lane + 64 * j] = w; }
        if (frow) ((f32x4*)frow)[lane + 64 * j] = o; }
}

__device__ __forceinline__ void hg_prefix(const _Float16* grow, int fr, int fq, float (&g)[2][8], float (&b)[2][8], float& blast) {
    const h16x8 v0 = *(const h16x8*)(grow + 8 * fq), v1 = *(const h16x8*)(grow + 32 + 8 * fq);
    float t0 = 0.f, t1 = 0.f;
#pragma unroll
    for (int j = 0; j < 8; ++j) { g[0][j] = (float)v0[j]; t0 += g[0][j]; b[0][j] = t0; g[1][j] = (float)v1[j]; t1 += g[1][j]; b[1][j] = t1; }
    float off0 = 0.f, off1 = 0.f, sum0 = 0.f, sum1 = 0.f;
#pragma unroll
    for (int q = 0; q < 4; ++q) { const float a0 = __shfl(t0, fr + 16 * q), a1 = __shfl(t1, fr + 16 * q); if (q < fq) { off0 += a0; off1 += a1; } sum0 += a0; sum1 += a1; }
#pragma unroll
    for (int j = 0; j < 8; ++j) { b[0][j] += off0; b[1][j] += sum0 + off1; }
    blast = sum0 + sum1;
}

__device__ __forceinline__ void hg_r1(const Params& p, unsigned char* ws, int wave, int lane) {
    int bid = blockIdx.x, gdim = gridDim.x; asm volatile("" : "+s"(bid), "+s"(gdim));
    const _Float16* GT = (const _Float16*)(ws + WS_GT); const bf16* VT = (const bf16*)(ws + WS_VT); bf16* ST = (bf16*)(ws + WS_ST); float* DEC = (float*)(ws + WS_DEC);
    const int fr = lane & 15, fq = lane >> 4;
    for (int unit = bid; unit < 2048; unit += gdim) {
        const int h = unit >> 8, c = unit & 255, d = 16 * wave + fr;
        float g[2][8], b[2][8], blast;
        hg_prefix(GT + (size_t)(h * 128 + d) * M + c * 64, fr, fq, g, b, blast);
        bf16x8 afr[2];
#pragma unroll
        for (int ks = 0; ks < 2; ++ks) { float kd[8];
#pragma unroll
            for (int j = 0; j < 8; ++j) {
#if R1_VAR == 1
                kd[j] = (1.0f - __expf(g[ks][j]));
#elif R1_VAR == 2
                kd[j] = __expf(blast - b[ks][j]);
#elif R1_VAR == 3
                kd[j] = 1.0f;
#else
                kd[j] = (1.0f - __expf(g[ks][j])) * __expf(blast - b[ks][j]);
#endif
            }
            afr[ks] = pack8(kd); }
        if (fq == 0) DEC[(h * 256 + c) * 128 + d] = __expf(blast);
#pragma unroll
        for (int nt = 0; nt < 8; ++nt) { f32x4 acc = {0.f, 0.f, 0.f, 0.f};
#pragma unroll
            for (int ks = 0; ks < 2; ++ks) { const bf16x8 bfr = *(const bf16x8*)(VT + (size_t)(h * 128 + 16 * nt + fr) * M + c * 64 + 32 * ks + 8 * fq); acc = MFMA16(afr[ks], bfr, acc); }
            u32x2 w; w.x = cvt_pk_bf16(acc[0], acc[1]); w.y = cvt_pk_bf16(acc[2], acc[3]);
            *(u32x2*)(ST + ((size_t)(h * 256 + c) * 128 + 16 * nt + fr) * 128 + 16 * wave + 4 * fq) = w; }
    }
}
__device__ __forceinline__ void hg_r2(const Params& p, unsigned char* ws, int tid) {
    int bid = blockIdx.x, gdim = gridDim.x; asm volatile("" : "+s"(bid), "+s"(gdim));
    bf16* ST = (bf16*)(ws + WS_ST); const float* DEC = (const float*)(ws + WS_DEC);
    for (int e = bid * 512 + tid; e < 131072; e += gdim * 512) {
        const int h = e >> 14, r = e & 16383, d = r & 127;
        bf16* sp = ST + (size_t)h * 256 * 16384 + r; const float* dp = DEC + h * 256 * 128 + d;
        float S = 0.f;
        for (int c = 0; c < 256; c += 8) { unsigned short loc[8]; float dc[8];
#pragma unroll
            for (int i = 0; i < 8; ++i) { loc[i] = sp[(size_t)(c + i) * 16384]; dc[i] = dp[(c + i) * 128]; }
#pragma unroll
            for (int i = 0; i < 8; ++i) { sp[(size_t)(c + i) * 16384] = (bf16)f2bf(S); S = dc[i] * S + bf2f(loc[i]); } }
    }
}
__device__ __forceinline__ void hg_r3(const Params& p, unsigned char* ws, int L, LAS unsigned char* lds, int tid, int wave, int lane) {
    int bid = blockIdx.x, gdim = gridDim.x; asm volatile("" : "+s"(bid), "+s"(gdim));
    const _Float16* GT = (const _Float16*)(ws + WS_GT); const bf16* VT = (const bf16*)(ws + WS_VT); const bf16* ST = (const bf16*)(ws + WS_ST);
    const bf16* Q = (const bf16*)(ws + WS_Q); const bf16* GATE = (const bf16*)(ws + WS_GATE); bf16* OG = (bf16*)(ws + WS_Q);
    const float* norm_g = as_global(p.in[base_of(L) + 1]);
    LAS float* bt = (LAS float*)lds; LAS float* red = bt + 65 * 132;
    const int fr = lane & 15, fq = lane >> 4;
    if (tid < 132) bt[tid] = 0.f;
    const int mt = wave >> 1, nh = wave & 1;
    for (int unit = bid; unit < 2048; unit += gdim) {
        const int h = unit >> 8, c = unit & 255;
        { const int d = 16 * wave + fr; float g[2][8], b[2][8], blast;
            hg_prefix(GT + (size_t)(h * 128 + d) * M + c * 64, fr, fq, g, b, blast);
#pragma unroll
            for (int ks = 0; ks < 2; ++ks)
#pragma unroll
                for (int j = 0; j < 8; ++j) bt[(32 * ks + 8 * fq + j + 1) * 132 + d] = b[ks][j]; }
        __syncthreads();
        const int t = 16 * mt + fr; const size_t tok = (size_t)c * 64 + t;
        bf16x8 qtil[4], qhat[4]; float Rr[4][8];
#pragma unroll
        for (int ks = 0; ks < 4; ++ks) { float qf[8], bq[8], a[8], a2[8];
            unpack8(*(const bf16x8*)(Q + tok * 1024 + h * 128 + 32 * ks + 8 * fq), qf);
            const f32x4 b0 = *(const LAS f32x4*)(bt + (t + 1) * 132 + 32 * ks + 8 * fq), b1 = *(const LAS f32x4*)(bt + (t + 1) * 132 + 32 * ks + 8 * fq + 4);
            const f32x4 r0 = *(const LAS f32x4*)(bt + (16 * mt) * 132 + 32 * ks + 8 * fq), r1 = *(const LAS f32x4*)(bt + (16 * mt) * 132 + 32 * ks + 8 * fq + 4);
#pragma unroll
            for (int j = 0; j < 4; ++j) { bq[j] = b0[j]; bq[4 + j] = b1[j]; Rr[ks][j] = r0[j]; Rr[ks][4 + j] = r1[j]; }
#pragma unroll
            for (int j = 0; j < 8; ++j) { a[j] = qf[j] * __expf(bq[j]); a2[j] = qf[j] * __expf(bq[j] - Rr[ks][j]); }
            qtil[ks] = pack8(a); qhat[ks] = pack8(a2); }
        f32x4 o[4];
#pragma unroll
        for (int n = 0; n < 4; ++n) { o[n] = (f32x4){0.f, 0.f, 0.f, 0.f};
#pragma unroll
            for (int ks = 0; ks < 4; ++ks) { const bf16x8 sfr = *(const bf16x8*)(ST + ((size_t)(h * 256 + c) * 128 + 16 * (4 * nh + n) + fr) * 128 + 32 * ks + 8 * fq); o[n] = MFMA16(sfr, qtil[ks], o[n]); } }
        unsigned pk[4][2];
#pragma unroll
        for (int i = 0; i < 4; ++i) {
            if (i <= mt) { f32x4 sc = {0.f, 0.f, 0.f, 0.f}; const int s = 16 * i + fr;
#pragma unroll
                for (int ks = 0; ks < 4; ++ks) { float kt[8];
                    const f32x4 b0 = *(const LAS f32x4*)(bt + (s + 1) * 132 + 32 * ks + 8 * fq), b1 = *(const LAS f32x4*)(bt + (s + 1) * 132 + 32 * ks + 8 * fq + 4);
                    const f32x4 m0 = *(const LAS f32x4*)(bt + s * 132 + 32 * ks + 8 * fq), m1 = *(const LAS f32x4*)(bt + s * 132 + 32 * ks + 8 * fq + 4);
#pragma unroll
                    for (int j = 0; j < 4; ++j) { kt[j] = (1.0f - __expf(b0[j] - m0[j])) * __expf(Rr[ks][j] - b0[j]); kt[4 + j] = (1.0f - __expf(b1[j] - m1[j])) * __expf(Rr[ks][4 + j] - b1[j]); }
                    sc = MFMA16(pack8(kt), qhat[ks], sc); }
                if (i == mt) {
#pragma unroll
                    for (int j = 0; j < 4; ++j) if (4 * fq + j > fr) sc[j] = 0.f; }
                pk[i][0] = cvt_pk_bf16(sc[0], sc[1]); pk[i][1] = cvt_pk_bf16(sc[2], sc[3]);
            } else { pk[i][0] = 0u; pk[i][1] = 0u; } }
#pragma unroll
        for (int kk = 0; kk < 2; ++kk) if (2 * kk <= mt) {
            u32x4 pw; pw.x = pk[2 * kk][0]; pw.y = pk[2 * kk][1]; pw.z = pk[2 * kk + 1][0]; pw.w = pk[2 * kk + 1][1]; const bf16x8 pf = __builtin_bit_cast(bf16x8, pw);
#pragma unroll
            for (int n = 0; n < 4; ++n) { const bf16* vrow = VT + (size_t)(h * 128 + 16 * (4 * nh + n) + fr) * M + c * 64 + 32 * kk + 4 * fq;
                const u32x2 lo = *(const u32x2*)vrow, hi = *(const u32x2*)(vrow + 16); u32x4 vw; vw.x = lo.x; vw.y = lo.y; vw.z = hi.x; vw.w = hi.y;
                o[n] = MFMA16(__builtin_bit_cast(bf16x8, vw), pf, o[n]); } }
        float ss = 0.f;
#pragma unroll
        for (int n = 0; n < 4; ++n) ss += (o[n][0] * o[n][0] + o[n][1] * o[n][1]) + (o[n][2] * o[n][2] + o[n][3] * o[n][3]);
        ss += __shfl_xor(ss, 16); ss += __shfl_xor(ss, 32);
        if (fq == 0) red[wave * 16 + fr] = ss;
        __syncthreads();
        const float rstd = 1.0f / sqrtf((ss + red[(wave ^ 1) * 16 + fr]) * (1.0f / 128.0f) + RMS_EPS);
#pragma unroll
        for (int n = 0; n < 4; ++n) { const int v0 = h * 128 + 16 * (4 * nh + n) + 4 * fq; const u32x2 gw = *(const u32x2*)(GATE + tok * 1024 + v0); const f32x4 ng = *(const f32x4*)(norm_g + v0);
            u32x2 w; w.x = cvt_pk_bf16(o[n][0] * rstd * ng[0] * bf_lo(gw.x), o[n][1] * rstd * ng[1] * bf_hi(gw.x)); w.y = cvt_pk_bf16(o[n][2] * rstd * ng[2] * bf_lo(gw.y), o[n][3] * rstd * ng[3] * bf_hi(gw.y));
            *(u32x2*)(OG + tok * 1024 + v0) = w; }
    }
    __syncthreads();
}

constexpr int KS_STRIDE = 272, VS_STRIDE = 528, KS_BYTES = 256 * KS_STRIDE, VS_BYTES = 128 * VS_STRIDE, PRE_OFF = KS_BYTES + VS_BYTES;
constexpr float ATT_SC2 = 0.08838834764831845f * 1.4426950408889634f;
__device__ __forceinline__ int list_off(int n) { return 256 * (63 * n - (n * (n - 1)) / 2); }
__device__ __forceinline__ void mb_stage(const bf16* K, const bf16* VT, int h, int n, LAS unsigned char* lds, int tid) {
#pragma unroll
    for (int i = 0; i < 8; ++i) { const int row = (tid >> 4) + 32 * i, ch = tid & 15; *(LAS u32x4*)(lds + row * KS_STRIDE + ch * 16) = *(const u32x4*)(K + (size_t)(256 * n + row) * 1024 + h * 128 + 8 * ch); }
#pragma unroll
    for (int i = 0; i < 8; ++i) { const int row = (tid >> 5) + 16 * i, ch = tid & 31; *(LAS u32x4*)(lds + KS_BYTES + row * VS_STRIDE + ch * 16) = *(const u32x4*)(VT + (size_t)(h * 128 + row) * M + 256 * n + 8 * ch); }
}
__device__ __forceinline__ void attn_group(LAS const unsigned char* lds, const bf16* qrow, bool valid, float ref2, int nkt, bool causal, int qpos, int fr, int fq, f32x4 (&o)[8], float& l) {
    bf16x8 qf[4];
#pragma unroll
    for (int ks = 0; ks < 4; ++ks) qf[ks] = valid ? *(const bf16x8*)(qrow + 32 * ks + 8 * fq) : (bf16x8){0, 0, 0, 0, 0, 0, 0, 0};
    unsigned pk[16][2]; float lsum = 0.f;
#pragma unroll
    for (int kt = 0; kt < 16; ++kt) {
        if (kt < nkt) { f32x4 s = {0.f, 0.f, 0.f, 0.f};
#pragma unroll
            for (int ks = 0; ks < 4; ++ks) { const bf16x8 kf = *(const LAS bf16x8*)(lds + (16 * kt + fr) * KS_STRIDE + (32 * ks + 8 * fq) * 2); s = MFMA16(kf, qf[ks], s); }
            float pv[4];
#pragma unroll
            for (int j = 0; j < 4; ++j) { pv[j] = __builtin_amdgcn_exp2f(s[j] * ATT_SC2 - ref2); if (causal && (16 * kt + 4 * fq + j > qpos)) pv[j] = 0.f; lsum += pv[j]; }
            pk[kt][0] = cvt_pk_bf16(pv[0], pv[1]); pk[kt][1] = cvt_pk_bf16(pv[2], pv[3]);
        } else { pk[kt][0] = 0u; pk[kt][1] = 0u; } }
#pragma unroll
    for (int dt = 0; dt < 8; ++dt) o[dt] = (f32x4){0.f, 0.f, 0.f, 0.f};
#pragma unroll
    for (int kk = 0; kk < 8; ++kk) if (2 * kk < nkt) {
        u32x4 pw; pw.x = pk[2 * kk][0]; pw.y = pk[2 * kk][1]; pw.z = pk[2 * kk + 1][0]; pw.w = pk[2 * kk + 1][1]; const bf16x8 pf = __builtin_bit_cast(bf16x8, pw);
#pragma unroll
        for (int dt = 0; dt < 8; ++dt) { LAS const unsigned char* vp = lds + KS_BYTES + (16 * dt + fr) * VS_STRIDE + (32 * kk + 4 * fq) * 2;
            const u32x2 lo = *(const LAS u32x2*)vp, hi = *(const LAS u32x2*)(vp + 32); u32x4 vw; vw.x = lo.x; vw.y = lo.y; vw.z = hi.x; vw.w = hi.y;
            o[dt] = MFMA16(__builtin_bit_cast(bf16x8, vw), pf, o[dt]); } }
    lsum += __shfl_xor(lsum, 16); lsum += __shfl_xor(lsum, 32); l = lsum;
}
__device__ __forceinline__ void mb_kmean(const Params& p, unsigned char* ws, LAS unsigned char* lds, int tid, int wave, int lane) {
    int bid = blockIdx.x, gdim = gridDim.x; asm volatile("" : "+s"(bid), "+s"(gdim));
    const bf16* K = (const bf16*)(ws + WS_K); float* KMEAN = (float*)(ws + WS_KMEAN); float* KNMAX = (float*)(ws + WS_KNMAX);
    LAS float* part = (LAS float*)lds; LAS float* mx = part + 8 * 128;
    for (int unit = bid; unit < 512; unit += gdim) { const int h = unit >> 6, n = unit & 63;
        float s0 = 0.f, s1 = 0.f, rm = 0.f;
        for (int r = wave; r < 256; r += 8) { const unsigned w = *(const unsigned*)(K + (size_t)(256 * n + r) * 1024 + h * 128 + 2 * lane); const float x0 = bf_lo(w), x1 = bf_hi(w);
            s0 += x0; s1 += x1; rm = fmaxf(rm, wave_sum(x0 * x0 + x1 * x1)); }
        part[wave * 128 + 2 * lane] = s0; part[wave * 128 + 2 * lane + 1] = s1; if (lane == 0) mx[wave] = rm;
        __syncthreads();
        if (tid < 128) { float s = 0.f;
#pragma unroll
            for (int w = 0; w < 8; ++w) s += part[w * 128 + tid];
            KMEAN[(size_t)unit * 128 + tid] = s * (1.0f / 256.0f); }
        if (tid == 0) { float m = 0.f;
#pragma unroll
            for (int w = 0; w < 8; ++w) m = fmaxf(m, mx[w]);
            KNMAX[unit] = m; }
        __syncthreads(); }
}
__device__ __forceinline__ void mb_gate(const Params& p, unsigned char* ws, LAS unsigned char* lds, int tid) {
    int bid = blockIdx.x, gdim = gridDim.x; asm volatile("" : "+s"(bid), "+s"(gdim));
    const bf16* Q = (const bf16*)(ws + WS_Q); const float* KMEAN = (const float*)(ws + WS_KMEAN); const float* KNMAX = (const float*)(ws + WS_KNMAX);
    int* CNT = (int*)(ws + WS_CNT); unsigned short* LIST = (unsigned short*)(ws + WS_LIST); float* QREF = (float*)(ws + WS_QREF);
    LAS float* km = (LAS float*)lds; LAS float* kn = km + 64 * 128;
    for (int item = bid; item < 256; item += gdim) { const int h = item >> 5, s = (item & 31) * 512 + tid, blk = s >> 8;
        __syncthreads();
        for (int i = tid; i < 64 * 128 / 4; i += 512) ((LAS f32x4*)km)[i] = ((const f32x4*)(KMEAN + (size_t)h * 64 * 128))[i];
        if (tid < 64) kn[tid] = KNMAX[h * 64 + tid];
        __syncthreads();
        unsigned qp[64]; float qq = 0.f;
#pragma unroll
        for (int ch = 0; ch < 16; ++ch) { const u32x4 w = *(const u32x4*)(Q + (size_t)s * 1024 + h * 128 + 8 * ch); qp[4 * ch] = w.x; qp[4 * ch + 1] = w.y; qp[4 * ch + 2] = w.z; qp[4 * ch + 3] = w.w; }
#pragma unroll
        for (int i = 0; i < 64; ++i) { const float x0 = bf_lo(qp[i]), x1 = bf_hi(qp[i]); qq += x0 * x0 + x1 * x1; }
        float kmax = 0.f;
#pragma unroll 8
        for (int n = 0; n < 64; ++n) kmax = fmaxf(kmax, kn[n]);
        QREF[(size_t)s * 8 + h] = sqrtf(qq) * sqrtf(kmax) * ATT_SC2;
        float b0 = -3.0e38f, b1 = -3.0e38f, b2 = -3.0e38f; int i0 = 0, i1 = 0, i2 = 0;
#pragma unroll 1
        for (int n = 0; n < blk; ++n) { float d0 = 0.f, d1 = 0.f, d2 = 0.f, d3 = 0.f;
#pragma unroll
            for (int c8 = 0; c8 < 4; ++c8) {
#pragma unroll
                for (int c4 = 8 * c8; c4 < 8 * c8 + 8; ++c4) { const f32x4 k4 = *(const LAS f32x4*)(km + n * 128 + 4 * c4);
                    d0 += bf_lo(qp[2 * c4]) * k4[0]; d1 += bf_hi(qp[2 * c4]) * k4[1]; d2 += bf_lo(qp[2 * c4 + 1]) * k4[2]; d3 += bf_hi(qp[2 * c4 + 1]) * k4[3]; }
                asm volatile("" ::: "memory"); }
            const float v = (d0 + d1) + (d2 + d3);
            if (v > b0) { b2 = b1; i2 = i1; b1 = b0; i1 = i0; b0 = v; i0 = n; } else if (v > b1) { b2 = b1; i2 = i1; b1 = v; i1 = n; } else if (v > b2) { b2 = v; i2 = n; } }
#pragma unroll
        for (int r = 0; r < 3; ++r) { if (r < blk) { const int bi = r == 0 ? i0 : (r == 1 ? i1 : i2);
                const int pos = atomicAdd(&CNT[h * 64 + bi], 1);
                LIST[(size_t)h * LIST_PER_HEAD + list_off(bi) + pos] = (unsigned short)(s | (r << 14)); } }
    }
    __syncthreads();
}
__device__ __forceinline__ void mb_sel(const Params& p, unsigned char* ws, LAS unsigned char* lds, int tid, int wave, int lane) {
    int bid = blockIdx.x, gdim = gridDim.x; asm volatile("" : "+s"(bid), "+s"(gdim));
    const bf16* Q = (const bf16*)(ws + WS_Q); const bf16* K = (const bf16*)(ws + WS_K); const bf16* VT = (const bf16*)(ws + WS_VT);
    const int* CNT = (const int*)(ws + WS_CNT); const unsigned short* LIST = (const unsigned short*)(ws + WS_LIST); const float* QREF = (const float*)(ws + WS_QREF);
    bf16* PART = (bf16*)(ws + WS_PART); float* LPART = (float*)(ws + WS_LPART);
    LAS int* pre = (LAS int*)(lds + PRE_OFF); LAS int* wtot = pre + 520;
    const int fr = lane & 15, fq = lane >> 4;
    { const int tl = (CNT[tid] + 127) >> 7; int x = tl;
#pragma unroll
        for (int o = 1; o < 64; o <<= 1) { const int y = __shfl_up(x, o); if (lane >= o) x += y; }
        if (lane == 63) wtot[wave] = x;
        __syncthreads();
        int add = 0;
#pragma unroll
        for (int w = 0; w < 8; ++w) if (w < wave) add += wtot[w];
        pre[tid + 1] = x + add; if (tid == 0) pre[0] = 0;
        __syncthreads(); }
    const int T = pre[512];
    const int lo = (int)(((long)T * bid) / gdim), hi = (int)(((long)T * (bid + 1)) / gdim);
    int cur = -1;
    for (int it = lo; it < hi; ++it) {
        int a = 0, b = 511;
        while (a < b) { const int mid = (a + b + 1) >> 1; if (pre[mid] <= it) a = mid; else b = mid - 1; }
        const int hn = a, h = hn >> 6, n = hn & 63, tile = it - pre[hn];
        if (hn != cur) { __syncthreads(); mb_stage(K, VT, h, n, lds, tid); __syncthreads(); cur = hn; }
        const int cnt = CNT[hn], e0 = (tile * 8 + wave) * 16;
        if (e0 < cnt) { const int idx = e0 + fr; const bool valid = idx < cnt;
            const unsigned ent = valid ? LIST[(size_t)h * LIST_PER_HEAD + list_off(n) + idx] : 0u; const int s = ent & 0x3fff, slot = ent >> 14;
            f32x4 o[8]; float l;
            attn_group(lds, Q + (size_t)s * 1024 + h * 128, valid, QREF[(size_t)s * 8 + h], 16, false, 0, fr, fq, o, l);
            if (valid) { bf16* pp = PART + ((size_t)slot * M + s) * 1024 + h * 128 + 4 * fq;
#pragma unroll
                for (int dt = 0; dt < 8; ++dt) { u32x2 w; w.x = cvt_pk_bf16(o[dt][0], o[dt][1]); w.y = cvt_pk_bf16(o[dt][2], o[dt][3]); *(u32x2*)(pp + 16 * dt) = w; }
                if (fq == 0) LPART[((size_t)slot * M + s) * 8 + h] = l; } }
    }
    __syncthreads();
}
__device__ __forceinline__ void mb_own(const Params& p, unsigned char* ws, LAS unsigned char* lds, int tid, int wave, int lane) {
    int bid = blockIdx.x, gdim = gridDim.x; asm volatile("" : "+s"(bid), "+s"(gdim));
    const bf16* Q = (const bf16*)(ws + WS_Q); const bf16* K = (const bf16*)(ws + WS_K); const bf16* VT = (const bf16*)(ws + WS_VT);
    const float* QREF = (const float*)(ws + WS_QREF); const bf16* PART = (const bf16*)(ws + WS_PART); const float* LPART = (const float*)(ws + WS_LPART); bf16* OG = (bf16*)(ws + WS_Q);
    const int fr = lane & 15, fq = lane >> 4;
    for (int unit = bid; unit < 512; unit += gdim) { const int h = unit >> 6, b = unit & 63;
        __syncthreads(); mb_stage(K, VT, h, b, lds, tid); __syncthreads();
        const int nsl = b < 3 ? b : 3;
#pragma unroll 1
        for (int gi = 0; gi < 2; ++gi) { const int g = gi ? 15 - wave : wave, s = 256 * b + 16 * g + fr;
            f32x4 o[8]; float l;
            attn_group(lds, Q + (size_t)s * 1024 + h * 128, true, QREF[(size_t)s * 8 + h], g + 1, true, 16 * g + fr, fr, fq, o, l);
            for (int j = 0; j < nsl; ++j) { const bf16* pp = PART + ((size_t)j * M + s) * 1024 + h * 128 + 4 * fq; l += LPART[((size_t)j * M + s) * 8 + h];
#pragma unroll
                for (int dt = 0; dt < 8; ++dt) { const u32x2 w = *(const u32x2*)(pp + 16 * dt); o[dt][0] += bf_lo(w.x); o[dt][1] += bf_hi(w.x); o[dt][2] += bf_lo(w.y); o[dt][3] += bf_hi(w.y); } }
            const float inv = 1.0f / l; bf16* op = OG + (size_t)s * 1024 + h * 128 + 4 * fq;
#pragma unroll
            for (int dt = 0; dt < 8; ++dt) { u32x2 w; w.x = cvt_pk_bf16(o[dt][0] * inv, o[dt][1] * inv); w.y = cvt_pk_bf16(o[dt][2] * inv, o[dt][3] * inv); *(u32x2*)(op + 16 * dt) = w; } }
    }
    __syncthreads();
}
__device__ __forceinline__ void sc_conv(const Params& p, unsigned char* ws, int L, int tid) {
    int bid = blockIdx.x, gdim = gridDim.x; asm volatile("" : "+s"(bid), "+s"(gdim));
    const bf16* PROJ = (const bf16*)(ws + WS_PROJ); bf16* OG = (bf16*)(ws + WS_OGSC); const float* cw = as_global(p.in[base_of(L) + 1]);
    for (int idx = bid * 512 + tid; idx < M * 128; idx += gdim * 512) { const int t = idx >> 7, c = (idx & 127) * 8;
        float accv[8];
#pragma unroll
        for (int j = 0; j < 8; ++j) accv[j] = 0.f;
#pragma unroll
        for (int k = 0; k < 3; ++k) { const int tt = t - 2 + k; if (tt >= 0) { float cgv[8], hv[8]; unpack8(*(const bf16x8*)(PROJ + (size_t)tt * 3072 + 1024 + c), cgv); unpack8(*(const bf16x8*)(PROJ + (size_t)tt * 3072 + 2048 + c), hv);
                const f32x4 w0 = *(const f32x4*)(cw + k * 1024 + c), w1 = *(const f32x4*)(cw + k * 1024 + c + 4);
#pragma unroll
                for (int j = 0; j < 4; ++j) { accv[j] += w0[j] * cgv[j] * hv[j]; accv[4 + j] += w1[j] * cgv[4 + j] * hv[4 + j]; } } }
        float bg[8]; unpack8(*(const bf16x8*)(PROJ + (size_t)t * 3072 + c), bg);
#pragma unroll
        for (int j = 0; j < 8; ++j) accv[j] *= bg[j];
        *(bf16x8*)(OG + (size_t)t * 1024 + c) = pack8(accv); }
}

#define XB_TMO      128
#define XB_XCNT(j)  (256  + 64 * (j))
#define XB_XSUB(j)  (1280 + 64 * (j))
#define XB_XGEN(j)  (2304 + 64 * (j))
#define XB_TOP      3328
#define XB_TOPGEN   3392
#define XCD_BAR_WORDS 3456
#define XB_SPIN_CAP (1u << 18)

__device__ __forceinline__ unsigned xb_ld(unsigned* p)              { return __hip_atomic_load(p, __ATOMIC_RELAXED, __HIP_MEMORY_SCOPE_AGENT); }
__device__ __forceinline__ unsigned xb_add(unsigned* p, unsigned v) { return __hip_atomic_fetch_add(p, v, __ATOMIC_RELAXED, __HIP_MEMORY_SCOPE_AGENT); }
__device__ __forceinline__ unsigned xb_xcc_id() { return (unsigned)__builtin_amdgcn_s_getreg((3 << 11) | 20) & 0xFu; }
#define XB_SPIN(cond, bar) do { unsigned _sp = 0; while (cond) { __builtin_amdgcn_s_sleep(1); \
    if ((++_sp & 255u) == 0u) { if (xb_ld(&(bar)[XB_TMO])) break; if (_sp > XB_SPIN_CAP) { atomicAdd(&(bar)[XB_TMO], 1u); break; } } } } while (0)

struct XcdBarrier {
    unsigned* bar; unsigned x;
    volatile LAS unsigned* st;
};

__device__ __forceinline__ XcdBarrier xcd_barrier_post(unsigned* bar, volatile LAS unsigned* st) {
    XcdBarrier b; b.bar = bar; b.x = xb_xcc_id(); b.st = st;
    if (threadIdx.x == 0) (void)xb_add(&bar[XB_XCNT(b.x)], 1u);
    return b;
}
__device__ __forceinline__ void xcd_barrier_complete(unsigned* bar, unsigned x, unsigned& nloc, unsigned& nx) {
    const unsigned G = gridDim.x * gridDim.y * gridDim.z;
    unsigned sum, cnt, mine, sp = 0u;
    for (;;) {
        sum = 0u; cnt = 0u; mine = 0u;
#pragma unroll
        for (unsigned j = 0; j < 16; ++j) { const unsigned c = xb_ld(&bar[XB_XCNT(j)]); sum += c; cnt += (c > 0u) ? 1u : 0u; mine = (j == x) ? c : mine; }
        if (sum == G) break;
        __builtin_amdgcn_s_sleep(1);
        if ((++sp & 255u) == 0u) { if (xb_ld(&bar[XB_TMO])) break; if (sp > XB_SPIN_CAP) { atomicAdd(&bar[XB_TMO], 1u); break; } }
    }
    nloc = mine > 0u ? mine : 1u; nx = cnt > 0u ? cnt : 1u;
}

__device__ __forceinline__ void xcd_barrier(const XcdBarrier& b) {
    asm volatile("s_waitcnt vmcnt(0)" ::: "memory");
    __syncthreads();
    if (threadIdx.x == 0) {
        unsigned* bar = b.bar;
        __builtin_amdgcn_s_waitcnt(0);
        unsigned nloc = b.st[0], nx = b.st[1];
        if (nloc == 0u) { xcd_barrier_complete(bar, b.x, nloc, nx); b.st[0] = nloc; b.st[1] = nx; }
        const unsigned old = xb_add(&bar[XB_XSUB(b.x)], 1u);
        const unsigned gen = old / nloc;
        if (old + 1u == (gen + 1u) * nloc) {
            __builtin_amdgcn_fence(__ATOMIC_RELEASE, "agent");
            asm volatile("s_waitcnt vmcnt(0)" ::: "memory");
            const unsigned og = xb_add(&bar[XB_TOP], 1u);
            const unsigned tg = og / nx;
            if (og + 1u == (tg + 1u) * nx) xb_add(&bar[XB_TOPGEN], 1u);
            else XB_SPIN(xb_ld(&bar[XB_TOPGEN]) == tg, bar);
            __builtin_amdgcn_fence(__ATOMIC_ACQUIRE, "agent");
            xb_add(&bar[XB_XGEN(b.x)], 1u);
            asm volatile("s_waitcnt vmcnt(0)" ::: "memory");
        } else {
            XB_SPIN(xb_ld(&bar[XB_XGEN(b.x)]) == gen, bar);
            __builtin_amdgcn_fence(__ATOMIC_ACQUIRE, "agent");
            asm volatile("s_waitcnt vmcnt(0)" ::: "memory");
        }
    }
    __syncthreads();
}


__global__ void __launch_bounds__(512, 2) mk_fwd(Params p) {
    extern __shared__ __attribute__((aligned(16))) unsigned char lds_raw[];
    LAS unsigned char* lds = (LAS unsigned char*)lds_raw;
    const int G = gridDim.x;
    if (threadIdx.x < 4) ((LAS unsigned*)(lds + LDS_BARST))[threadIdx.x] = 0u;
    __syncthreads();
    if (p.hi - p.lo > 1) (void)xcd_barrier_post((unsigned*)(as_global(p.ws) + WS_BAR), (volatile LAS unsigned*)(lds + LDS_BARST));
#define GRID_BAR() do { size_t zb = 0; asm volatile("" : "+s"(zb)); unsigned char* wsb = p.ws + zb; XcdBarrier xb_; xb_.bar = (unsigned*)(wsb + WS_BAR); xb_.x = xb_xcc_id(); xb_.st = (volatile LAS unsigned*)(lds + LDS_BARST); xcd_barrier(xb_); } while (0)
#define FRESH() size_t zo = 0; int zero = 0; int tid = threadIdx.x; int bid = blockIdx.x, gdim = gridDim.x; asm volatile("" : "+s"(zo), "+s"(zero), "+v"(tid), "+s"(bid), "+s"(gdim)); \
        unsigned char* ws = p.ws + zo; float* Y = p.out + zo; \
        const int lane = tid & 63, wave = __builtin_amdgcn_readfirstlane(tid >> 6), gw = bid * 8 + wave, NGW = gdim * 8; bf16* XB = (bf16*)(ws + WS_XB); (void)lane; (void)gw; (void)NGW; (void)XB; (void)Y; (void)zero;
    for (int pi = p.lo; pi < p.hi; ++pi) {
        const int pw = __builtin_amdgcn_readfirstlane((int)p.prog[pi]); const int op = pw & 31, L = pw >> 5;
        if (op == OP_PRO) { FRESH();
            const float* x = as_global(p.in[zero]);
            for (size_t i = (size_t)bid * 512 + tid; i < (size_t)M * D / 8; i += (size_t)gdim * 512) { const f32x4 a = ((const f32x4*)x)[2 * i], b = ((const f32x4*)x)[2 * i + 1];
                u32x4 w; w.x = cvt_pk_bf16(a.x, a.y); w.y = cvt_pk_bf16(a.z, a.w); w.z = cvt_pk_bf16(b.x, b.y); w.w = cvt_pk_bf16(b.z, b.w); ((u32x4*)XB)[i] = w; }
            if (bid == 0 && tid == 0) *(unsigned*)(ws + 3 * 1024) = 0u;
            if (bid == 0) { const float* lbp = as_global(p.in[2 + zero]); float* LB = (float*)(ws + WS_LBTAB);
                for (int c = tid; c < 1024; c += 512) { const float a0 = lbp[c], a1 = lbp[1024 + c], a2 = lbp[2048 + c], a3 = lbp[3072 + c]; const float mx = fmaxf(fmaxf(a0, a1), fmaxf(a2, a3));
                    const float e0 = __expf(a0 - mx), e1 = __expf(a1 - mx), e2 = __expf(a2 - mx), e3 = __expf(a3 - mx); const float inv = 1.0f / (e0 + e1 + e2 + e3);
                    LB[c] = 0.f; LB[1024 + c] = (e1 + e2 + e3) * inv; } }
            convert_weights(p, ws, 0, lds, gw, NGW, wave, lane);
        } else if (op == OP_HG_IN || op == OP_MB_IN || op == OP_SC_IN || op == OP_OUT || op == OP_UP || op == OP_DOWN) {
            FRESH(); const int nsub = (op == OP_HG_IN || op == OP_MB_IN) ? 2 : 1;
            if (op == OP_MB_IN && bid == 0) ((int*)(ws + WS_CNT))[tid] = 0;
            for (int subx = 0; subx < nsub * (1 + DUP_GEMM); ++subx) { const int sub = subx % nsub;
                pg8::Gemm g; pg8::Epi E; int nM, nN; g.M = M; g.amode = 0; E.aux = nullptr; E.pos = nullptr; E.O1 = nullptr; E.ldc = 1024;
                bf16* WIN = (bf16*)(ws + WS_WIN);
                if (op == OP_HG_IN) {
                    if (sub == 0) { g.A = XB; g.Bt = WIN; g.N = 2048; g.K = 1024; nM = 64; nN = 8; E.mode = pg8::EPI_SILU_SPLIT; E.O0 = ws + WS_Q; E.O1 = ws + WS_GATE; }
                    else { g.A = WIN + (size_t)2048 * 1024; g.Bt = XB; g.N = M; g.K = 1024; nM = 8; nN = 64; E.mode = pg8::EPI_T_HGRN; E.O0 = ws + WS_GT; E.O1 = ws + WS_VT; E.aux = (const float*)(ws + WS_LBTAB) + (L == 0 ? 0 : 1024); }
                } else if (op == OP_MB_IN) {
                    if (sub == 0) { g.A = XB; g.Bt = WIN; g.N = 2048; g.K = 1024; nM = 64; nN = 8; E.mode = pg8::EPI_ROPE_SPLIT; E.O0 = ws + WS_Q; E.O1 = ws + WS_K; E.pos = (const int*)as_global(p.in[1 + zero]); }
                    else { g.A = WIN + (size_t)2048 * 1024; g.Bt = XB; g.N = M; g.K = 1024; nM = 4; nN = 64; E.mode = pg8::EPI_T_PLAIN; E.O0 = ws + WS_VT; }
                } else if (op == OP_SC_IN) { g.A = XB; g.Bt = WIN; g.N = 3072; g.K = 1024; nM = 64; nN = 12; E.mode = pg8::EPI_PLAIN; E.O0 = ws + WS_PROJ; E.ldc = 3072;
                } else if (op == OP_OUT) { g.A = (const bf16*)(ws + (kind_of(L) == 2 ? WS_OGSC : WS_Q)); g.Bt = (const bf16*)(ws + WS_WOUT); g.N = 1024; g.K = 1024; nM = 64; nN = 4; E.mode = pg8::EPI_RES; E.O0 = Y; E.O1 = XB;
                } else if (op == OP_UP) { g.A = XB - (size_t)2 * 1024; g.Bt = (const bf16*)(ws + WS_WUP); g.N = NFF; g.K = 1024; g.amode = 1; nM = 67; nN = 22; E.mode = pg8::EPI_UPCONV; E.O0 = ws + WS_H; E.aux = as_global(p.in[wout_of(L) + 4]);
                } else { g.A = (const bf16*)(ws + WS_H); g.Bt = (const bf16*)(ws + WS_WDN); g.N = 1024; g.K = DFF; nM = 64; nN = 4; E.mode = pg8::EPI_RES; E.O0 = Y; E.O1 = XB; }
                pg8::StaticOrder S; S.init(nM, nN, gdim, bid);
                pg8::gemm_phase<pg8::Epi, pg8::StaticOrder, true, true>(lds, g, S, E);
            }
        } else if (op == OP_HG_R1) { FRESH(); hg_r1(p, ws, wave, lane);
        } else if (op == OP_HG_R2) { FRESH(); hg_r2(p, ws, tid);
        } else if (op == OP_HG_R3) { FRESH(); hg_r3(p, ws, L, lds, tid, wave, lane);
        } else if (op == OP_MB_KMEAN) { FRESH(); mb_kmean(p, ws, lds, tid, wave, lane);
        } else if (op == OP_MB_GATE) { FRESH(); mb_gate(p, ws, lds, tid);
        } else if (op == OP_MB_SEL) { FRESH(); mb_sel(p, ws, lds, tid, wave, lane);
        } else if (op == OP_MB_OWN) { FRESH(); mb_own(p, ws, lds, tid, wave, lane);
        } else if (op == OP_SC_CONV) { FRESH(); sc_conv(p, ws, L, tid);
        } else if (op == OP_LN1 || op == OP_LN2) { FRESH();
            const int wo = wout_of(L); const float* gg = as_global(p.in[wo + (op == OP_LN1 ? 1 : 6)]); const float* bb = as_global(p.in[wo + (op == OP_LN1 ? 2 : 7)]);
            const bool fin = (op == OP_LN2 && L == 3);
            for (int r = gw; r < M; r += NGW) ln_row(Y + (size_t)r * D, gg, bb, fin ? nullptr : XB + (size_t)r * D, fin ? Y + (size_t)r * D : nullptr, lane);
            if (op == OP_LN2 && L < 3) convert_weights(p, ws, L + 1, lds, gw, NGW, wave, lane);
        }
        else if (op == OP_CONVW) { FRESH(); convert_weights(p, ws, L, lds, gw, NGW, wave, lane); }
        else if (op == OP_DIAG1) { FRESH(); const unsigned short* R = (const unsigned short*)(ws + DIAG_OFF); unsigned bad = 0;
            for (size_t i = (size_t)bid * 512 + tid; i < (size_t)DIAG_ELEMS; i += (size_t)gdim * 512) { const unsigned short v = R[i]; if ((v & 0x7f80u) == 0x7f80u) bad = 1; }
            if (bad) atomicOr((unsigned*)(ws + 3 * 1024), 1u); }
        else if (op == OP_DIAG2) { FRESH(); const float A = (*(const unsigned*)(ws + 3 * 1024)) ? 3.0f : 0.0f; for (size_t i = (size_t)bid * 512 + tid; i < (size_t)M * D; i += (size_t)gdim * 512) Y[i] = A; }
        else if (op == OP_DUMP) { FRESH(); for (size_t i = (size_t)bid * 512 + tid; i < (size_t)M * D; i += (size_t)gdim * 512) Y[i] = bf2f(XB[i]); }
        if (pi + 1 < p.hi) {
            if (p.nprog < 0) cg::this_grid().sync();
            GRID_BAR();
#if DUP_SYNC
            GRID_BAR();
#endif
        }
    }
}

extern "C" void kernel_launch(void* const* d_in, const int* in_sizes, int n_in, void* d_out, int out_size, void* d_ws, size_t ws_size, hipStream_t stream) {
    static int grid = 0;
    if (grid == 0) {
        if (n_in != 42 || out_size != M * D || ws_size < WS_NEED) { fprintf(stderr, "kernel_launch: unexpected shapes (n_in %d out %d ws %zu need %zu)\n", n_in, out_size, ws_size, (size_t)WS_NEED); grid = -1; return; }
        int dev = 0, cus = 0, per_cu = 0;
        hipGetDevice(&dev); hipDeviceGetAttribute(&cus, hipDeviceAttributeMultiprocessorCount, dev);
        hipFuncSetAttribute((const void*)mk_fwd, hipFuncAttributeMaxDynamicSharedMemorySize, LDS_BYTES);
        hipOccupancyMaxActiveBlocksPerMultiprocessor(&per_cu, (const void*)mk_fwd, 512, LDS_BYTES);
        (void)hipGetLastError();
        if (per_cu < 1) per_cu = 1;
        grid = cus * 1;
        if (grid > 256) grid = 256;
    }
    if (grid < 0) return;
    Params p{};
    for (int i = 0; i < 42; ++i) p.in[i] = (const float*)d_in[i];
    p.out = (float*)d_out; p.ws = (unsigned char*)d_ws;
    int n = 0;
    p.prog[n++] = OP_PRO;
#ifndef DBG_MIX
#define DBG_MIX 15
#endif
#ifndef DBG_FFN
#define DBG_FFN 15
#endif
    bool have_w = true, out_done = false;
    for (int L = 0; L < 4; ++L) { const int k = L % 3; const unsigned char lb = (unsigned char)(L << 5);
        const bool mix = (DBG_MIX >> L) & 1, ffn = (DBG_FFN >> L) & 1;
        if (!have_w && (mix || ffn)) { p.prog[n++] = lb | OP_CONVW; have_w = true; }
        if (mix) {
            if (k == 0) { p.prog[n++] = lb | OP_HG_IN;
#ifndef DBG_SKIPR
#define DBG_SKIPR 0
#endif
                if (!(DBG_SKIPR & 1)) p.prog[n++] = lb | OP_HG_R1;
#ifdef DBG_DIAG_AFTER_R1
                p.prog[n++] = OP_DIAG1; p.prog[n++] = OP_DIAG2; goto prog_done;
#endif
 if (!(DBG_SKIPR & 2)) p.prog[n++] = lb | OP_HG_R2; if (!(DBG_SKIPR & 4)) p.prog[n++] = lb | OP_HG_R3; }
            else if (k == 1) { p.prog[n++] = lb | OP_MB_IN; p.prog[n++] = lb | OP_MB_KMEAN; p.prog[n++] = lb | OP_MB_GATE; p.prog[n++] = lb | OP_MB_SEL; p.prog[n++] = lb | OP_MB_OWN; }
            else { p.prog[n++] = lb | OP_SC_IN; p.prog[n++] = lb | OP_SC_CONV; }
            p.prog[n++] = lb | OP_OUT; p.prog[n++] = lb | OP_LN1; }
        if (ffn) { p.prog[n++] = lb | OP_UP; p.prog[n++] = lb | OP_DOWN; p.prog[n++] = lb | OP_LN2; out_done = (L == 3); }
        else have_w = false; }
    if (!out_done) p.prog[n++] = OP_DUMP;
prog_done:
    p.nprog = n;
#if ONE_LAUNCH
    p.lo = 0; p.hi = n;
    if (hipMemsetAsync((char*)d_ws + WS_BAR, 0, BAR_ZERO_BYTES, stream) != hipSuccess) { fprintf(stderr, "memset of barrier words failed\n"); return; }
    void* args[] = {&p};
    hipError_t e = hipLaunchCooperativeKernel((const void*)mk_fwd, dim3(grid), dim3(512), args, LDS_BYTES, stream);
    if (e != hipSuccess) fprintf(stderr, "cooperative launch failed: %s (grid %d)\n", hipGetErrorString(e), grid);
#else
    for (int i = 0; i < n; ++i) { p.lo = i; p.hi = i + 1; hipLaunchKernelGGL(mk_fwd, dim3(grid), dim3(512), LDS_BYTES, stream, p); }
#endif
}
```

```cpp
#include <hip/hip_runtime.h>
#include <hip/hip_cooperative_groups.h>
#include <cstdio>
#include <cstdint>
namespace cg = cooperative_groups;

#ifndef ONE_LAUNCH
#define ONE_LAUNCH 1
#endif
#define DBG_SKIPR 0
#define R1_VAR 0
#ifndef DUP_SYNC
#define DUP_SYNC 0
#endif
#ifndef DUP_GEMM
#define DUP_GEMM 0
#endif

namespace pg8 {
#define PG8_LAS __attribute__((address_space(3)))
typedef unsigned short bf16_t;
typedef short bf16x8 __attribute__((ext_vector_type(8)));
typedef float f32x4 __attribute__((ext_vector_type(4)));
typedef unsigned u32x4 __attribute__((ext_vector_type(4)));
constexpr int BM = 256, BK = 64, HALF = 128, HTB = HALF * BK * 2  , STAGE_BYTES = 8 * HTB, NXCD = 8, WGM = 8;

__host__ __device__ __forceinline__ int lds_byte(int r, int c) { const int st = (r >> 4) * 2 + (c >> 5), rr = r & 15, cc = c & 31, ob = rr * 64 + cc * 2; return st * 1024 + (ob ^ (((ob >> 9) & 1) << 5)); }
__host__ __device__ __forceinline__ void stage_rc(int b, int& R, int& C) { const int st = b / 1024, sb = b % 1024, swz = sb ^ (((sb >> 9) & 1) << 5); R = (st >> 1) * 16 + swz / 64; C = (st & 1) * 32 + (swz % 64) / 2; }
__host__ __device__ __forceinline__ int perm32(int rho) { const int n = rho >> 4, i = rho & 15; return 8 * (i >> 2) + 4 * n + (i & 3); }

struct Unit { int pm, pn; };
struct Gemm { const bf16_t* A; const bf16_t* Bt; int M, N, K, amode; };

typedef float f32x2_t __attribute__((ext_vector_type(2))); typedef __bf16 bf16x2_t __attribute__((ext_vector_type(2)));
__device__ __forceinline__ unsigned cvt_pk_bf16(float lo, float hi) { f32x2_t v = {lo, hi}; bf16x2_t b = __builtin_convertvector(v, bf16x2_t); return __builtin_bit_cast(unsigned, b); }

struct StaticOrder {
    int nM, nN, nwg, G, c;
    __host__ __device__ void init(int nM_, int nN_, int G_, int c_) { nM = nM_; nN = nN_; nwg = nM * nN; G = G_; c = c_; }
    __host__ __device__ bool next(int i, Unit& u) const {
        const long L = (long)i * G + c; if (L >= nwg) return false;
        int wgid = (int)L; { const int q = nwg / NXCD, r = nwg % NXCD, xcd = wgid % NXCD, off = wgid / NXCD; wgid = (xcd < r ? xcd * (q + 1) : r * (q + 1) + (xcd - r) * q) + off; }
        const int nig = WGM * nN, gid = wgid / nig, fm = gid * WGM, gsz = (nM - fm) < WGM ? (nM - fm) : WGM;
        u.pm = fm + ((wgid % nig) % gsz); u.pn = (wgid % nig) / gsz; return true;
    }
    __device__ __forceinline__ void a_ready(const Unit&) const {}
    __device__ __forceinline__ void done(const Unit&) const {}
};

typedef unsigned u32x2 __attribute__((ext_vector_type(2)));
typedef _Float16 h16x4 __attribute__((ext_vector_type(4)));
__device__ __forceinline__ float bf_lo(unsigned w) { return __uint_as_float(w << 16); }
__device__ __forceinline__ float bf_hi(unsigned w) { return __uint_as_float(w & 0xffff0000u); }
__device__ __forceinline__ float silu_f(float x) { return x * __builtin_amdgcn_rcpf(1.0f + __builtin_amdgcn_exp2f(-1.4426950408889634f * x)); }
__device__ __forceinline__ float ror1(float x) { return __int_as_float(__builtin_amdgcn_update_dpp(0, __float_as_int(x), 0x121, 0xF, 0xF, false)); }
__device__ __forceinline__ float ror2(float x) { return __int_as_float(__builtin_amdgcn_update_dpp(0, __float_as_int(x), 0x122, 0xF, 0xF, false)); }
__device__ const double ROPE_F[16] = {0.15915494309189535, 0.070086521587798503, 0.03086376340470123, 0.013591370636193905, 0.0059851857127137054, 0.002635675898667414, 0.001160663641240061, 0.00051111750453754386,
    0.00022507907903927653, 9.9117309369019355e-05, 4.3647952792802891e-05, 1.9221100684944863e-05, 8.4643308082414014e-06, 3.7274086019153519e-06, 1.6414262627950345e-06, 7.2282930688328648e-07};
constexpr int TOK = 16384;
constexpr float DN_ALPHA = 1.6817928305074290f;
enum { EPI_SILU_SPLIT = 0, EPI_PLAIN = 1, EPI_ROPE_SPLIT = 2, EPI_T_HGRN = 3, EPI_T_PLAIN = 4, EPI_RES = 5, EPI_UPCONV = 6 };
struct Epi {
    static constexpr bool PERM = false, AFTER_DRAIN = false;
    int mode, ldc; void* O0; void* O1; const float* aux; const int* pos;
    __device__ __forceinline__ void st4(bf16_t* p, f32x4 v) const { u32x2 w; w.x = cvt_pk_bf16(v[0], v[1]); w.y = cvt_pk_bf16(v[2], v[3]); *(u32x2*)p = w; }
    __device__ __forceinline__ void operator()(const f32x4 (&acc)[2][2][4][2], const Unit& u, int wr, int wc, int fr, int fq) const {
        const int row0 = u.pm * BM + wr * 64 + fr, col0 = u.pn * BM + wc * 32 + 4 * fq;
        if (mode == EPI_RES) {
            float* Y = (float*)O0; const bf16_t* XB = (const bf16_t*)O1;
#pragma unroll
            for (int ai = 0; ai < 2; ++ai)
#pragma unroll
                for (int m = 0; m < 4; ++m) { const size_t ro = (size_t)(row0 + ai * HALF + m * 16) * 1024 + col0;
#pragma unroll
                    for (int bj = 0; bj < 2; ++bj)
#pragma unroll
                        for (int n = 0; n < 2; ++n) { const size_t o = ro + bj * HALF + n * 16; const u32x2 xw = *(const u32x2*)(XB + o);
                            f32x4 r; r[0] = DN_ALPHA * bf_lo(xw.x) + acc[ai][bj][m][n][0]; r[1] = DN_ALPHA * bf_hi(xw.x) + acc[ai][bj][m][n][1];
                            r[2] = DN_ALPHA * bf_lo(xw.y) + acc[ai][bj][m][n][2]; r[3] = DN_ALPHA * bf_hi(xw.y) + acc[ai][bj][m][n][3];
                            *(f32x4*)(Y + o) = r; } }
        } else if (mode == EPI_UPCONV) {
            bf16_t* H = (bf16_t*)O0; const float* cw = aux;
            const int cbase = 128 * u.pn + 32 * wc + 4 * fq;
#pragma unroll
            for (int n = 0; n < 2; ++n) {
                const f32x4 wa0 = *(const f32x4*)(cw + cbase + 16 * n), wa1 = *(const f32x4*)(cw + 5632 + cbase + 16 * n), wa2 = *(const f32x4*)(cw + 2 * 5632 + cbase + 16 * n);
                const f32x4 wb0 = *(const f32x4*)(cw + 2816 + cbase + 16 * n), wb1 = *(const f32x4*)(cw + 5632 + 2816 + cbase + 16 * n), wb2 = *(const f32x4*)(cw + 2 * 5632 + 2816 + cbase + 16 * n);
#pragma unroll
                for (int ai = 0; ai < 2; ++ai) { const int tok0 = 248 * u.pm + 62 * (2 * ai + wr) - 2;
                    f32x4 pa1 = {0.f, 0.f, 0.f, 0.f}, pa2 = pa1, pb1 = pa1, pb2 = pa1;
#pragma unroll
                    for (int m = 0; m < 4; ++m) { const int rho = 16 * m + fr, tok = tok0 + rho;
                        const f32x4 za = acc[ai][0][m][n], zb = acc[ai][1][m][n]; f32x4 ra1, ra2, rb1, rb2, hv;
#pragma unroll
                        for (int e = 0; e < 4; ++e) { ra1[e] = ror1(za[e]); ra2[e] = ror2(za[e]); rb1[e] = ror1(zb[e]); rb2[e] = ror2(zb[e]); }
#pragma unroll
                        for (int e = 0; e < 4; ++e) {
                            float a1 = fr == 0 ? pa1[e] : ra1[e], a2 = fr < 2 ? pa2[e] : ra2[e], b1 = fr == 0 ? pb1[e] : rb1[e], b2 = fr < 2 ? pb2[e] : rb2[e];
                            if (tok < 1) { a1 = 0.f; b1 = 0.f; } if (tok < 2) { a2 = 0.f; b2 = 0.f; }
                            const float ua = wa2[e] * za[e] + wa1[e] * a1 + wa0[e] * a2, ub = wb2[e] * zb[e] + wb1[e] * b1 + wb0[e] * b2;
                            hv[e] = silu_f(ua) * ub; }
                        if (rho >= 2 && tok < TOK) st4(H + (size_t)tok * 2816 + cbase + 16 * n, hv);
                        pa1 = ra1; pa2 = ra2; pb1 = rb1; pb2 = rb2; }
                    asm volatile("" ::: "memory"); } }
        } else if (mode == EPI_T_HGRN || mode == EPI_T_PLAIN) {
            const bool isg = (mode == EPI_T_HGRN) && (u.pm < 4);
            bf16_t* base = (mode == EPI_T_HGRN && u.pm >= 4) ? (bf16_t*)O1 - (size_t)1024 * TOK : (bf16_t*)O0;
#pragma unroll
            for (int ai = 0; ai < 2; ++ai)
#pragma unroll
                for (int m = 0; m < 4; ++m) { const int r = row0 + ai * HALF + m * 16; const size_t ro = (size_t)r * TOK + col0; const float lb = isg ? aux[r] : 0.f;
#pragma unroll
                    for (int bj = 0; bj < 2; ++bj)
#pragma unroll
                        for (int n = 0; n < 2; ++n) { const f32x4 v = acc[ai][bj][m][n]; bf16_t* p = base + ro + bj * HALF + n * 16;
                            if (isg) { h16x4 hg;
#pragma unroll
                                for (int e = 0; e < 4; ++e) { const float sg = __builtin_amdgcn_rcpf(1.0f + __expf(-v[e])); hg[e] = (_Float16)__logf(lb + (1.0f - lb) * sg); }
                                *(h16x4*)p = hg; }
                            else st4(p, v); } }
        } else {
            int colt = u.pn * BM; bf16_t* base = (bf16_t*)O0;
            if (mode != EPI_PLAIN) { if (colt >= 1024) { base = (bf16_t*)O1; colt -= 1024; } }
            const int c0 = colt + wc * 32 + 4 * fq;
            double rf[4];
#pragma unroll
            for (int e = 0; e < 4; ++e) rf[e] = ROPE_F[4 * fq + e];
#pragma unroll
            for (int ai = 0; ai < 2; ++ai)
#pragma unroll
                for (int m = 0; m < 4; ++m) { const int r = row0 + ai * HALF + m * 16; bf16_t* rowp = base + (size_t)r * ldc + c0;
                    float cs[4], sn[4];
                    if (mode == EPI_ROPE_SPLIT && wc == 0) { const double pp = (double)pos[r];
#pragma unroll
                        for (int e = 0; e < 4; ++e) { double tt = pp * rf[e]; tt -= __builtin_floor(tt); const float tf = (float)tt; sn[e] = __builtin_amdgcn_sinf(tf); cs[e] = __builtin_amdgcn_cosf(tf); } }
#pragma unroll
                    for (int bj = 0; bj < 2; ++bj) { f32x4 v0 = acc[ai][bj][m][0], v1 = acc[ai][bj][m][1];
                        if (mode == EPI_SILU_SPLIT) {
#pragma unroll
                            for (int e = 0; e < 4; ++e) { v0[e] = silu_f(v0[e]); v1[e] = silu_f(v1[e]); } }
                        if (mode == EPI_ROPE_SPLIT && wc == 0) {
#pragma unroll
                            for (int e = 0; e < 4; ++e) { const float x1 = v0[e], x2 = v1[e]; v0[e] = x1 * cs[e] - x2 * sn[e]; v1[e] = x2 * cs[e] + x1 * sn[e]; } }
                        st4(rowp + bj * HALF, v0); st4(rowp + bj * HALF + 16, v1); } }
        }
    }
};

template <class Epi, class Sched, bool ALIGN_EPI = false, bool SP2 = false>
__device__ __forceinline__ void gemm_phase(PG8_LAS unsigned char* lds, const Gemm g, const Sched& S, const Epi& E) {
    int tid = threadIdx.x; asm volatile("" : "+v"(tid));
    const int wid = __builtin_amdgcn_readfirstlane(tid >> 6), lane = tid & 63, wr = wid >> 2, wc = wid & 3, fr = lane & 15, fq = lane >> 4;
    const int K = g.K, nt = K / BK;
    unsigned voffA[2], voffB[2];
#pragma unroll
    for (int i = 0; i < 2; ++i) { int R, C; stage_rc(tid * 16 + i * 8192, R, C); const int Rb = Epi::PERM ? ((R & ~31) + perm32(R & 31)) : R;
        voffA[i] = (unsigned)((g.amode ? (R - 2 * (R >> 6)) : R) * K + C) * 2u; voffB[i] = (unsigned)(Rb * K + C) * 2u; }
    const size_t kstep = (size_t)(BK * 2);
    const size_t hstep = (size_t)HALF * K * 2;
    const size_t tstep = 2 * hstep;  const size_t hstepA = g.amode ? (size_t)124 * K * 2 : hstep, tstepA = 2 * hstepA;
    const unsigned ldsw = (unsigned)wid * 1024u;
    const int aoff = lds_byte(wr * 64 + fr, fq * 8), boff = lds_byte(wc * 32 + fr, fq * 8);
#define PG8_SA(b, h) (((b) * 2 + (h)) * HTB)
#define PG8_SB(b, h) ((4 + (b) * 2 + (h)) * HTB)
#define PG8_STAGE(bufoff, gbase, voff) do { _Pragma("unroll") for (int _i = 0; _i < 2; ++_i) \
        __builtin_amdgcn_global_load_lds((const unsigned*)((const char*)(gbase) + (voff)[_i]), (PG8_LAS unsigned*)(lds + (bufoff) + ldsw + _i * 8192), 16, 0, 0); } while (0)
#define PG8_LDA(dst, b, h) do { _Pragma("unroll") for (int m = 0; m < 4; ++m) _Pragma("unroll") for (int k = 0; k < 2; ++k) dst[m][k] = *(const PG8_LAS bf16x8*)(lds + PG8_SA(b, h) + aoff + m * 2048 + k * 1024); } while (0)
#define PG8_LDB(dst, b, h) do { _Pragma("unroll") for (int n = 0; n < 2; ++n) _Pragma("unroll") for (int k = 0; k < 2; ++k) dst[n][k] = *(const PG8_LAS bf16x8*)(lds + PG8_SB(b, h) + boff + n * 2048 + k * 1024); } while (0)
#define PG8_MMA(ai, bj, At, Bt) do { __builtin_amdgcn_s_setprio(1); _Pragma("unroll") for (int m = 0; m < 4; ++m) _Pragma("unroll") for (int n = 0; n < 2; ++n) _Pragma("unroll") for (int k = 0; k < 2; ++k) \
        acc[ai][bj][m][n] = __builtin_amdgcn_mfma_f32_16x16x32_bf16(Bt[n][k], At[m][k], acc[ai][bj][m][n], 0, 0, 0); __builtin_amdgcn_s_setprio(0); } while (0)
#define PG8_WAIT_V(n) asm volatile("s_waitcnt vmcnt(" #n ")" ::: "memory")
#define PG8_WAIT_L(n) asm volatile("s_waitcnt lgkmcnt(" #n ")" ::: "memory")
#define PG8_BAR __builtin_amdgcn_s_barrier()
#define PG8_SCHED __builtin_amdgcn_sched_barrier(0)
    Unit cur, nxt; int ui = 0;
    if (!S.next(0, cur)) return;
    f32x4 acc[2][2][4][2];
#pragma unroll
    for (int a = 0; a < 2; ++a)
#pragma unroll
        for (int b = 0; b < 2; ++b)
#pragma unroll
            for (int m = 0; m < 4; ++m)
#pragma unroll
                for (int n = 0; n < 2; ++n) acc[a][b][m][n] = (f32x4){0.f, 0.f, 0.f, 0.f};
    bf16x8 At[4][2], B0[2][2], B1[2][2];
    const char* cA = (const char*)g.A + (size_t)cur.pm * tstepA; const char* cB = (const char*)g.Bt + (size_t)cur.pn * tstep;
    S.a_ready(cur);
    if constexpr (SP2) {
        PG8_STAGE(PG8_SB(0, 0), cB, voffB); PG8_STAGE(PG8_SB(0, 1), cB + hstep, voffB); PG8_STAGE(PG8_SA(0, 0), cA, voffA); PG8_STAGE(PG8_SA(0, 1), cA + hstepA, voffA);
        if (wr == 1) PG8_BAR;
        PG8_WAIT_V(2); PG8_BAR;
        PG8_STAGE(PG8_SB(1, 0), cB + kstep, voffB); PG8_STAGE(PG8_SA(1, 0), cA + kstep, voffA); PG8_STAGE(PG8_SB(1, 1), cB + hstep + kstep, voffB);
        PG8_WAIT_V(6); PG8_BAR;
    } else {
        PG8_STAGE(PG8_SB(0, 0), cB, voffB); PG8_STAGE(PG8_SA(0, 0), cA, voffA); PG8_STAGE(PG8_SB(0, 1), cB + hstep, voffB); PG8_STAGE(PG8_SA(0, 1), cA + hstepA, voffA);
        if (wr == 1) PG8_BAR;
        PG8_WAIT_V(4); PG8_BAR;
        PG8_STAGE(PG8_SB(1, 0), cB + kstep, voffB); PG8_STAGE(PG8_SA(1, 0), cA + kstep, voffA); PG8_STAGE(PG8_SB(1, 1), cB + hstep + kstep, voffB);
        PG8_WAIT_V(6); PG8_BAR;
    }
    for (;;) {
        const bool has_next = S.next(ui + 1, nxt);
        const char* nA = has_next ? (const char*)g.A + (size_t)nxt.pm * tstepA : cA; const char* nB = has_next ? (const char*)g.Bt + (size_t)nxt.pn * tstep : cB;
        for (int t = 0; t < nt; t += 2) {
            const bool last = (t == nt - 2);
            const char* a1 = cA + (size_t)(t + 1) * kstep;
            const char* a2 = last ? nA : cA + (size_t)(t + 2) * kstep; const char* b2 = last ? nB : cB + (size_t)(t + 2) * kstep;
            const char* a3 = a2 + kstep; const char* b3 = b2 + kstep;
            if (last && has_next) S.a_ready(nxt);
            if constexpr (SP2) {
            PG8_LDB(B0, 0, 0); PG8_LDB(B1, 0, 1); PG8_SCHED; PG8_LDA(At, 0, 0); PG8_STAGE(PG8_SA(1, 1), a1 + hstepA, voffA);
            PG8_WAIT_V(8); PG8_WAIT_L(0); PG8_BAR; PG8_MMA(0, 0, At, B0); PG8_MMA(0, 1, At, B1); PG8_BAR; PG8_SCHED;
            PG8_LDA(At, 0, 1); PG8_STAGE(PG8_SB(0, 0), b2, voffB); PG8_STAGE(PG8_SB(0, 1), b2 + hstep, voffB); PG8_STAGE(PG8_SA(0, 0), a2, voffA);
            PG8_WAIT_V(8); PG8_WAIT_L(0); PG8_BAR; PG8_MMA(1, 0, At, B0); PG8_MMA(1, 1, At, B1); PG8_BAR; PG8_SCHED;
            PG8_LDB(B0, 1, 0); PG8_LDB(B1, 1, 1); PG8_SCHED; PG8_LDA(At, 1, 0); PG8_STAGE(PG8_SA(0, 1), a2 + hstepA, voffA);
            PG8_WAIT_V(8); PG8_WAIT_L(0); PG8_BAR; PG8_MMA(0, 0, At, B0); PG8_MMA(0, 1, At, B1); PG8_BAR; PG8_SCHED;
            PG8_LDA(At, 1, 1); PG8_STAGE(PG8_SB(1, 0), b3, voffB); PG8_STAGE(PG8_SB(1, 1), b3 + hstep, voffB); PG8_STAGE(PG8_SA(1, 0), a3, voffA);
            PG8_WAIT_V(8); PG8_WAIT_L(0); PG8_BAR; PG8_MMA(1, 0, At, B0); PG8_MMA(1, 1, At, B1); PG8_BAR; PG8_SCHED;
            } else {
            PG8_LDB(B0, 0, 0); PG8_SCHED; PG8_LDA(At, 0, 0); PG8_STAGE(PG8_SA(1, 1), a1 + hstepA, voffA);
            PG8_WAIT_L(8); PG8_BAR; PG8_WAIT_L(0); PG8_MMA(0, 0, At, B0); PG8_BAR; PG8_SCHED;
            PG8_LDB(B1, 0, 1); PG8_STAGE(PG8_SB(0, 0), b2, voffB);
            PG8_BAR; PG8_WAIT_L(0); PG8_MMA(0, 1, At, B1); PG8_BAR;
            PG8_LDA(At, 0, 1); PG8_STAGE(PG8_SA(0, 0), a2, voffA);
            PG8_BAR; PG8_WAIT_L(0); PG8_MMA(1, 0, At, B0); PG8_BAR; PG8_SCHED;
            PG8_STAGE(PG8_SB(0, 1), b2 + hstep, voffB);
            PG8_WAIT_V(6); PG8_BAR; PG8_MMA(1, 1, At, B1); PG8_BAR;
            PG8_LDB(B0, 1, 0); PG8_SCHED; PG8_LDA(At, 1, 0); PG8_STAGE(PG8_SA(0, 1), a2 + hstepA, voffA);
            PG8_WAIT_L(8); PG8_BAR; PG8_WAIT_L(0); PG8_MMA(0, 0, At, B0); PG8_BAR; PG8_SCHED;
            PG8_LDB(B1, 1, 1); PG8_STAGE(PG8_SB(1, 0), b3, voffB);
            PG8_BAR; PG8_WAIT_L(0); PG8_MMA(0, 1, At, B1); PG8_BAR;
            PG8_LDA(At, 1, 1); PG8_STAGE(PG8_SA(1, 0), a3, voffA);
            PG8_BAR; PG8_WAIT_L(0); PG8_MMA(1, 0, At, B0); PG8_BAR; PG8_SCHED;
            PG8_STAGE(PG8_SB(1, 1), b3 + hstep, voffB);
            PG8_WAIT_V(6); PG8_BAR; PG8_MMA(1, 1, At, B1); PG8_BAR;
            }
        }
        if constexpr (ALIGN_EPI) { if (wr == 0) PG8_BAR; }
        if constexpr (!Epi::AFTER_DRAIN) { E(acc, cur, wr, wc, fr, fq); S.done(cur); __builtin_amdgcn_s_waitcnt(0x0F70); }
        if (!has_next) break;
#pragma unroll
        for (int a = 0; a < 2; ++a)
#pragma unroll
            for (int b = 0; b < 2; ++b)
#pragma unroll
                for (int m = 0; m < 4; ++m)
#pragma unroll
                    for (int n = 0; n < 2; ++n) acc[a][b][m][n] = (f32x4){0.f, 0.f, 0.f, 0.f};
        cur = nxt; cA = nA; cB = nB; ++ui;
        if constexpr (ALIGN_EPI) { if (wr == 1) PG8_BAR; }
    }
    PG8_WAIT_V(0);
    if constexpr (!ALIGN_EPI) { if (wr == 0) PG8_BAR; }
    PG8_BAR;
    if constexpr (Epi::AFTER_DRAIN) { E.fused(acc, cur, wr, wc, fr, fq, lds, wid, lane); S.done(cur); }
#undef PG8_SA
#undef PG8_SB
#undef PG8_STAGE
#undef PG8_LDA
#undef PG8_LDB
#undef PG8_MMA
#undef PG8_WAIT_V
#undef PG8_WAIT_L
#undef PG8_BAR
#undef PG8_SCHED
}
}

#define LAS __attribute__((address_space(3)))
typedef unsigned short bf16;
typedef short bf16x8 __attribute__((ext_vector_type(8)));
typedef float f32x4 __attribute__((ext_vector_type(4)));
typedef unsigned u32x4 __attribute__((ext_vector_type(4)));
typedef unsigned u32x2 __attribute__((ext_vector_type(2)));
typedef _Float16 h16x8 __attribute__((ext_vector_type(8)));
using pg8::bf_lo; using pg8::bf_hi; using pg8::cvt_pk_bf16;

constexpr int M = 16384, D = 1024, DFF = 2816, NFF = 5632;
constexpr float LN_EPS = 1e-5f, RMS_EPS = 1e-6f;
constexpr size_t MiB = 1u << 20;
constexpr size_t WS_CNT = 0, WS_LBTAB = 4096, WS_KNMAX = 16384, WS_KMEAN = 65536, WS_QREF = 512 * 1024, WS_DEC = 1 * MiB, WS_LPART = 2 * MiB;
constexpr size_t WS_WIN = 4 * MiB, WS_WOUT = 12 * MiB, WS_WUP = 14 * MiB, WS_WDN = 25 * MiB;
constexpr size_t WS_XB = 32 * MiB, WS_L = 64 * MiB;
constexpr size_t WS_Q = WS_L, WS_GT = WS_L + 32 * MiB, WS_VT = WS_L + 64 * MiB, WS_GATE = WS_L + 96 * MiB, WS_ST = WS_L + 128 * MiB;
constexpr size_t WS_K = WS_L + 32 * MiB, WS_LIST = WS_L + 96 * MiB, WS_PART = WS_L + 104 * MiB;
constexpr size_t WS_PROJ = WS_L, WS_OGSC = WS_L + 96 * MiB;
constexpr size_t WS_H = WS_L;
constexpr size_t WS_NEED = WS_PART + 96 * MiB;
constexpr int LDS_BYTES = 147456;
constexpr size_t WS_BAR = 32 * 1024, BAR_ZERO_BYTES = 16 * 1024;
constexpr int LDS_BARST = LDS_BYTES - 16;
#ifndef DIAG_OFF
#define DIAG_OFF WS_VT
#define DIAG_ELEMS (16u << 20)
#endif
constexpr int LIST_PER_HEAD = 256 * 2016;

enum { OP_PRO = 0, OP_HG_IN, OP_HG_R1, OP_HG_R2, OP_HG_R3, OP_MB_IN, OP_MB_KMEAN, OP_MB_GATE, OP_MB_SEL, OP_MB_OWN, OP_SC_IN, OP_SC_CONV, OP_OUT, OP_LN1, OP_UP, OP_DOWN, OP_LN2, OP_CONVW, OP_DUMP, OP_DIAG1, OP_DIAG2 };
struct Params { const float* in[42]; float* out; unsigned char* ws; unsigned char prog[64]; int nprog, lo, hi, pad; };

template <class T> __device__ __forceinline__ T* as_global(T* q) { return (T*)(__attribute__((address_space(1))) T*)q; }
__device__ __forceinline__ unsigned f2bf(float f) { unsigned u = __float_as_uint(f); return (u + 0x7fffu + ((u >> 16) & 1u)) >> 16; }
__device__ __forceinline__ float bf2f(unsigned short b) { return __uint_as_float((unsigned)b << 16); }
__device__ __forceinline__ bf16x8 pack8(const float (&v)[8]) { u32x4 w; w.x = cvt_pk_bf16(v[0], v[1]); w.y = cvt_pk_bf16(v[2], v[3]); w.z = cvt_pk_bf16(v[4], v[5]); w.w = cvt_pk_bf16(v[6], v[7]); return __builtin_bit_cast(bf16x8, w); }
__device__ __forceinline__ void unpack8(bf16x8 x, float (&v)[8]) { const u32x4 w = __builtin_bit_cast(u32x4, x); v[0] = bf_lo(w.x); v[1] = bf_hi(w.x); v[2] = bf_lo(w.y); v[3] = bf_hi(w.y); v[4] = bf_lo(w.z); v[5] = bf_hi(w.z); v[6] = bf_lo(w.w); v[7] = bf_hi(w.w); }
__device__ __forceinline__ float wave_sum(float v) {
#pragma unroll
    for (int o = 1; o < 64; o <<= 1) v += __shfl_xor(v, o);
    return v;
}
#define MFMA16(a, b, c) __builtin_amdgcn_mfma_f32_16x16x32_bf16((a), (b), (c), 0, 0, 0)

__device__ __forceinline__ int kind_of(int L) { return L == 1 ? 1 : (L == 2 ? 2 : 0); }
__device__ __forceinline__ int base_of(int L) { return L == 0 ? 3 : (L == 1 ? 13 : (L == 2 ? 22 : 32)); }
__device__ __forceinline__ int wout_of(int L) { return base_of(L) + (L == 1 ? 1 : 2); }

__device__ __forceinline__ void transpose_item(const float* W, int ldw, int K, int col0, int ncols, bf16* WT, int drow0, int mode, LAS float* scr, int item, int lane) {
    const int nblk = ncols / 32, kb = item / nblk, nb = item % nblk, k0 = 64 * kb, n0 = 32 * nb;
    int dr;
    if (mode == 1) { const int c = n0; dr = c < DFF ? 256 * (c / 128) + (c % 128) : 256 * ((c - DFF) / 128) + 128 + ((c - DFF) % 128); } else dr = drow0 + n0;
#pragma unroll 8
    for (int i = 0; i < 32; ++i) { const int kk = 2 * i + (lane >> 5); scr[kk * 33 + (lane & 31)] = W[(size_t)(k0 + kk) * ldw + col0 + n0 + (lane & 31)]; }
    asm volatile("s_waitcnt lgkmcnt(0)" ::: "memory");
    const int c = lane & 7;
#pragma unroll
    for (int j = 0; j < 4; ++j) { const int n = (lane >> 3) + 8 * j; const LAS float* s = scr + (8 * c) * 33 + n;
        u32x4 o; o.x = cvt_pk_bf16(s[0 * 33], s[1 * 33]); o.y = cvt_pk_bf16(s[2 * 33], s[3 * 33]); o.z = cvt_pk_bf16(s[4 * 33], s[5 * 33]); o.w = cvt_pk_bf16(s[6 * 33], s[7 * 33]);
        *(u32x4*)(WT + (size_t)(dr + n) * K + k0 + 8 * c) = o; }
    asm volatile("s_waitcnt lgkmcnt(0)" ::: "memory");
}
__device__ __forceinline__ void convert_weights(const Params& p, unsigned char* ws, int L, LAS unsigned char* lds, int gw, int NGW, int wave, int lane) {
    LAS float* scr = (LAS float*)(lds + wave * 16384);
    const int kind = kind_of(L), wo = wout_of(L);
    const float* w_in = as_global(p.in[base_of(L)]); const float* w_out = as_global(p.in[wo]); const float* w_up = as_global(p.in[wo + 3]); const float* w_dn = as_global(p.in[wo + 5]);
    bf16* WIN = (bf16*)(ws + WS_WIN); bf16* WOUT = (bf16*)(ws + WS_WOUT); bf16* WUP = (bf16*)(ws + WS_WUP); bf16* WDN = (bf16*)(ws + WS_WDN);
    const int ldin = kind == 0 ? 4096 : 3072;
    const int n0 = (kind == 0 ? 1024 : 3072), n1 = (kind == 0 ? 1024 : 0), n2 = (kind == 0 ? 2048 : 0);
    const int i0 = 16 * (n0 / 32), i1 = 16 * (n1 / 32), i2 = 16 * (n2 / 32), i3 = 16 * 32, i4 = 16 * (NFF / 32), i5 = (DFF / 64) * 32;
    const int total = i0 + i1 + i2 + i3 + i4 + i5;
    for (int it = gw; it < total; it += NGW) {
        int r = it;
        if (r < i0) { transpose_item(w_in, ldin, 1024, 0, n0, WIN, 0, 0, scr, r, lane); continue; } r -= i0;
        if (r < i1) { transpose_item(w_in, ldin, 1024, 3072, n1, WIN, 1024, 0, scr, r, lane); continue; } r -= i1;
        if (r < i2) { transpose_item(w_in, ldin, 1024, 1024, n2, WIN, 2048, 0, scr, r, lane); continue; } r -= i2;
        if (r < i3) { transpose_item(w_out, 1024, 1024, 0, 1024, WOUT, 0, 0, scr, r, lane); continue; } r -= i3;
        if (r < i4) { transpose_item(w_up, NFF, 1024, 0, NFF, WUP, 0, 1, scr, r, lane); continue; } r -= i4;
        transpose_item(w_dn, 1024, DFF, 0, 1024, WDN, 0, 0, scr, r, lane);
    }
}

__device__ __forceinline__ void ln_row(const float* yrow, const float* g, const float* b, bf16* orow, float* frow, int lane) {
    const f32x4* xr = (const f32x4*)yrow + lane;
    f32x4 v[4]; float s = 0.f;
#pragma unroll
    for (int j = 0; j < 4; ++j) { v[j] = xr[64 * j]; s += (v[j].x + v[j].y) + (v[j].z + v[j].w); }
    const float mean = wave_sum(s) * (1.f / D); float s2 = 0.f;
#pragma unroll
    for (int j = 0; j < 4; ++j) { v[j] = v[j] - mean; s2 += (v[j].x * v[j].x + v[j].y * v[j].y) + (v[j].z * v[j].z + v[j].w * v[j].w); }
    const float rstd = 1.f / sqrtf(wave_sum(s2) * (1.f / D) + LN_EPS);
#pragma unroll
    for (int j = 0; j < 4; ++j) { const f32x4 gg = ((const f32x4*)g)[lane + 64 * j], bb = ((const f32x4*)b)[lane + 64 * j]; const f32x4 o = v[j] * rstd * gg + bb;
        if (orow) { u32x2 w; w.x = cvt_pk_bf16(o.x, o.y); w.y = cvt_pk_bf16(o.z, o.w); ((u32x2*)orow)[lane + 64 * j] = w; }
        if (frow) ((f32x4*)frow)[lane + 64 * j] = o; }
}

__device__ __forceinline__ void hg_prefix(const h16x8 v0, const h16x8 v1, int fr, int fq, float (&g)[2][8], float (&b)[2][8], float& blast) {
    float t0 = 0.f, t1 = 0.f;
#pragma unroll
    for (int j = 0; j < 8; ++j) { g[0][j] = (float)v0[j]; t0 += g[0][j]; b[0][j] = t0; g[1][j] = (float)v1[j]; t1 += g[1][j]; b[1][j] = t1; }
    float off0 = 0.f, off1 = 0.f, sum0 = 0.f, sum1 = 0.f;
#pragma unroll
    for (int q = 0; q < 4; ++q) { const float a0 = __shfl(t0, fr + 16 * q), a1 = __shfl(t1, fr + 16 * q); if (q < fq) { off0 += a0; off1 += a1; } sum0 += a0; sum1 += a1; }
#pragma unroll
    for (int j = 0; j < 8; ++j) { b[0][j] += off0; b[1][j] += sum0 + off1; }
    blast = sum0 + sum1;
}

__device__ __forceinline__ void hg_r1(const Params& p, unsigned char* ws, int wave, int lane) {
    int bid = blockIdx.x, gdim = gridDim.x; asm volatile("" : "+s"(bid), "+s"(gdim));
    const _Float16* GT = (const _Float16*)(ws + WS_GT); const bf16* VT = (const bf16*)(ws + WS_VT); bf16* ST = (bf16*)(ws + WS_ST); float* DEC = (float*)(ws + WS_DEC);
    const int fr = lane & 15, fq = lane >> 4;
    for (int unit = bid; unit < 2048; unit += gdim) {
        const int h = unit >> 8, c = unit & 255, d = 16 * wave + fr;
        float g[2][8], b[2][8], blast;
        const _Float16* grow = GT + (size_t)(h * 128 + d) * M + c * 64;
        const h16x8 gv0 = *(const h16x8*)(grow + 8 * fq), gv1 = *(const h16x8*)(grow + 32 + 8 * fq);
        bf16x8 bfrv[8][2];
#pragma unroll
        for (int nt = 0; nt < 8; ++nt)
#pragma unroll
            for (int ks = 0; ks < 2; ++ks) bfrv[nt][ks] = *(const bf16x8*)(VT + (size_t)(h * 128 + 16 * nt + fr) * M + c * 64 + 32 * ks + 8 * fq);
        hg_prefix(gv0, gv1, fr, fq, g, b, blast);
        bf16x8 afr[2];
#pragma unroll
        for (int ks = 0; ks < 2; ++ks) { float kd[8];
#pragma unroll
            for (int j = 0; j < 8; ++j) {
#if R1_VAR == 1
                kd[j] = (1.0f - __expf(g[ks][j]));
#elif R1_VAR == 2
                kd[j] = __expf(blast - b[ks][j]);
#elif R1_VAR == 3
                kd[j] = 1.0f;
#else
                kd[j] = (1.0f - __expf(g[ks][j])) * __expf(blast - b[ks][j]);
#endif
            }
            afr[ks] = pack8(kd); }
        if (fq == 0) DEC[(h * 256 + c) * 128 + d] = __expf(blast);
#pragma unroll
        for (int nt = 0; nt < 8; ++nt) { f32x4 acc = {0.f, 0.f, 0.f, 0.f};
#pragma unroll
            for (int ks = 0; ks < 2; ++ks) acc = MFMA16(afr[ks], bfrv[nt][ks], acc);
            u32x2 w; w.x = cvt_pk_bf16(acc[0], acc[1]); w.y = cvt_pk_bf16(acc[2], acc[3]);
            *(u32x2*)(ST + ((size_t)(h * 256 + c) * 128 + 16 * nt + fr) * 128 + 16 * wave + 4 * fq) = w; }
    }
}
__device__ __forceinline__ void hg_r2(const Params& p, unsigned char* ws, int tid) {
    int bid = blockIdx.x, gdim = gridDim.x; asm volatile("" : "+s"(bid), "+s"(gdim));
    bf16* ST = (bf16*)(ws + WS_ST); const float* DEC = (const float*)(ws + WS_DEC);
    for (int e = bid * 512 + tid; e < 131072; e += gdim * 512) {
        const int h = e >> 14, r = e & 16383, d = r & 127;
        bf16* sp = ST + (size_t)h * 256 * 16384 + r; const float* dp = DEC + h * 256 * 128 + d;
        float S = 0.f;
#pragma unroll 1
        for (int c = 0; c < 256; c += 32) { unsigned short loc[32]; float dc[32];
#pragma unroll
            for (int i = 0; i < 32; ++i) { loc[i] = sp[(size_t)(c + i) * 16384]; dc[i] = dp[(c + i) * 128]; }
#pragma unroll
            for (int i = 0; i < 32; ++i) { sp[(size_t)(c + i) * 16384] = (bf16)f2bf(S); S = dc[i] * S + bf2f(loc[i]); } }
    }
}
__device__ __forceinline__ void hg_r3(const Params& p, unsigned char* ws, int L, LAS unsigned char* lds, int tid, int wave, int lane) {
    int bid = blockIdx.x, gdim = gridDim.x; asm volatile("" : "+s"(bid), "+s"(gdim));
    const _Float16* GT = (const _Float16*)(ws + WS_GT); const bf16* VT = (const bf16*)(ws + WS_VT); const bf16* ST = (const bf16*)(ws + WS_ST);
    const bf16* Q = (const bf16*)(ws + WS_Q); const bf16* GATE = (const bf16*)(ws + WS_GATE); bf16* OG = (bf16*)(ws + WS_Q);
    const float* norm_g = as_global(p.in[base_of(L) + 1]);
    LAS float* bt = (LAS float*)lds; LAS float* red = bt + 65 * 132;
    const int fr = lane & 15, fq = lane >> 4;
    if (tid < 132) bt[tid] = 0.f;
    const int mt = wave >> 1, nh = wave & 1;
    for (int unit = bid; unit < 2048; unit += gdim) {
        const int h = unit >> 8, c = unit & 255;
        const int t = 16 * mt + fr; const size_t tok = (size_t)c * 64 + t;
        bf16x8 qraw[4], sfrv[4][4];
        { const int d = 16 * wave + fr; float g[2][8], b[2][8], blast;
            const _Float16* grow = GT + (size_t)(h * 128 + d) * M + c * 64;
            const h16x8 gv0 = *(const h16x8*)(grow + 8 * fq), gv1 = *(const h16x8*)(grow + 32 + 8 * fq);
#pragma unroll
            for (int ks = 0; ks < 4; ++ks) qraw[ks] = *(const bf16x8*)(Q + tok * 1024 + h * 128 + 32 * ks + 8 * fq);
#pragma unroll
            for (int n = 0; n < 4; ++n)
#pragma unroll
                for (int ks = 0; ks < 4; ++ks) sfrv[n][ks] = *(const bf16x8*)(ST + ((size_t)(h * 256 + c) * 128 + 16 * (4 * nh + n) + fr) * 128 + 32 * ks + 8 * fq);
            hg_prefix(gv0, gv1, fr, fq, g, b, blast);
#pragma unroll
            for (int ks = 0; ks < 2; ++ks)
#pragma unroll
                for (int j = 0; j < 8; ++j) bt[(32 * ks + 8 * fq + j + 1) * 132 + d] = b[ks][j]; }
        __syncthreads();
        bf16x8 qtil[4], qhat[4]; float Rr[4][8];
#pragma unroll
        for (int ks = 0; ks < 4; ++ks) { float qf[8], bq[8], a[8], a2[8];
            unpack8(qraw[ks], qf);
            const f32x4 b0 = *(const LAS f32x4*)(bt + (t + 1) * 132 + 32 * ks + 8 * fq), b1 = *(const LAS f32x4*)(bt + (t + 1) * 132 + 32 * ks + 8 * fq + 4);
            const f32x4 r0 = *(const LAS f32x4*)(bt + (16 * mt) * 132 + 32 * ks + 8 * fq), r1 = *(const LAS f32x4*)(bt + (16 * mt) * 132 + 32 * ks + 8 * fq + 4);
#pragma unroll
            for (int j = 0; j < 4; ++j) { bq[j] = b0[j]; bq[4 + j] = b1[j]; Rr[ks][j] = r0[j]; Rr[ks][4 + j] = r1[j]; }
#pragma unroll
            for (int j = 0; j < 8; ++j) { a[j] = qf[j] * __expf(bq[j]); a2[j] = qf[j] * __expf(bq[j] - Rr[ks][j]); }
            qtil[ks] = pack8(a); qhat[ks] = pack8(a2); }
        f32x4 o[4];
#pragma unroll
        for (int n = 0; n < 4; ++n) { o[n] = (f32x4){0.f, 0.f, 0.f, 0.f};
#pragma unroll
            for (int ks = 0; ks < 4; ++ks) o[n] = MFMA16(sfrv[n][ks], qtil[ks], o[n]); }
        unsigned pk[4][2];
#pragma unroll
        for (int i = 0; i < 4; ++i) {
            if (i <= mt) { f32x4 sc = {0.f, 0.f, 0.f, 0.f}; const int s = 16 * i + fr;
#pragma unroll
                for (int ks = 0; ks < 4; ++ks) { float kt[8];
                    const f32x4 b0 = *(const LAS f32x4*)(bt + (s + 1) * 132 + 32 * ks + 8 * fq), b1 = *(const LAS f32x4*)(bt + (s + 1) * 132 + 32 * ks + 8 * fq + 4);
                    const f32x4 m0 = *(const LAS f32x4*)(bt + s * 132 + 32 * ks + 8 * fq), m1 = *(const LAS f32x4*)(bt + s * 132 + 32 * ks + 8 * fq + 4);
#pragma unroll
                    for (int j = 0; j < 4; ++j) { kt[j] = (1.0f - __expf(b0[j] - m0[j])) * __expf(Rr[ks][j] - b0[j]); kt[4 + j] = (1.0f - __expf(b1[j] - m1[j])) * __expf(Rr[ks][4 + j] - b1[j]); }
                    sc = MFMA16(pack8(kt), qhat[ks], sc); }
                if (i == mt) {
#pragma unroll
                    for (int j = 0; j < 4; ++j) if (4 * fq + j > fr) sc[j] = 0.f; }
                pk[i][0] = cvt_pk_bf16(sc[0], sc[1]); pk[i][1] = cvt_pk_bf16(sc[2], sc[3]);
            } else { pk[i][0] = 0u; pk[i][1] = 0u; } }
#pragma unroll
        for (int kk = 0; kk < 2; ++kk) if (2 * kk <= mt) {
            u32x4 pw; pw.x = pk[2 * kk][0]; pw.y = pk[2 * kk][1]; pw.z = pk[2 * kk + 1][0]; pw.w = pk[2 * kk + 1][1]; const bf16x8 pf = __builtin_bit_cast(bf16x8, pw);
#pragma unroll
            for (int n = 0; n < 4; ++n) { const bf16* vrow = VT + (size_t)(h * 128 + 16 * (4 * nh + n) + fr) * M + c * 64 + 32 * kk + 4 * fq;
                const u32x2 lo = *(const u32x2*)vrow, hi = *(const u32x2*)(vrow + 16); u32x4 vw; vw.x = lo.x; vw.y = lo.y; vw.z = hi.x; vw.w = hi.y;
                o[n] = MFMA16(__builtin_bit_cast(bf16x8, vw), pf, o[n]); } }
        float ss = 0.f;
#pragma unroll
        for (int n = 0; n < 4; ++n) ss += (o[n][0] * o[n][0] + o[n][1] * o[n][1]) + (o[n][2] * o[n][2] + o[n][3] * o[n][3]);
        ss += __shfl_xor(ss, 16); ss += __shfl_xor(ss, 32);
        if (fq == 0) red[wave * 16 + fr] = ss;
        __syncthreads();
        const float rstd = 1.0f / sqrtf((ss + red[(wave ^ 1) * 16 + fr]) * (1.0f / 128.0f) + RMS_EPS);
#pragma unroll
        for (int n = 0; n < 4; ++n) { const int v0 = h * 128 + 16 * (4 * nh + n) + 4 * fq; const u32x2 gw = *(const u32x2*)(GATE + tok * 1024 + v0); const f32x4 ng = *(const f32x4*)(norm_g + v0);
            u32x2 w; w.x = cvt_pk_bf16(o[n][0] * rstd * ng[0] * bf_lo(gw.x), o[n][1] * rstd * ng[1] * bf_hi(gw.x)); w.y = cvt_pk_bf16(o[n][2] * rstd * ng[2] * bf_lo(gw.y), o[n][3] * rstd * ng[3] * bf_hi(gw.y));
            *(u32x2*)(OG + tok * 1024 + v0) = w; }
    }
    __syncthreads();
}

constexpr int KS_STRIDE = 272, VS_STRIDE = 528, KS_BYTES = 256 * KS_STRIDE, VS_BYTES = 128 * VS_STRIDE, PRE_OFF = KS_BYTES + VS_BYTES;
constexpr float ATT_SC2 = 0.08838834764831845f * 1.4426950408889634f;
__device__ __forceinline__ int list_off(int n) { return 256 * (63 * n - (n * (n - 1)) / 2); }
__device__ __forceinline__ void mb_stage(const bf16* K, const bf16* VT, int h, int n, LAS unsigned char* lds, int tid) {
#pragma unroll
    for (int i = 0; i < 8; ++i) { const int row = (tid >> 4) + 32 * i, ch = tid & 15; *(LAS u32x4*)(lds + row * KS_STRIDE + ch * 16) = *(const u32x4*)(K + (size_t)(256 * n + row) * 1024 + h * 128 + 8 * ch); }
#pragma unroll
    for (int i = 0; i < 8; ++i) { const int row = (tid >> 5) + 16 * i, ch = tid & 31; *(LAS u32x4*)(lds + KS_BYTES + row * VS_STRIDE + ch * 16) = *(const u32x4*)(VT + (size_t)(h * 128 + row) * M + 256 * n + 8 * ch); }
}
__device__ __forceinline__ void attn_group(LAS const unsigned char* lds, const bf16* qrow, bool valid, float ref2, int nkt, bool causal, int qpos, int fr, int fq, f32x4 (&o)[8], float& l) {
    bf16x8 qf[4];
#pragma unroll
    for (int ks = 0; ks < 4; ++ks) qf[ks] = valid ? *(const bf16x8*)(qrow + 32 * ks + 8 * fq) : (bf16x8){0, 0, 0, 0, 0, 0, 0, 0};
    unsigned pk[16][2]; float lsum = 0.f;
#pragma unroll
    for (int kt = 0; kt < 16; ++kt) {
        if (kt < nkt) { f32x4 s = {0.f, 0.f, 0.f, 0.f};
#pragma unroll
            for (int ks = 0; ks < 4; ++ks) { const bf16x8 kf = *(const LAS bf16x8*)(lds + (16 * kt + fr) * KS_STRIDE + (32 * ks + 8 * fq) * 2); s = MFMA16(kf, qf[ks], s); }
            float pv[4];
#pragma unroll
            for (int j = 0; j < 4; ++j) { pv[j] = __builtin_amdgcn_exp2f(s[j] * ATT_SC2 - ref2); if (causal && (16 * kt + 4 * fq + j > qpos)) pv[j] = 0.f; lsum += pv[j]; }
            pk[kt][0] = cvt_pk_bf16(pv[0], pv[1]); pk[kt][1] = cvt_pk_bf16(pv[2], pv[3]);
        } else { pk[kt][0] = 0u; pk[kt][1] = 0u; } }
#pragma unroll
    for (int dt = 0; dt < 8; ++dt) o[dt] = (f32x4){0.f, 0.f, 0.f, 0.f};
#pragma unroll
    for (int kk = 0; kk < 8; ++kk) if (2 * kk < nkt) {
        u32x4 pw; pw.x = pk[2 * kk][0]; pw.y = pk[2 * kk][1]; pw.z = pk[2 * kk + 1][0]; pw.w = pk[2 * kk + 1][1]; const bf16x8 pf = __builtin_bit_cast(bf16x8, pw);
#pragma unroll
        for (int dt = 0; dt < 8; ++dt) { LAS const unsigned char* vp = lds + KS_BYTES + (16 * dt + fr) * VS_STRIDE + (32 * kk + 4 * fq) * 2;
            const u32x2 lo = *(const LAS u32x2*)vp, hi = *(const LAS u32x2*)(vp + 32); u32x4 vw; vw.x = lo.x; vw.y = lo.y; vw.z = hi.x; vw.w = hi.y;
            o[dt] = MFMA16(__builtin_bit_cast(bf16x8, vw), pf, o[dt]); } }
    lsum += __shfl_xor(lsum, 16); lsum += __shfl_xor(lsum, 32); l = lsum;
}
__device__ __forceinline__ void mb_kmean(const Params& p, unsigned char* ws, LAS unsigned char* lds, int tid, int wave, int lane) {
    int bid = blockIdx.x, gdim = gridDim.x; asm volatile("" : "+s"(bid), "+s"(gdim));
    const bf16* K = (const bf16*)(ws + WS_K); float* KMEAN = (float*)(ws + WS_KMEAN); float* KNMAX = (float*)(ws + WS_KNMAX);
    LAS float* part = (LAS float*)lds; LAS float* mx = part + 8 * 128;
    for (int unit = bid; unit < 512; unit += gdim) { const int h = unit >> 6, n = unit & 63;
        float s0 = 0.f, s1 = 0.f, rm = 0.f;
        for (int r = wave; r < 256; r += 8) { const unsigned w = *(const unsigned*)(K + (size_t)(256 * n + r) * 1024 + h * 128 + 2 * lane); const float x0 = bf_lo(w), x1 = bf_hi(w);
            s0 += x0; s1 += x1; rm = fmaxf(rm, wave_sum(x0 * x0 + x1 * x1)); }
        part[wave * 128 + 2 * lane] = s0; part[wave * 128 + 2 * lane + 1] = s1; if (lane == 0) mx[wave] = rm;
        __syncthreads();
        if (tid < 128) { float s = 0.f;
#pragma unroll
            for (int w = 0; w < 8; ++w) s += part[w * 128 + tid];
            KMEAN[(size_t)unit * 128 + tid] = s * (1.0f / 256.0f); }
        if (tid == 0) { float m = 0.f;
#pragma unroll
            for (int w = 0; w < 8; ++w) m = fmaxf(m, mx[w]);
            KNMAX[unit] = m; }
        __syncthreads(); }
}
__device__ __forceinline__ void mb_gate(const Params& p, unsigned char* ws, LAS unsigned char* lds, int tid) {
    int bid = blockIdx.x, gdim = gridDim.x; asm volatile("" : "+s"(bid), "+s"(gdim));
    const bf16* Q = (const bf16*)(ws + WS_Q); const float* KMEAN = (const float*)(ws + WS_KMEAN); const float* KNMAX = (const float*)(ws + WS_KNMAX);
    int* CNT = (int*)(ws + WS_CNT); unsigned short* LIST = (unsigned short*)(ws + WS_LIST); float* QREF = (float*)(ws + WS_QREF);
    LAS float* km = (LAS float*)lds; LAS float* kn = km + 64 * 128;
    for (int item = bid; item < 256; item += gdim) { const int h = item >> 5, s = (item & 31) * 512 + tid, blk = s >> 8;
        __syncthreads();
        for (int i = tid; i < 64 * 128 / 4; i += 512) ((LAS f32x4*)km)[i] = ((const f32x4*)(KMEAN + (size_t)h * 64 * 128))[i];
        if (tid < 64) kn[tid] = KNMAX[h * 64 + tid];
        __syncthreads();
        unsigned qp[64]; float qq = 0.f;
#pragma unroll
        for (int ch = 0; ch < 16; ++ch) { const u32x4 w = *(const u32x4*)(Q + (size_t)s * 1024 + h * 128 + 8 * ch); qp[4 * ch] = w.x; qp[4 * ch + 1] = w.y; qp[4 * ch + 2] = w.z; qp[4 * ch + 3] = w.w; }
#pragma unroll
        for (int i = 0; i < 64; ++i) { const float x0 = bf_lo(qp[i]), x1 = bf_hi(qp[i]); qq += x0 * x0 + x1 * x1; }
        float kmax = 0.f;
#pragma unroll 8
        for (int n = 0; n < 64; ++n) kmax = fmaxf(kmax, kn[n]);
        QREF[(size_t)s * 8 + h] = sqrtf(qq) * sqrtf(kmax) * ATT_SC2;
        float b0 = -3.0e38f, b1 = -3.0e38f, b2 = -3.0e38f; int i0 = 0, i1 = 0, i2 = 0;
#pragma unroll 1
        for (int n = 0; n < blk; ++n) { float d0 = 0.f, d1 = 0.f, d2 = 0.f, d3 = 0.f;
#pragma unroll
            for (int c8 = 0; c8 < 4; ++c8) {
#pragma unroll
                for (int c4 = 8 * c8; c4 < 8 * c8 + 8; ++c4) { const f32x4 k4 = *(const LAS f32x4*)(km + n * 128 + 4 * c4);
                    d0 += bf_lo(qp[2 * c4]) * k4[0]; d1 += bf_hi(qp[2 * c4]) * k4[1]; d2 += bf_lo(qp[2 * c4 + 1]) * k4[2]; d3 += bf_hi(qp[2 * c4 + 1]) * k4[3]; }
                asm volatile("" ::: "memory"); }
            const float v = (d0 + d1) + (d2 + d3);
            if (v > b0) { b2 = b1; i2 = i1; b1 = b0; i1 = i0; b0 = v; i0 = n; } else if (v > b1) { b2 = b1; i2 = i1; b1 = v; i1 = n; } else if (v > b2) { b2 = v; i2 = n; } }
#pragma unroll
        for (int r = 0; r < 3; ++r) { if (r < blk) { const int bi = r == 0 ? i0 : (r == 1 ? i1 : i2);
                const int pos = atomicAdd(&CNT[h * 64 + bi], 1);
                LIST[(size_t)h * LIST_PER_HEAD + list_off(bi) + pos] = (unsigned short)(s | (r << 14)); } }
    }
    __syncthreads();
}
__device__ __forceinline__ void mb_sel(const Params& p, unsigned char* ws, LAS unsigned char* lds, int tid, int wave, int lane) {
    int bid = blockIdx.x, gdim = gridDim.x; asm volatile("" : "+s"(bid), "+s"(gdim));
    const bf16* Q = (const bf16*)(ws + WS_Q); const bf16* K = (const bf16*)(ws + WS_K); const bf16* VT = (const bf16*)(ws + WS_VT);
    const int* CNT = (const int*)(ws + WS_CNT); const unsigned short* LIST = (const unsigned short*)(ws + WS_LIST); const float* QREF = (const float*)(ws + WS_QREF);
    bf16* PART = (bf16*)(ws + WS_PART); float* LPART = (float*)(ws + WS_LPART);
    LAS int* pre = (LAS int*)(lds + PRE_OFF); LAS int* wtot = pre + 520;
    const int fr = lane & 15, fq = lane >> 4;
    { const int tl = (CNT[tid] + 127) >> 7; int x = tl;
#pragma unroll
        for (int o = 1; o < 64; o <<= 1) { const int y = __shfl_up(x, o); if (lane >= o) x += y; }
        if (lane == 63) wtot[wave] = x;
        __syncthreads();
        int add = 0;
#pragma unroll
        for (int w = 0; w < 8; ++w) if (w < wave) add += wtot[w];
        pre[tid + 1] = x + add; if (tid == 0) pre[0] = 0;
        __syncthreads(); }
    const int T = pre[512];
    const int lo = (int)(((long)T * bid) / gdim), hi = (int)(((long)T * (bid + 1)) / gdim);
    int cur = -1;
    for (int it = lo; it < hi; ++it) {
        int a = 0, b = 511;
        while (a < b) { const int mid = (a + b + 1) >> 1; if (pre[mid] <= it) a = mid; else b = mid - 1; }
        const int hn = a, h = hn >> 6, n = hn & 63, tile = it - pre[hn];
        if (hn != cur) { __syncthreads(); mb_stage(K, VT, h, n, lds, tid); __syncthreads(); cur = hn; }
        const int cnt = CNT[hn], e0 = (tile * 8 + wave) * 16;
        if (e0 < cnt) { const int idx = e0 + fr; const bool valid = idx < cnt;
            const unsigned ent = valid ? LIST[(size_t)h * LIST_PER_HEAD + list_off(n) + idx] : 0u; const int s = ent & 0x3fff, slot = ent >> 14;
            f32x4 o[8]; float l;
            attn_group(lds, Q + (size_t)s * 1024 + h * 128, valid, QREF[(size_t)s * 8 + h], 16, false, 0, fr, fq, o, l);
            if (valid) { bf16* pp = PART + ((size_t)slot * M + s) * 1024 + h * 128 + 4 * fq;
#pragma unroll
                for (int dt = 0; dt < 8; ++dt) { u32x2 w; w.x = cvt_pk_bf16(o[dt][0], o[dt][1]); w.y = cvt_pk_bf16(o[dt][2], o[dt][3]); *(u32x2*)(pp + 16 * dt) = w; }
                if (fq == 0) LPART[((size_t)slot * M + s) * 8 + h] = l; } }
    }
    __syncthreads();
}
__device__ __forceinline__ void mb_own(const Params& p, unsigned char* ws, LAS unsigned char* lds, int tid, int wave, int lane) {
    int bid = blockIdx.x, gdim = gridDim.x; asm volatile("" : "+s"(bid), "+s"(gdim));
    const bf16* Q = (const bf16*)(ws + WS_Q); const bf16* K = (const bf16*)(ws + WS_K); const bf16* VT = (const bf16*)(ws + WS_VT);
    const float* QREF = (const float*)(ws + WS_QREF); const bf16* PART = (const bf16*)(ws + WS_PART); const float* LPART = (const float*)(ws + WS_LPART); bf16* OG = (bf16*)(ws + WS_Q);
    const int fr = lane & 15, fq = lane >> 4;
    for (int unit = bid; unit < 512; unit += gdim) { const int h = unit >> 6, b = unit & 63;
        __syncthreads(); mb_stage(K, VT, h, b, lds, tid); __syncthreads();
        const int nsl = b < 3 ? b : 3;
#pragma unroll 1
        for (int gi = 0; gi < 2; ++gi) { const int g = gi ? 15 - wave : wave, s = 256 * b + 16 * g + fr;
            f32x4 o[8]; float l;
            attn_group(lds, Q + (size_t)s * 1024 + h * 128, true, QREF[(size_t)s * 8 + h], g + 1, true, 16 * g + fr, fr, fq, o, l);
            for (int j = 0; j < nsl; ++j) { const bf16* pp = PART + ((size_t)j * M + s) * 1024 + h * 128 + 4 * fq; l += LPART[((size_t)j * M + s) * 8 + h];
#pragma unroll
                for (int dt = 0; dt < 8; ++dt) { const u32x2 w = *(const u32x2*)(pp + 16 * dt); o[dt][0] += bf_lo(w.x); o[dt][1] += bf_hi(w.x); o[dt][2] += bf_lo(w.y); o[dt][3] += bf_hi(w.y); } }
            const float inv = 1.0f / l; bf16* op = OG + (size_t)s * 1024 + h * 128 + 4 * fq;
#pragma unroll
            for (int dt = 0; dt < 8; ++dt) { u32x2 w; w.x = cvt_pk_bf16(o[dt][0] * inv, o[dt][1] * inv); w.y = cvt_pk_bf16(o[dt][2] * inv, o[dt][3] * inv); *(u32x2*)(op + 16 * dt) = w; } }
    }
    __syncthreads();
}
__device__ __forceinline__ void sc_conv(const Params& p, unsigned char* ws, int L, int tid) {
    int bid = blockIdx.x, gdim = gridDim.x; asm volatile("" : "+s"(bid), "+s"(gdim));
    const bf16* PROJ = (const bf16*)(ws + WS_PROJ); bf16* OG = (bf16*)(ws + WS_OGSC); const float* cw = as_global(p.in[base_of(L) + 1]);
    for (int idx = bid * 512 + tid; idx < M * 128; idx += gdim * 512) { const int t = idx >> 7, c = (idx & 127) * 8;
        float accv[8];
#pragma unroll
        for (int j = 0; j < 8; ++j) accv[j] = 0.f;
#pragma unroll
        for (int k = 0; k < 3; ++k) { const int tt = t - 2 + k; if (tt >= 0) { float cgv[8], hv[8]; unpack8(*(const bf16x8*)(PROJ + (size_t)tt * 3072 + 1024 + c), cgv); unpack8(*(const bf16x8*)(PROJ + (size_t)tt * 3072 + 2048 + c), hv);
                const f32x4 w0 = *(const f32x4*)(cw + k * 1024 + c), w1 = *(const f32x4*)(cw + k * 1024 + c + 4);
#pragma unroll
                for (int j = 0; j < 4; ++j) { accv[j] += w0[j] * cgv[j] * hv[j]; accv[4 + j] += w1[j] * cgv[4 + j] * hv[4 + j]; } } }
        float bg[8]; unpack8(*(const bf16x8*)(PROJ + (size_t)t * 3072 + c), bg);
#pragma unroll
        for (int j = 0; j < 8; ++j) accv[j] *= bg[j];
        *(bf16x8*)(OG + (size_t)t * 1024 + c) = pack8(accv); }
}

#define XB_TMO      128
#define XB_XCNT(j)  (256  + 64 * (j))
#define XB_XSUB(j)  (1280 + 64 * (j))
#define XB_XGEN(j)  (2304 + 64 * (j))
#define XB_TOP      3328
#define XB_TOPGEN   3392
#define XCD_BAR_WORDS 3456
#define XB_SPIN_CAP (1u << 18)

__device__ __forceinline__ unsigned xb_ld(unsigned* p)              { return __hip_atomic_load(p, __ATOMIC_RELAXED, __HIP_MEMORY_SCOPE_AGENT); }
__device__ __forceinline__ unsigned xb_add(unsigned* p, unsigned v) { return __hip_atomic_fetch_add(p, v, __ATOMIC_RELAXED, __HIP_MEMORY_SCOPE_AGENT); }
__device__ __forceinline__ unsigned xb_xcc_id() { return (unsigned)__builtin_amdgcn_s_getreg((3 << 11) | 20) & 0xFu; }
#define XB_SPIN(cond, bar) do { unsigned _sp = 0; while (cond) { __builtin_amdgcn_s_sleep(1); \
    if ((++_sp & 255u) == 0u) { if (xb_ld(&(bar)[XB_TMO])) break; if (_sp > XB_SPIN_CAP) { atomicAdd(&(bar)[XB_TMO], 1u); break; } } } } while (0)

struct XcdBarrier {
    unsigned* bar; unsigned x;
    volatile LAS unsigned* st;
};

__device__ __forceinline__ XcdBarrier xcd_barrier_post(unsigned* bar, volatile LAS unsigned* st) {
    XcdBarrier b; b.bar = bar; b.x = xb_xcc_id(); b.st = st;
    if (threadIdx.x == 0) (void)xb_add(&bar[XB_XCNT(b.x)], 1u);
    return b;
}
__device__ __forceinline__ void xcd_barrier_complete(unsigned* bar, unsigned x, unsigned& nloc, unsigned& nx) {
    const unsigned G = gridDim.x * gridDim.y * gridDim.z;
    unsigned sum, cnt, mine, sp = 0u;
    for (;;) {
        sum = 0u; cnt = 0u; mine = 0u;
#pragma unroll
        for (unsigned j = 0; j < 16; ++j) { const unsigned c = xb_ld(&bar[XB_XCNT(j)]); sum += c; cnt += (c > 0u) ? 1u : 0u; mine = (j == x) ? c : mine; }
        if (sum == G) break;
        __builtin_amdgcn_s_sleep(1);
        if ((++sp & 255u) == 0u) { if (xb_ld(&bar[XB_TMO])) break; if (sp > XB_SPIN_CAP) { atomicAdd(&bar[XB_TMO], 1u); break; } }
    }
    nloc = mine > 0u ? mine : 1u; nx = cnt > 0u ? cnt : 1u;
}

__device__ __forceinline__ void xcd_barrier(const XcdBarrier& b) {
    asm volatile("s_waitcnt vmcnt(0)" ::: "memory");
    __syncthreads();
    if (threadIdx.x == 0) {
        unsigned* bar = b.bar;
        __builtin_amdgcn_s_waitcnt(0);
        unsigned nloc = b.st[0], nx = b.st[1];
        if (nloc == 0u) { xcd_barrier_complete(bar, b.x, nloc, nx); b.st[0] = nloc; b.st[1] = nx; }
        const unsigned old = xb_add(&bar[XB_XSUB(b.x)], 1u);
        const unsigned gen = old / nloc;
        if (old + 1u == (gen + 1u) * nloc) {
            __builtin_amdgcn_fence(__ATOMIC_RELEASE, "agent");
            asm volatile("s_waitcnt vmcnt(0)" ::: "memory");
            const unsigned og = xb_add(&bar[XB_TOP], 1u);
            const unsigned tg = og / nx;
            if (og + 1u == (tg + 1u) * nx) xb_add(&bar[XB_TOPGEN], 1u);
            else XB_SPIN(xb_ld(&bar[XB_TOPGEN]) == tg, bar);
            __builtin_amdgcn_fence(__ATOMIC_ACQUIRE, "agent");
            xb_add(&bar[XB_XGEN(b.x)], 1u);
            asm volatile("s_waitcnt vmcnt(0)" ::: "memory");
        } else {
            XB_SPIN(xb_ld(&bar[XB_XGEN(b.x)]) == gen, bar);
            __builtin_amdgcn_fence(__ATOMIC_ACQUIRE, "agent");
            asm volatile("s_waitcnt vmcnt(0)" ::: "memory");
        }
    }
    __syncthreads();
}


__global__ void __launch_bounds__(512, 2) mk_fwd(Params p) {
    extern __shared__ __attribute__((aligned(16))) unsigned char lds_raw[];
    LAS unsigned char* lds = (LAS unsigned char*)lds_raw;
    const int G = gridDim.x;
    if (threadIdx.x < 4) ((LAS unsigned*)(lds + LDS_BARST))[threadIdx.x] = 0u;
    __syncthreads();
    if (p.hi - p.lo > 1) (void)xcd_barrier_post((unsigned*)(as_global(p.ws) + WS_BAR), (volatile LAS unsigned*)(lds + LDS_BARST));
#define GRID_BAR() do { size_t zb = 0; asm volatile("" : "+s"(zb)); unsigned char* wsb = p.ws + zb; XcdBarrier xb_; xb_.bar = (unsigned*)(wsb + WS_BAR); xb_.x = xb_xcc_id(); xb_.st = (volatile LAS unsigned*)(lds + LDS_BARST); xcd_barrier(xb_); } while (0)
#define FRESH() size_t zo = 0; int zero = 0; int tid = threadIdx.x; int bid = blockIdx.x, gdim = gridDim.x; asm volatile("" : "+s"(zo), "+s"(zero), "+v"(tid), "+s"(bid), "+s"(gdim)); \
        unsigned char* ws = p.ws + zo; float* Y = p.out + zo; \
        const int lane = tid & 63, wave = __builtin_amdgcn_readfirstlane(tid >> 6), gw = bid * 8 + wave, NGW = gdim * 8; bf16* XB = (bf16*)(ws + WS_XB); (void)lane; (void)gw; (void)NGW; (void)XB; (void)Y; (void)zero;
    for (int pi = p.lo; pi < p.hi; ++pi) {
        const int pw = __builtin_amdgcn_readfirstlane((int)p.prog[pi]); const int op = pw & 31, L = pw >> 5;
        if (op == OP_PRO) { FRESH();
            const float* x = as_global(p.in[zero]);
            for (size_t i = (size_t)bid * 512 + tid; i < (size_t)M * D / 8; i += (size_t)gdim * 512) { const f32x4 a = ((const f32x4*)x)[2 * i], b = ((const f32x4*)x)[2 * i + 1];
                u32x4 w; w.x = cvt_pk_bf16(a.x, a.y); w.y = cvt_pk_bf16(a.z, a.w); w.z = cvt_pk_bf16(b.x, b.y); w.w = cvt_pk_bf16(b.z, b.w); ((u32x4*)XB)[i] = w; }
            if (bid == 0 && tid == 0) *(unsigned*)(ws + 3 * 1024) = 0u;
            if (bid == 0) { const float* lbp = as_global(p.in[2 + zero]); float* LB = (float*)(ws + WS_LBTAB);
                for (int c = tid; c < 1024; c += 512) { const float a0 = lbp[c], a1 = lbp[1024 + c], a2 = lbp[2048 + c], a3 = lbp[3072 + c]; const float mx = fmaxf(fmaxf(a0, a1), fmaxf(a2, a3));
                    const float e0 = __expf(a0 - mx), e1 = __expf(a1 - mx), e2 = __expf(a2 - mx), e3 = __expf(a3 - mx); const float inv = 1.0f / (e0 + e1 + e2 + e3);
                    LB[c] = 0.f; LB[1024 + c] = (e1 + e2 + e3) * inv; } }
            convert_weights(p, ws, 0, lds, gw, NGW, wave, lane);
        } else if (op == OP_HG_IN || op == OP_MB_IN || op == OP_SC_IN || op == OP_OUT || op == OP_UP || op == OP_DOWN) {
            FRESH(); const int nsub = (op == OP_HG_IN || op == OP_MB_IN) ? 2 : 1;
            if (op == OP_MB_IN && bid == 0) ((int*)(ws + WS_CNT))[tid] = 0;
            for (int subx = 0; subx < nsub * (1 + DUP_GEMM); ++subx) { const int sub = subx % nsub;
                pg8::Gemm g; pg8::Epi E; int nM, nN; g.M = M; g.amode = 0; E.aux = nullptr; E.pos = nullptr; E.O1 = nullptr; E.ldc = 1024;
                bf16* WIN = (bf16*)(ws + WS_WIN);
                if (op == OP_HG_IN) {
                    if (sub == 0) { g.A = XB; g.Bt = WIN; g.N = 2048; g.K = 1024; nM = 64; nN = 8; E.mode = pg8::EPI_SILU_SPLIT; E.O0 = ws + WS_Q; E.O1 = ws + WS_GATE; }
                    else { g.A = WIN + (size_t)2048 * 1024; g.Bt = XB; g.N = M; g.K = 1024; nM = 8; nN = 64; E.mode = pg8::EPI_T_HGRN; E.O0 = ws + WS_GT; E.O1 = ws + WS_VT; E.aux = (const float*)(ws + WS_LBTAB) + (L == 0 ? 0 : 1024); }
                } else if (op == OP_MB_IN) {
                    if (sub == 0) { g.A = XB; g.Bt = WIN; g.N = 2048; g.K = 1024; nM = 64; nN = 8; E.mode = pg8::EPI_ROPE_SPLIT; E.O0 = ws + WS_Q; E.O1 = ws + WS_K; E.pos = (const int*)as_global(p.in[1 + zero]); }
                    else { g.A = WIN + (size_t)2048 * 1024; g.Bt = XB; g.N = M; g.K = 1024; nM = 4; nN = 64; E.mode = pg8::EPI_T_PLAIN; E.O0 = ws + WS_VT; }
                } else if (op == OP_SC_IN) { g.A = XB; g.Bt = WIN; g.N = 3072; g.K = 1024; nM = 64; nN = 12; E.mode = pg8::EPI_PLAIN; E.O0 = ws + WS_PROJ; E.ldc = 3072;
                } else if (op == OP_OUT) { g.A = (const bf16*)(ws + (kind_of(L) == 2 ? WS_OGSC : WS_Q)); g.Bt = (const bf16*)(ws + WS_WOUT); g.N = 1024; g.K = 1024; nM = 64; nN = 4; E.mode = pg8::EPI_RES; E.O0 = Y; E.O1 = XB;
                } else if (op == OP_UP) { g.A = XB - (size_t)2 * 1024; g.Bt = (const bf16*)(ws + WS_WUP); g.N = NFF; g.K = 1024; g.amode = 1; nM = 67; nN = 22; E.mode = pg8::EPI_UPCONV; E.O0 = ws + WS_H; E.aux = as_global(p.in[wout_of(L) + 4]);
                } else { g.A = (const bf16*)(ws + WS_H); g.Bt = (const bf16*)(ws + WS_WDN); g.N = 1024; g.K = DFF; nM = 64; nN = 4; E.mode = pg8::EPI_RES; E.O0 = Y; E.O1 = XB; }
                pg8::StaticOrder S; S.init(nM, nN, gdim, bid);
                pg8::gemm_phase<pg8::Epi, pg8::StaticOrder, true, true>(lds, g, S, E);
            }
        } else if (op == OP_HG_R1) { FRESH(); hg_r1(p, ws, wave, lane);
        } else if (op == OP_HG_R2) { FRESH(); hg_r2(p, ws, tid);
        } else if (op == OP_HG_R3) { FRESH(); hg_r3(p, ws, L, lds, tid, wave, lane);
        } else if (op == OP_MB_KMEAN) { FRESH(); mb_kmean(p, ws, lds, tid, wave, lane);
        } else if (op == OP_MB_GATE) { FRESH(); mb_gate(p, ws, lds, tid);
        } else if (op == OP_MB_SEL) { FRESH(); mb_sel(p, ws, lds, tid, wave, lane);
        } else if (op == OP_MB_OWN) { FRESH(); mb_own(p, ws, lds, tid, wave, lane);
        } else if (op == OP_SC_CONV) { FRESH(); sc_conv(p, ws, L, tid);
        } else if (op == OP_LN1 || op == OP_LN2) { FRESH();
            const int wo = wout_of(L); const float* gg = as_global(p.in[wo + (op == OP_LN1 ? 1 : 6)]); const float* bb = as_global(p.in[wo + (op == OP_LN1 ? 2 : 7)]);
            const bool fin = (op == OP_LN2 && L == 3);
            for (int r = gw; r < M; r += NGW) ln_row(Y + (size_t)r * D, gg, bb, fin ? nullptr : XB + (size_t)r * D, fin ? Y + (size_t)r * D : nullptr, lane);
            if (op == OP_LN2 && L < 3) convert_weights(p, ws, L + 1, lds, gw, NGW, wave, lane);
        }
        else if (op == OP_CONVW) { FRESH(); convert_weights(p, ws, L, lds, gw, NGW, wave, lane); }
        else if (op == OP_DIAG1) { FRESH(); const unsigned short* R = (const unsigned short*)(ws + DIAG_OFF); unsigned bad = 0;
            for (size_t i = (size_t)bid * 512 + tid; i < (size_t)DIAG_ELEMS; i += (size_t)gdim * 512) { const unsigned short v = R[i]; if ((v & 0x7f80u) == 0x7f80u) bad = 1; }
            if (bad) atomicOr((unsigned*)(ws + 3 * 1024), 1u); }
        else if (op == OP_DIAG2) { FRESH(); const float A = (*(const unsigned*)(ws + 3 * 1024)) ? 3.0f : 0.0f; for (size_t i = (size_t)bid * 512 + tid; i < (size_t)M * D; i += (size_t)gdim * 512) Y[i] = A; }
        else if (op == OP_DUMP) { FRESH(); for (size_t i = (size_t)bid * 512 + tid; i < (size_t)M * D; i += (size_t)gdim * 512) Y[i] = bf2f(XB[i]); }
        if (pi + 1 < p.hi) {
            if (p.nprog < 0) cg::this_grid().sync();
            GRID_BAR();
#if DUP_SYNC
            GRID_BAR();
#endif
        }
    }
}

extern "C" void kernel_launch(void* const* d_in, const int* in_sizes, int n_in, void* d_out, int out_size, void* d_ws, size_t ws_size, hipStream_t stream) {
    static int grid = 0;
    if (grid == 0) {
        if (n_in != 42 || out_size != M * D || ws_size < WS_NEED) { fprintf(stderr, "kernel_launch: unexpected shapes (n_in %d out %d ws %zu need %zu)\n", n_in, out_size, ws_size, (size_t)WS_NEED); grid = -1; return; }
        int dev = 0, cus = 0, per_cu = 0;
        hipGetDevice(&dev); hipDeviceGetAttribute(&cus, hipDeviceAttributeMultiprocessorCount, dev);
        hipFuncSetAttribute((const void*)mk_fwd, hipFuncAttributeMaxDynamicSharedMemorySize, LDS_BYTES);
        hipOccupancyMaxActiveBlocksPerMultiprocessor(&per_cu, (const void*)mk_fwd, 512, LDS_BYTES);
        (void)hipGetLastError();
        if (per_cu < 1) per_cu = 1;
        grid = cus * 1;
        if (grid > 256) grid = 256;
    }
    if (grid < 0) return;
    Params p{};
    for (int i = 0; i < 42; ++i) p.in[i] = (const float*)d_in[i];
    p.out = (float*)d_out; p.ws = (unsigned char*)d_ws;
    int n = 0;
    p.prog[n++] = OP_PRO;
#ifndef DBG_MIX
#define DBG_MIX 15
#endif
#ifndef DBG_FFN
#define DBG_FFN 15
#endif
    bool have_w = true, out_done = false;
    for (int L = 0; L < 4; ++L) { const int k = L % 3; const unsigned char lb = (unsigned char)(L << 5);
        const bool mix = (DBG_MIX >> L) & 1, ffn = (DBG_FFN >> L) & 1;
        if (!have_w && (mix || ffn)) { p.prog[n++] = lb | OP_CONVW; have_w = true; }
        if (mix) {
            if (k == 0) { p.prog[n++] = lb | OP_HG_IN;
#ifndef DBG_SKIPR
#define DBG_SKIPR 0
#endif
                if (!(DBG_SKIPR & 1)) p.prog[n++] = lb | OP_HG_R1;
#ifdef DBG_DIAG_AFTER_R1
                p.prog[n++] = OP_DIAG1; p.prog[n++] = OP_DIAG2; goto prog_done;
#endif
 if (!(DBG_SKIPR & 2)) p.prog[n++] = lb | OP_HG_R2; if (!(DBG_SKIPR & 4)) p.prog[n++] = lb | OP_HG_R3; }
            else if (k == 1) { p.prog[n++] = lb | OP_MB_IN; p.prog[n++] = lb | OP_MB_KMEAN; p.prog[n++] = lb | OP_MB_GATE; p.prog[n++] = lb | OP_MB_SEL; p.prog[n++] = lb | OP_MB_OWN; }
            else { p.prog[n++] = lb | OP_SC_IN; p.prog[n++] = lb | OP_SC_CONV; }
            p.prog[n++] = lb | OP_OUT; p.prog[n++] = lb | OP_LN1; }
        if (ffn) { p.prog[n++] = lb | OP_UP; p.prog[n++] = lb | OP_DOWN; p.prog[n++] = lb | OP_LN2; out_done = (L == 3); }
        else have_w = false; }
    if (!out_done) p.prog[n++] = OP_DUMP;
prog_done:
    p.nprog = n;
#if ONE_LAUNCH
    p.lo = 0; p.hi = n;
    if (hipMemsetAsync((char*)d_ws + WS_BAR, 0, BAR_ZERO_BYTES, stream) != hipSuccess) { fprintf(stderr, "memset of barrier words failed\n"); return; }
    void* args[] = {&p};
    hipError_t e = hipLaunchCooperativeKernel((const void*)mk_fwd, dim3(grid), dim3(512), args, LDS_BYTES, stream);
    if (e != hipSuccess) fprintf(stderr, "cooperative launch failed: %s (grid %d)\n", hipGetErrorString(e), grid);
#else
    for (int i = 0; i < n; ++i) { p.lo = i; p.hi = i + 1; hipLaunchKernelGGL(mk_fwd, dim3(grid), dim3(512), LDS_BYTES, stream, p); }
#endif
}
```

```cpp
#include <hip/hip_runtime.h>
#include <hip/hip_cooperative_groups.h>
#include <cstdio>
#include <cstdint>
namespace cg = cooperative_groups;

#ifndef ONE_LAUNCH
#define ONE_LAUNCH 1
#endif
#define DBG_SKIPR 0
#define R1_VAR 0
#ifndef DUP_SYNC
#define DUP_SYNC 0
#endif
#ifndef DUP_GEMM
#define DUP_GEMM 0
#endif

namespace pg8 {
#define PG8_LAS __attribute__((address_space(3)))
typedef unsigned short bf16_t;
typedef short bf16x8 __attribute__((ext_vector_type(8)));
typedef float f32x4 __attribute__((ext_vector_type(4)));
typedef unsigned u32x4 __attribute__((ext_vector_type(4)));
constexpr int BM = 256, BK = 64, HALF = 128, HTB = HALF * BK * 2  , STAGE_BYTES = 8 * HTB, NXCD = 8, WGM = 8;

__host__ __device__ __forceinline__ int lds_byte(int r, int c) { const int st = (r >> 4) * 2 + (c >> 5), rr = r & 15, cc = c & 31, ob = rr * 64 + cc * 2; return st * 1024 + (ob ^ (((ob >> 9) & 1) << 5)); }
__host__ __device__ __forceinline__ void stage_rc(int b, int& R, int& C) { const int st = b / 1024, sb = b % 1024, swz = sb ^ (((sb >> 9) & 1) << 5); R = (st >> 1) * 16 + swz / 64; C = (st & 1) * 32 + (swz % 64) / 2; }
__host__ __device__ __forceinline__ int perm32(int rho) { const int n = rho >> 4, i = rho & 15; return 8 * (i >> 2) + 4 * n + (i & 3); }

struct Unit { int pm, pn; };
struct Gemm { const bf16_t* A; const bf16_t* Bt; int M, N, K, amode; };

typedef float f32x2_t __attribute__((ext_vector_type(2))); typedef __bf16 bf16x2_t __attribute__((ext_vector_type(2)));
__device__ __forceinline__ unsigned cvt_pk_bf16(float lo, float hi) { f32x2_t v = {lo, hi}; bf16x2_t b = __builtin_convertvector(v, bf16x2_t); return __builtin_bit_cast(unsigned, b); }

struct StaticOrder {
    int nM, nN, nwg, G, c;
    __host__ __device__ void init(int nM_, int nN_, int G_, int c_) { nM = nM_; nN = nN_; nwg = nM * nN; G = G_; c = c_; }
    __host__ __device__ bool next(int i, Unit& u) const {
        const long L = (long)i * G + c; if (L >= nwg) return false;
        int wgid = (int)L; { const int q = nwg / NXCD, r = nwg % NXCD, xcd = wgid % NXCD, off = wgid / NXCD; wgid = (xcd < r ? xcd * (q + 1) : r * (q + 1) + (xcd - r) * q) + off; }
        const int nig = WGM * nN, gid = wgid / nig, fm = gid * WGM, gsz = (nM - fm) < WGM ? (nM - fm) : WGM;
        u.pm = fm + ((wgid % nig) % gsz); u.pn = (wgid % nig) / gsz; return true;
    }
    __device__ __forceinline__ void a_ready(const Unit&) const {}
    __device__ __forceinline__ void done(const Unit&) const {}
};

typedef unsigned u32x2 __attribute__((ext_vector_type(2)));
typedef _Float16 h16x4 __attribute__((ext_vector_type(4)));
__device__ __forceinline__ float bf_lo(unsigned w) { return __uint_as_float(w << 16); }
__device__ __forceinline__ float bf_hi(unsigned w) { return __uint_as_float(w & 0xffff0000u); }
__device__ __forceinline__ float silu_f(float x) { return x * __builtin_amdgcn_rcpf(1.0f + __builtin_amdgcn_exp2f(-1.4426950408889634f * x)); }
__device__ __forceinline__ float ror1(float x) { return __int_as_float(__builtin_amdgcn_update_dpp(0, __float_as_int(x), 0x121, 0xF, 0xF, false)); }
__device__ __forceinline__ float ror2(float x) { return __int_as_float(__builtin_amdgcn_update_dpp(0, __float_as_int(x), 0x122, 0xF, 0xF, false)); }
__device__ const double ROPE_F[16] = {0.15915494309189535, 0.070086521587798503, 0.03086376340470123, 0.013591370636193905, 0.0059851857127137054, 0.002635675898667414, 0.001160663641240061, 0.00051111750453754386,
    0.00022507907903927653, 9.9117309369019355e-05, 4.3647952792802891e-05, 1.9221100684944863e-05, 8.4643308082414014e-06, 3.7274086019153519e-06, 1.6414262627950345e-06, 7.2282930688328648e-07};
constexpr int TOK = 16384;
constexpr float DN_ALPHA = 1.6817928305074290f;
enum { EPI_SILU_SPLIT = 0, EPI_PLAIN = 1, EPI_ROPE_SPLIT = 2, EPI_T_HGRN = 3, EPI_T_PLAIN = 4, EPI_RES = 5, EPI_UPCONV = 6 };
struct Epi {
    static constexpr bool PERM = false, AFTER_DRAIN = false;
    int mode, ldc; void* O0; void* O1; const float* aux; const int* pos;
    __device__ __forceinline__ void st4(bf16_t* p, f32x4 v) const { u32x2 w; w.x = cvt_pk_bf16(v[0], v[1]); w.y = cvt_pk_bf16(v[2], v[3]); *(u32x2*)p = w; }
    __device__ __forceinline__ void operator()(const f32x4 (&acc)[2][2][4][2], const Unit& u, int wr, int wc, int fr, int fq) const {
        const int row0 = u.pm * BM + wr * 64 + fr, col0 = u.pn * BM + wc * 32 + 4 * fq;
        if (mode == EPI_RES) {
            float* Y = (float*)O0; const bf16_t* XB = (const bf16_t*)O1;
#pragma unroll
            for (int ai = 0; ai < 2; ++ai)
#pragma unroll
                for (int m = 0; m < 4; ++m) { const size_t ro = (size_t)(row0 + ai * HALF + m * 16) * 1024 + col0;
#pragma unroll
                    for (int bj = 0; bj < 2; ++bj)
#pragma unroll
                        for (int n = 0; n < 2; ++n) { const size_t o = ro + bj * HALF + n * 16; const u32x2 xw = *(const u32x2*)(XB + o);
                            f32x4 r; r[0] = DN_ALPHA * bf_lo(xw.x) + acc[ai][bj][m][n][0]; r[1] = DN_ALPHA * bf_hi(xw.x) + acc[ai][bj][m][n][1];
                            r[2] = DN_ALPHA * bf_lo(xw.y) + acc[ai][bj][m][n][2]; r[3] = DN_ALPHA * bf_hi(xw.y) + acc[ai][bj][m][n][3];
                            *(f32x4*)(Y + o) = r; } }
        } else if (mode == EPI_UPCONV) {
            bf16_t* H = (bf16_t*)O0; const float* cw = aux;
            const int cbase = 128 * u.pn + 32 * wc + 4 * fq;
#pragma unroll
            for (int n = 0; n < 2; ++n) {
                const f32x4 wa0 = *(const f32x4*)(cw + cbase + 16 * n), wa1 = *(const f32x4*)(cw + 5632 + cbase + 16 * n), wa2 = *(const f32x4*)(cw + 2 * 5632 + cbase + 16 * n);
                const f32x4 wb0 = *(const f32x4*)(cw + 2816 + cbase + 16 * n), wb1 = *(const f32x4*)(cw + 5632 + 2816 + cbase + 16 * n), wb2 = *(const f32x4*)(cw + 2 * 5632 + 2816 + cbase + 16 * n);
#pragma unroll
                for (int ai = 0; ai < 2; ++ai) { const int tok0 = 248 * u.pm + 62 * (2 * ai + wr) - 2;
                    f32x4 pa1 = {0.f, 0.f, 0.f, 0.f}, pa2 = pa1, pb1 = pa1, pb2 = pa1;
#pragma unroll
                    for (int m = 0; m < 4; ++m) { const int rho = 16 * m + fr, tok = tok0 + rho;
                        const f32x4 za = acc[ai][0][m][n], zb = acc[ai][1][m][n]; f32x4 ra1, ra2, rb1, rb2, hv;
#pragma unroll
                        for (int e = 0; e < 4; ++e) { ra1[e] = ror1(za[e]); ra2[e] = ror2(za[e]); rb1[e] = ror1(zb[e]); rb2[e] = ror2(zb[e]); }
#pragma unroll
                        for (int e = 0; e < 4; ++e) {
                            float a1 = fr == 0 ? pa1[e] : ra1[e], a2 = fr < 2 ? pa2[e] : ra2[e], b1 = fr == 0 ? pb1[e] : rb1[e], b2 = fr < 2 ? pb2[e] : rb2[e];
                            if (tok < 1) { a1 = 0.f; b1 = 0.f; } if (tok < 2) { a2 = 0.f; b2 = 0.f; }
                            const float ua = wa2[e] * za[e] + wa1[e] * a1 + wa0[e] * a2, ub = wb2[e] * zb[e] + wb1[e] * b1 + wb0[e] * b2;
                            hv[e] = silu_f(ua) * ub; }
                        if (rho >= 2 && tok < TOK) st4(H + (size_t)tok * 2816 + cbase + 16 * n, hv);
                        pa1 = ra1; pa2 = ra2; pb1 = rb1; pb2 = rb2; }
                    asm volatile("" ::: "memory"); } }
        } else if (mode == EPI_T_HGRN || mode == EPI_T_PLAIN) {
            const bool isg = (mode == EPI_T_HGRN) && (u.pm < 4);
            bf16_t* base = (mode == EPI_T_HGRN && u.pm >= 4) ? (bf16_t*)O1 - (size_t)1024 * TOK : (bf16_t*)O0;
#pragma unroll
            for (int ai = 0; ai < 2; ++ai)
#pragma unroll
                for (int m = 0; m < 4; ++m) { const int r = row0 + ai * HALF + m * 16; const size_t ro = (size_t)r * TOK + col0; const float lb = isg ? aux[r] : 0.f;
#pragma unroll
                    for (int bj = 0; bj < 2; ++bj)
#pragma unroll
                        for (int n = 0; n < 2; ++n) { const f32x4 v = acc[ai][bj][m][n]; bf16_t* p = base + ro + bj * HALF + n * 16;
                            if (isg) { h16x4 hg;
#pragma unroll
                                for (int e = 0; e < 4; ++e) { const float sg = __builtin_amdgcn_rcpf(1.0f + __expf(-v[e])); hg[e] = (_Float16)__logf(lb + (1.0f - lb) * sg); }
                                *(h16x4*)p = hg; }
                            else st4(p, v); } }
        } else {
            int colt = u.pn * BM; bf16_t* base = (bf16_t*)O0;
            if (mode != EPI_PLAIN) { if (colt >= 1024) { base = (bf16_t*)O1; colt -= 1024; } }
            const int c0 = colt + wc * 32 + 4 * fq;
            double rf[4];
#pragma unroll
            for (int e = 0; e < 4; ++e) rf[e] = ROPE_F[4 * fq + e];
#pragma unroll
            for (int ai = 0; ai < 2; ++ai)
#pragma unroll
                for (int m = 0; m < 4; ++m) { const int r = row0 + ai * HALF + m * 16; bf16_t* rowp = base + (size_t)r * ldc + c0;
                    float cs[4], sn[4];
                    if (mode == EPI_ROPE_SPLIT && wc == 0) { const double pp = (double)pos[r];
#pragma unroll
                        for (int e = 0; e < 4; ++e) { double tt = pp * rf[e]; tt -= __builtin_floor(tt); const float tf = (float)tt; sn[e] = __builtin_amdgcn_sinf(tf); cs[e] = __builtin_amdgcn_cosf(tf); } }
#pragma unroll
                    for (int bj = 0; bj < 2; ++bj) { f32x4 v0 = acc[ai][bj][m][0], v1 = acc[ai][bj][m][1];
                        if (mode == EPI_SILU_SPLIT) {
#pragma unroll
                            for (int e = 0; e < 4; ++e) { v0[e] = silu_f(v0[e]); v1[e] = silu_f(v1[e]); } }
                        if (mode == EPI_ROPE_SPLIT && wc == 0) {
#pragma unroll
                            for (int e = 0; e < 4; ++e) { const float x1 = v0[e], x2 = v1[e]; v0[e] = x1 * cs[e] - x2 * sn[e]; v1[e] = x2 * cs[e] + x1 * sn[e]; } }
                        st4(rowp + bj * HALF, v0); st4(rowp + bj * HALF + 16, v1); } }
        }
    }
};

template <class Epi, class Sched, bool ALIGN_EPI = false, bool SP2 = false>
__device__ __forceinline__ void gemm_phase(PG8_LAS unsigned char* lds, const Gemm g, const Sched& S, const Epi& E) {
    int tid = threadIdx.x; asm volatile("" : "+v"(tid));
    const int wid = __builtin_amdgcn_readfirstlane(tid >> 6), lane = tid & 63, wr = wid >> 2, wc = wid & 3, fr = lane & 15, fq = lane >> 4;
    const int K = g.K, nt = K / BK;
    unsigned voffA[2], voffB[2];
#pragma unroll
    for (int i = 0; i < 2; ++i) { int R, C; stage_rc(tid * 16 + i * 8192, R, C); const int Rb = Epi::PERM ? ((R & ~31) + perm32(R & 31)) : R;
        voffA[i] = (unsigned)((g.amode ? (R - 2 * (R >> 6)) : R) * K + C) * 2u; voffB[i] = (unsigned)(Rb * K + C) * 2u; }
    const size_t kstep = (size_t)(BK * 2);
    const size_t hstep = (size_t)HALF * K * 2;
    const size_t tstep = 2 * hstep;  const size_t hstepA = g.amode ? (size_t)124 * K * 2 : hstep, tstepA = 2 * hstepA;
    const unsigned ldsw = (unsigned)wid * 1024u;
    const int aoff = lds_byte(wr * 64 + fr, fq * 8), boff = lds_byte(wc * 32 + fr, fq * 8);
#define PG8_SA(b, h) (((b) * 2 + (h)) * HTB)
#define PG8_SB(b, h) ((4 + (b) * 2 + (h)) * HTB)
#define PG8_STAGE(bufoff, gbase, voff) do { _Pragma("unroll") for (int _i = 0; _i < 2; ++_i) \
        __builtin_amdgcn_global_load_lds((const unsigned*)((const char*)(gbase) + (voff)[_i]), (PG8_LAS unsigned*)(lds + (bufoff) + ldsw + _i * 8192), 16, 0, 0); } while (0)
#define PG8_LDA(dst, b, h) do { _Pragma("unroll") for (int m = 0; m < 4; ++m) _Pragma("unroll") for (int k = 0; k < 2; ++k) dst[m][k] = *(const PG8_LAS bf16x8*)(lds + PG8_SA(b, h) + aoff + m * 2048 + k * 1024); } while (0)
#define PG8_LDB(dst, b, h) do { _Pragma("unroll") for (int n = 0; n < 2; ++n) _Pragma("unroll") for (int k = 0; k < 2; ++k) dst[n][k] = *(const PG8_LAS bf16x8*)(lds + PG8_SB(b, h) + boff + n * 2048 + k * 1024); } while (0)
#define PG8_MMA(ai, bj, At, Bt) do { __builtin_amdgcn_s_setprio(1); _Pragma("unroll") for (int m = 0; m < 4; ++m) _Pragma("unroll") for (int n = 0; n < 2; ++n) _Pragma("unroll") for (int k = 0; k < 2; ++k) \
        acc[ai][bj][m][n] = __builtin_amdgcn_mfma_f32_16x16x32_bf16(Bt[n][k], At[m][k], acc[ai][bj][m][n], 0, 0, 0); __builtin_amdgcn_s_setprio(0); } while (0)
#define PG8_WAIT_V(n) asm volatile("s_waitcnt vmcnt(" #n ")" ::: "memory")
#define PG8_WAIT_L(n) asm volatile("s_waitcnt lgkmcnt(" #n ")" ::: "memory")
#define PG8_BAR __builtin_amdgcn_s_barrier()
#define PG8_SCHED __builtin_amdgcn_sched_barrier(0)
    Unit cur, nxt; int ui = 0;
    if (!S.next(0, cur)) return;
    f32x4 acc[2][2][4][2];
#pragma unroll
    for (int a = 0; a < 2; ++a)
#pragma unroll
        for (int b = 0; b < 2; ++b)
#pragma unroll
            for (int m = 0; m < 4; ++m)
#pragma unroll
                for (int n = 0; n < 2; ++n) acc[a][b][m][n] = (f32x4){0.f, 0.f, 0.f, 0.f};
    bf16x8 At[4][2], B0[2][2], B1[2][2];
    const char* cA = (const char*)g.A + (size_t)cur.pm * tstepA; const char* cB = (const char*)g.Bt + (size_t)cur.pn * tstep;
    S.a_ready(cur);
    if constexpr (SP2) {
        PG8_STAGE(PG8_SB(0, 0), cB, voffB); PG8_STAGE(PG8_SB(0, 1), cB + hstep, voffB); PG8_STAGE(PG8_SA(0, 0), cA, voffA); PG8_STAGE(PG8_SA(0, 1), cA + hstepA, voffA);
        if (wr == 1) PG8_BAR;
        PG8_WAIT_V(2); PG8_BAR;
        PG8_STAGE(PG8_SB(1, 0), cB + kstep, voffB); PG8_STAGE(PG8_SA(1, 0), cA + kstep, voffA); PG8_STAGE(PG8_SB(1, 1), cB + hstep + kstep, voffB);
        PG8_WAIT_V(6); PG8_BAR;
    } else {
        PG8_STAGE(PG8_SB(0, 0), cB, voffB); PG8_STAGE(PG8_SA(0, 0), cA, voffA); PG8_STAGE(PG8_SB(0, 1), cB + hstep, voffB); PG8_STAGE(PG8_SA(0, 1), cA + hstepA, voffA);
        if (wr == 1) PG8_BAR;
        PG8_WAIT_V(4); PG8_BAR;
        PG8_STAGE(PG8_SB(1, 0), cB + kstep, voffB); PG8_STAGE(PG8_SA(1, 0), cA + kstep, voffA); PG8_STAGE(PG8_SB(1, 1), cB + hstep + kstep, voffB);
        PG8_WAIT_V(6); PG8_BAR;
    }
    for (;;) {
        const bool has_next = S.next(ui + 1, nxt);
        const char* nA = has_next ? (const char*)g.A + (size_t)nxt.pm * tstepA : cA; const char* nB = has_next ? (const char*)g.Bt + (size_t)nxt.pn * tstep : cB;
        for (int t = 0; t < nt; t += 2) {
            const bool last = (t == nt - 2);
            const char* a1 = cA + (size_t)(t + 1) * kstep;
            const char* a2 = last ? nA : cA + (size_t)(t + 2) * kstep; const char* b2 = last ? nB : cB + (size_t)(t + 2) * kstep;
            const char* a3 = a2 + kstep; const char* b3 = b2 + kstep;
            if (last && has_next) S.a_ready(nxt);
            if constexpr (SP2) {
            PG8_LDB(B0, 0, 0); PG8_LDB(B1, 0, 1); PG8_SCHED; PG8_LDA(At, 0, 0); PG8_STAGE(PG8_SA(1, 1), a1 + hstepA, voffA);
            PG8_WAIT_V(8); PG8_WAIT_L(0); PG8_BAR; PG8_MMA(0, 0, At, B0); PG8_MMA(0, 1, At, B1); PG8_BAR; PG8_SCHED;
            PG8_LDA(At, 0, 1); PG8_STAGE(PG8_SB(0, 0), b2, voffB); PG8_STAGE(PG8_SB(0, 1), b2 + hstep, voffB); PG8_STAGE(PG8_SA(0, 0), a2, voffA);
            PG8_WAIT_V(8); PG8_WAIT_L(0); PG8_BAR; PG8_MMA(1, 0, At, B0); PG8_MMA(1, 1, At, B1); PG8_BAR; PG8_SCHED;
            PG8_LDB(B0, 1, 0); PG8_LDB(B1, 1, 1); PG8_SCHED; PG8_LDA(At, 1, 0); PG8_STAGE(PG8_SA(0, 1), a2 + hstepA, voffA);
            PG8_WAIT_V(8); PG8_WAIT_L(0); PG8_BAR; PG8_MMA(0, 0, At, B0); PG8_MMA(0, 1, At, B1); PG8_BAR; PG8_SCHED;
            PG8_LDA(At, 1, 1); PG8_STAGE(PG8_SB(1, 0), b3, voffB); PG8_STAGE(PG8_SB(1, 1), b3 + hstep, voffB); PG8_STAGE(PG8_SA(1, 0), a3, voffA);
            PG8_WAIT_V(8); PG8_WAIT_L(0); PG8_BAR; PG8_MMA(1, 0, At, B0); PG8_MMA(1, 1, At, B1); PG8_BAR; PG8_SCHED;
            } else {
            PG8_LDB(B0, 0, 0); PG8_SCHED; PG8_LDA(At, 0, 0); PG8_STAGE(PG8_SA(1, 1), a1 + hstepA, voffA);
            PG8_WAIT_L(8); PG8_BAR; PG8_WAIT_L(0); PG8_MMA(0, 0, At, B0); PG8_BAR; PG8_SCHED;
            PG8_LDB(B1, 0, 1); PG8_STAGE(PG8_SB(0, 0), b2, voffB);
            PG8_BAR; PG8_WAIT_L(0); PG8_MMA(0, 1, At, B1); PG8_BAR;
            PG8_LDA(At, 0, 1); PG8_STAGE(PG8_SA(0, 0), a2, voffA);
            PG8_BAR; PG8_WAIT_L(0); PG8_MMA(1, 0, At, B0); PG8_BAR; PG8_SCHED;
            PG8_STAGE(PG8_SB(0, 1), b2 + hstep, voffB);
            PG8_WAIT_V(6); PG8_BAR; PG8_MMA(1, 1, At, B1); PG8_BAR;
            PG8_LDB(B0, 1, 0); PG8_SCHED; PG8_LDA(At, 1, 0); PG8_STAGE(PG8_SA(0, 1), a2 + hstepA, voffA);
            PG8_WAIT_L(8); PG8_BAR; PG8_WAIT_L(0); PG8_MMA(0, 0, At, B0); PG8_BAR; PG8_SCHED;
            PG8_LDB(B1, 1, 1); PG8_STAGE(PG8_SB(1, 0), b3, voffB);
            PG8_BAR; PG8_WAIT_L(0); PG8_MMA(0, 1, At, B1); PG8_BAR;
            PG8_LDA(At, 1, 1); PG8_STAGE(PG8_SA(1, 0), a3, voffA);
            PG8_BAR; PG8_WAIT_L(0); PG8_MMA(1, 0, At, B0); PG8_BAR; PG8_SCHED;
            PG8_STAGE(PG8_SB(1, 1), b3 + hstep, voffB);
            PG8_WAIT_V(6); PG8_BAR; PG8_MMA(1, 1, At, B1); PG8_BAR;
            }
        }
        if constexpr (ALIGN_EPI) { if (wr == 0) PG8_BAR; }
        if constexpr (!Epi::AFTER_DRAIN) { E(acc, cur, wr, wc, fr, fq); S.done(cur); __builtin_amdgcn_s_waitcnt(0x0F70); }
        if (!has_next) break;
#pragma unroll
        for (int a = 0; a < 2; ++a)
#pragma unroll
            for (int b = 0; b < 2; ++b)
#pragma unroll
                for (int m = 0; m < 4; ++m)
#pragma unroll
                    for (int n = 0; n < 2; ++n) acc[a][b][m][n] = (f32x4){0.f, 0.f, 0.f, 0.f};
        cur = nxt; cA = nA; cB = nB; ++ui;
        if constexpr (ALIGN_EPI) { if (wr == 1) PG8_BAR; }
    }
    PG8_WAIT_V(0);
    if constexpr (!ALIGN_EPI) { if (wr == 0) PG8_BAR; }
    PG8_BAR;
    if constexpr (Epi::AFTER_DRAIN) { E.fused(acc, cur, wr, wc, fr, fq, lds, wid, lane); S.done(cur); }
#undef PG8_SA
#undef PG8_SB
#undef PG8_STAGE
#undef PG8_LDA
#undef PG8_LDB
#undef PG8_MMA
#undef PG8_WAIT_V
#undef PG8_WAIT_L
#undef PG8_BAR
#undef PG8_SCHED
}
}

#define LAS __attribute__((address_space(3)))
typedef unsigned short bf16;
typedef short bf16x8 __attribute__((ext_vector_type(8)));
typedef float f32x4 __attribute__((ext_vector_type(4)));
typedef unsigned u32x4 __attribute__((ext_vector_type(4)));
typedef unsigned u32x2 __attribute__((ext_vector_type(2)));
typedef _Float16 h16x8 __attribute__((ext_vector_type(8)));
using pg8::bf_lo; using pg8::bf_hi; using pg8::cvt_pk_bf16;

constexpr int M = 16384, D = 1024, DFF = 2816, NFF = 5632;
constexpr float LN_EPS = 1e-5f, RMS_EPS = 1e-6f;
constexpr size_t MiB = 1u << 20;
constexpr size_t WS_CNT = 0, WS_LBTAB = 4096, WS_KNMAX = 16384, WS_KMEAN = 65536, WS_QREF = 512 * 1024, WS_DEC = 1 * MiB, WS_LPART = 2 * MiB;
constexpr size_t WS_WIN = 4 * MiB, WS_WOUT = 12 * MiB, WS_WUP = 14 * MiB, WS_WDN = 25 * MiB;
constexpr size_t WS_XB = 32 * MiB, WS_L = 64 * MiB;
constexpr size_t WS_Q = WS_L, WS_GT = WS_L + 32 * MiB, WS_VT = WS_L + 64 * MiB, WS_GATE = WS_L + 96 * MiB, WS_ST = WS_L + 128 * MiB;
constexpr size_t WS_K = WS_L + 32 * MiB, WS_LIST = WS_L + 96 * MiB, WS_PART = WS_L + 104 * MiB;
constexpr size_t WS_PROJ = WS_L, WS_OGSC = WS_L + 96 * MiB;
constexpr size_t WS_H = WS_L;
constexpr size_t WS_NEED = WS_PART + 96 * MiB;
constexpr int LDS_BYTES = 147456;
constexpr size_t WS_BAR = 32 * 1024, BAR_ZERO_BYTES = 16 * 1024;
constexpr int LDS_BARST = LDS_BYTES - 16;
#ifndef DIAG_OFF
#define DIAG_OFF WS_VT
#define DIAG_ELEMS (16u << 20)
#endif
constexpr int LIST_PER_HEAD = 256 * 2016;

enum { OP_PRO = 0, OP_HG_IN, OP_HG_R1, OP_HG_R2, OP_HG_R3, OP_MB_IN, OP_MB_KMEAN, OP_MB_GATE, OP_MB_SEL, OP_MB_OWN, OP_SC_IN, OP_SC_CONV, OP_OUT, OP_LN1, OP_UP, OP_DOWN, OP_LN2, OP_CONVW, OP_DUMP, OP_DIAG1, OP_DIAG2 };
struct Params { const float* in[42]; float* out; unsigned char* ws; unsigned char prog[64]; int nprog, lo, hi, pad; };

template <class T> __device__ __forceinline__ T* as_global(T* q) { return (T*)(__attribute__((address_space(1))) T*)q; }
__device__ __forceinline__ unsigned f2bf(float f) { unsigned u = __float_as_uint(f); return (u + 0x7fffu + ((u >> 16) & 1u)) >> 16; }
__device__ __forceinline__ float bf2f(unsigned short b) { return __uint_as_float((unsigned)b << 16); }
__device__ __forceinline__ bf16x8 pack8(const float (&v)[8]) { u32x4 w; w.x = cvt_pk_bf16(v[0], v[1]); w.y = cvt_pk_bf16(v[2], v[3]); w.z = cvt_pk_bf16(v[4], v[5]); w.w = cvt_pk_bf16(v[6], v[7]); return __builtin_bit_cast(bf16x8, w); }
__device__ __forceinline__ void unpack8(bf16x8 x, float (&v)[8]) { const u32x4 w = __builtin_bit_cast(u32x4, x); v[0] = bf_lo(w.x); v[1] = bf_hi(w.x); v[2] = bf_lo(w.y); v[3] = bf_hi(w.y); v[4] = bf_lo(w.z); v[5] = bf_hi(w.z); v[6] = bf_lo(w.w); v[7] = bf_hi(w.w); }
__device__ __forceinline__ float wave_sum(float v) {
#pragma unroll
    for (int o = 1; o < 64; o <<= 1) v += __shfl_xor(v, o);
    return v;
}
#define MFMA16(a, b, c) __builtin_amdgcn_mfma_f32_16x16x32_bf16((a), (b), (c), 0, 0, 0)

__device__ __forceinline__ int kind_of(int L) { return L == 1 ? 1 : (L == 2 ? 2 : 0); }
__device__ __forceinline__ int base_of(int L) { return L == 0 ? 3 : (L == 1 ? 13 : (L == 2 ? 22 : 32)); }
__device__ __forceinline__ int wout_of(int L) { return base_of(L) + (L == 1 ? 1 : 2); }

__device__ __forceinline__ void transpose_item(const float* W, int ldw, int K, int col0, int ncols, bf16* WT, int drow0, int mode, LAS float* scr, int item, int lane) {
    const int nblk = ncols / 32, kb = item / nblk, nb = item % nblk, k0 = 64 * kb, n0 = 32 * nb;
    int dr;
    if (mode == 1) { const int c = n0; dr = c < DFF ? 256 * (c / 128) + (c % 128) : 256 * ((c - DFF) / 128) + 128 + ((c - DFF) % 128); } else dr = drow0 + n0;
    f32x4 wv[8];
#pragma unroll
    for (int i = 0; i < 8; ++i) wv[i] = *(const f32x4*)(W + (size_t)(k0 + 8 * i + (lane >> 3)) * ldw + col0 + n0 + 4 * (lane & 7));
#pragma unroll
    for (int i = 0; i < 8; ++i) { LAS float* d = scr + (8 * i + (lane >> 3)) * 33 + 4 * (lane & 7); d[0] = wv[i][0]; d[1] = wv[i][1]; d[2] = wv[i][2]; d[3] = wv[i][3]; }
    asm volatile("s_waitcnt lgkmcnt(0)" ::: "memory");
    const int c = lane & 7;
#pragma unroll
    for (int j = 0; j < 4; ++j) { const int n = (lane >> 3) + 8 * j; const LAS float* s = scr + (8 * c) * 33 + n;
        u32x4 o; o.x = cvt_pk_bf16(s[0 * 33], s[1 * 33]); o.y = cvt_pk_bf16(s[2 * 33], s[3 * 33]); o.z = cvt_pk_bf16(s[4 * 33], s[5 * 33]); o.w = cvt_pk_bf16(s[6 * 33], s[7 * 33]);
        *(u32x4*)(WT + (size_t)(dr + n) * K + k0 + 8 * c) = o; }
    asm volatile("s_waitcnt lgkmcnt(0)" ::: "memory");
}
__device__ __forceinline__ void convert_weights(const Params& p, unsigned char* ws, int L, LAS unsigned char* lds, int gw, int NGW, int wave, int lane) {
    LAS float* scr = (LAS float*)(lds + wave * 16384);
    const int kind = kind_of(L), wo = wout_of(L);
    const float* w_in = as_global(p.in[base_of(L)]); const float* w_out = as_global(p.in[wo]); const float* w_up = as_global(p.in[wo + 3]); const float* w_dn = as_global(p.in[wo + 5]);
    bf16* WIN = (bf16*)(ws + WS_WIN); bf16* WOUT = (bf16*)(ws + WS_WOUT); bf16* WUP = (bf16*)(ws + WS_WUP); bf16* WDN = (bf16*)(ws + WS_WDN);
    const int ldin = kind == 0 ? 4096 : 3072;
    const int n0 = (kind == 0 ? 1024 : 3072), n1 = (kind == 0 ? 1024 : 0), n2 = (kind == 0 ? 2048 : 0);
    const int i0 = 16 * (n0 / 32), i1 = 16 * (n1 / 32), i2 = 16 * (n2 / 32), i3 = 16 * 32, i4 = 16 * (NFF / 32), i5 = (DFF / 64) * 32;
    const int total = i0 + i1 + i2 + i3 + i4 + i5;
    for (int it = gw; it < total; it += NGW) {
        int r = it;
        if (r < i0) { transpose_item(w_in, ldin, 1024, 0, n0, WIN, 0, 0, scr, r, lane); continue; } r -= i0;
        if (r < i1) { transpose_item(w_in, ldin, 1024, 3072, n1, WIN, 1024, 0, scr, r, lane); continue; } r -= i1;
        if (r < i2) { transpose_item(w_in, ldin, 1024, 1024, n2, WIN, 2048, 0, scr, r, lane); continue; } r -= i2;
        if (r < i3) { transpose_item(w_out, 1024, 1024, 0, 1024, WOUT, 0, 0, scr, r, lane); continue; } r -= i3;
        if (r < i4) { transpose_item(w_up, NFF, 1024, 0, NFF, WUP, 0, 1, scr, r, lane); continue; } r -= i4;
        transpose_item(w_dn, 1024, DFF, 0, 1024, WDN, 0, 0, scr, r, lane);
    }
}

__device__ __forceinline__ void ln_row(const float* yrow, const float* g, const float* b, bf16* orow, float* frow, int lane) {
    const f32x4* xr = (const f32x4*)yrow + lane;
    f32x4 v[4]; float s = 0.f;
#pragma unroll
    for (int j = 0; j < 4; ++j) { v[j] = xr[64 * j]; s += (v[j].x + v[j].y) + (v[j].z + v[j].w); }
    const float mean = wave_sum(s) * (1.f / D); float s2 = 0.f;
#pragma unroll
    for (int j = 0; j < 4; ++j) { v[j] = v[j] - mean; s2 += (v[j].x * v[j].x + v[j].y * v[j].y) + (v[j].z * v[j].z + v[j].w * v[j].w); }
    const float rstd = 1.f / sqrtf(wave_sum(s2) * (1.f / D) + LN_EPS);
#pragma unroll
    for (int j = 0; j < 4; ++j) { const f32x4 gg = ((const f32x4*)g)[lane + 64 * j], bb = ((const f32x4*)b)[lane + 64 * j]; const f32x4 o = v[j] * rstd * gg + bb;
        if (orow) { u32x2 w; w.x = cvt_pk_bf16(o.x, o.y); w.y = cvt_pk_bf16(o.z, o.w); ((u32x2*)orow)[lane + 64 * j] = w; }
        if (frow) ((f32x4*)frow)[lane + 64 * j] = o; }
}

__device__ __forceinline__ void hg_prefix(const h16x8 v0, const h16x8 v1, int fr, int fq, float (&g)[2][8], float (&b)[2][8], float& blast) {
    float t0 = 0.f, t1 = 0.f;
#pragma unroll
    for (int j = 0; j < 8; ++j) { g[0][j] = (float)v0[j]; t0 += g[0][j]; b[0][j] = t0; g[1][j] = (float)v1[j]; t1 += g[1][j]; b[1][j] = t1; }
    float off0 = 0.f, off1 = 0.f, sum0 = 0.f, sum1 = 0.f;
#pragma unroll
    for (int q = 0; q < 4; ++q) { const float a0 = __shfl(t0, fr + 16 * q), a1 = __shfl(t1, fr + 16 * q); if (q < fq) { off0 += a0; off1 += a1; } sum0 += a0; sum1 += a1; }
#pragma unroll
    for (int j = 0; j < 8; ++j) { b[0][j] += off0; b[1][j] += sum0 + off1; }
    blast = sum0 + sum1;
}

__device__ __forceinline__ void hg_r1(const Params& p, unsigned char* ws, int wave, int lane) {
    int bid = blockIdx.x, gdim = gridDim.x; asm volatile("" : "+s"(bid), "+s"(gdim));
    const _Float16* GT = (const _Float16*)(ws + WS_GT); const bf16* VT = (const bf16*)(ws + WS_VT); bf16* ST = (bf16*)(ws + WS_ST); float* DEC = (float*)(ws + WS_DEC);
    const int fr = lane & 15, fq = lane >> 4;
    for (int unit = bid; unit < 2048; unit += gdim) {
        const int h = unit >> 8, c = unit & 255, d = 16 * wave + fr;
        float g[2][8], b[2][8], blast;
        const _Float16* grow = GT + (size_t)(h * 128 + d) * M + c * 64;
        const h16x8 gv0 = *(const h16x8*)(grow + 8 * fq), gv1 = *(const h16x8*)(grow + 32 + 8 * fq);
        bf16x8 bfrv[8][2];
#pragma unroll
        for (int nt = 0; nt < 8; ++nt)
#pragma unroll
            for (int ks = 0; ks < 2; ++ks) bfrv[nt][ks] = *(const bf16x8*)(VT + (size_t)(h * 128 + 16 * nt + fr) * M + c * 64 + 32 * ks + 8 * fq);
        hg_prefix(gv0, gv1, fr, fq, g, b, blast);
        bf16x8 afr[2];
#pragma unroll
        for (int ks = 0; ks < 2; ++ks) { float kd[8];
#pragma unroll
            for (int j = 0; j < 8; ++j) {
#if R1_VAR == 1
                kd[j] = (1.0f - __expf(g[ks][j]));
#elif R1_VAR == 2
                kd[j] = __expf(blast - b[ks][j]);
#elif R1_VAR == 3
                kd[j] = 1.0f;
#else
                kd[j] = (1.0f - __expf(g[ks][j])) * __expf(blast - b[ks][j]);
#endif
            }
            afr[ks] = pack8(kd); }
        if (fq == 0) DEC[(h * 256 + c) * 128 + d] = __expf(blast);
#pragma unroll
        for (int nt = 0; nt < 8; ++nt) { f32x4 acc = {0.f, 0.f, 0.f, 0.f};
#pragma unroll
            for (int ks = 0; ks < 2; ++ks) acc = MFMA16(afr[ks], bfrv[nt][ks], acc);
            u32x2 w; w.x = cvt_pk_bf16(acc[0], acc[1]); w.y = cvt_pk_bf16(acc[2], acc[3]);
            *(u32x2*)(ST + ((size_t)(h * 256 + c) * 128 + 16 * nt + fr) * 128 + 16 * wave + 4 * fq) = w; }
    }
}
__device__ __forceinline__ void hg_r2(const Params& p, unsigned char* ws, int tid) {
    int bid = blockIdx.x, gdim = gridDim.x; asm volatile("" : "+s"(bid), "+s"(gdim));
    bf16* ST = (bf16*)(ws + WS_ST); const float* DEC = (const float*)(ws + WS_DEC);
    for (int e = bid * 512 + tid; e < 131072; e += gdim * 512) {
        const int h = e >> 14, r = e & 16383, d = r & 127;
        bf16* sp = ST + (size_t)h * 256 * 16384 + r; const float* dp = DEC + h * 256 * 128 + d;
        float S = 0.f;
#pragma unroll 1
        for (int c = 0; c < 256; c += 32) { unsigned short loc[32]; float dc[32];
#pragma unroll
            for (int i = 0; i < 32; ++i) { loc[i] = sp[(size_t)(c + i) * 16384]; dc[i] = dp[(c + i) * 128]; }
#pragma unroll
            for (int i = 0; i < 32; ++i) { sp[(size_t)(c + i) * 16384] = (bf16)f2bf(S); S = dc[i] * S + bf2f(loc[i]); } }
    }
}
__device__ __forceinline__ void hg_r3(const Params& p, unsigned char* ws, int L, LAS unsigned char* lds, int tid, int wave, int lane) {
    int bid = blockIdx.x, gdim = gridDim.x; asm volatile("" : "+s"(bid), "+s"(gdim));
    const _Float16* GT = (const _Float16*)(ws + WS_GT); const bf16* VT = (const bf16*)(ws + WS_VT); const bf16* ST = (const bf16*)(ws + WS_ST);
    const bf16* Q = (const bf16*)(ws + WS_Q); const bf16* GATE = (const bf16*)(ws + WS_GATE); bf16* OG = (bf16*)(ws + WS_Q);
    const float* norm_g = as_global(p.in[base_of(L) + 1]);
    LAS float* bt = (LAS float*)lds; LAS float* red = bt + 65 * 132;
    const int fr = lane & 15, fq = lane >> 4;
    if (tid < 132) bt[tid] = 0.f;
    const int mt = wave >> 1, nh = wave & 1;
    for (int unit = bid; unit < 2048; unit += gdim) {
        const int h = unit >> 8, c = unit & 255;
        const int t = 16 * mt + fr; const size_t tok = (size_t)c * 64 + t;
        bf16x8 qraw[4], sfrv[4][4];
        { const int d = 16 * wave + fr; float g[2][8], b[2][8], blast;
            const _Float16* grow = GT + (size_t)(h * 128 + d) * M + c * 64;
            const h16x8 gv0 = *(const h16x8*)(grow + 8 * fq), gv1 = *(const h16x8*)(grow + 32 + 8 * fq);
#pragma unroll
            for (int ks = 0; ks < 4; ++ks) qraw[ks] = *(const bf16x8*)(Q + tok * 1024 + h * 128 + 32 * ks + 8 * fq);
#pragma unroll
            for (int n = 0; n < 4; ++n)
#pragma unroll
                for (int ks = 0; ks < 4; ++ks) sfrv[n][ks] = *(const bf16x8*)(ST + ((size_t)(h * 256 + c) * 128 + 16 * (4 * nh + n) + fr) * 128 + 32 * ks + 8 * fq);
            hg_prefix(gv0, gv1, fr, fq, g, b, blast);
#pragma unroll
            for (int ks = 0; ks < 2; ++ks)
#pragma unroll
                for (int j = 0; j < 8; ++j) bt[(32 * ks + 8 * fq + j + 1) * 132 + d] = b[ks][j]; }
        __syncthreads();
        bf16x8 qtil[4], qhat[4]; float Rr[4][8];
#pragma unroll
        for (int ks = 0; ks < 4; ++ks) { float qf[8], bq[8], a[8], a2[8];
            unpack8(qraw[ks], qf);
            const f32x4 b0 = *(const LAS f32x4*)(bt + (t + 1) * 132 + 32 * ks + 8 * fq), b1 = *(const LAS f32x4*)(bt + (t + 1) * 132 + 32 * ks + 8 * fq + 4);
            const f32x4 r0 = *(const LAS f32x4*)(bt + (16 * mt) * 132 + 32 * ks + 8 * fq), r1 = *(const LAS f32x4*)(bt + (16 * mt) * 132 + 32 * ks + 8 * fq + 4);
#pragma unroll
            for (int j = 0; j < 4; ++j) { bq[j] = b0[j]; bq[4 + j] = b1[j]; Rr[ks][j] = r0[j]; Rr[ks][4 + j] = r1[j]; }
#pragma unroll
            for (int j = 0; j < 8; ++j) { a[j] = qf[j] * __expf(bq[j]); a2[j] = qf[j] * __expf(bq[j] - Rr[ks][j]); }
            qtil[ks] = pack8(a); qhat[ks] = pack8(a2); }
        f32x4 o[4];
#pragma unroll
        for (int n = 0; n < 4; ++n) { o[n] = (f32x4){0.f, 0.f, 0.f, 0.f};
#pragma unroll
            for (int ks = 0; ks < 4; ++ks) o[n] = MFMA16(sfrv[n][ks], qtil[ks], o[n]); }
        unsigned pk[4][2];
#pragma unroll
        for (int i = 0; i < 4; ++i) {
            if (i <= mt) { f32x4 sc = {0.f, 0.f, 0.f, 0.f}; const int s = 16 * i + fr;
#pragma unroll
                for (int ks = 0; ks < 4; ++ks) { float kt[8];
                    const f32x4 b0 = *(const LAS f32x4*)(bt + (s + 1) * 132 + 32 * ks + 8 * fq), b1 = *(const LAS f32x4*)(bt + (s + 1) * 132 + 32 * ks + 8 * fq + 4);
                    const f32x4 m0 = *(const LAS f32x4*)(bt + s * 132 + 32 * ks + 8 * fq), m1 = *(const LAS f32x4*)(bt + s * 132 + 32 * ks + 8 * fq + 4);
#pragma unroll
                    for (int j = 0; j < 4; ++j) { kt[j] = (1.0f - __expf(b0[j] - m0[j])) * __expf(Rr[ks][j] - b0[j]); kt[4 + j] = (1.0f - __expf(b1[j] - m1[j])) * __expf(Rr[ks][4 + j] - b1[j]); }
                    sc = MFMA16(pack8(kt), qhat[ks], sc); }
                if (i == mt) {
#pragma unroll
                    for (int j = 0; j < 4; ++j) if (4 * fq + j > fr) sc[j] = 0.f; }
                pk[i][0] = cvt_pk_bf16(sc[0], sc[1]); pk[i][1] = cvt_pk_bf16(sc[2], sc[3]);
            } else { pk[i][0] = 0u; pk[i][1] = 0u; } }
#pragma unroll
        for (int kk = 0; kk < 2; ++kk) if (2 * kk <= mt) {
            u32x4 pw; pw.x = pk[2 * kk][0]; pw.y = pk[2 * kk][1]; pw.z = pk[2 * kk + 1][0]; pw.w = pk[2 * kk + 1][1]; const bf16x8 pf = __builtin_bit_cast(bf16x8, pw);
#pragma unroll
            for (int n = 0; n < 4; ++n) { const bf16* vrow = VT + (size_t)(h * 128 + 16 * (4 * nh + n) + fr) * M + c * 64 + 32 * kk + 4 * fq;
                const u32x2 lo = *(const u32x2*)vrow, hi = *(const u32x2*)(vrow + 16); u32x4 vw; vw.x = lo.x; vw.y = lo.y; vw.z = hi.x; vw.w = hi.y;
                o[n] = MFMA16(__builtin_bit_cast(bf16x8, vw), pf, o[n]); } }
        float ss = 0.f;
#pragma unroll
        for (int n = 0; n < 4; ++n) ss += (o[n][0] * o[n][0] + o[n][1] * o[n][1]) + (o[n][2] * o[n][2] + o[n][3] * o[n][3]);
        ss += __shfl_xor(ss, 16); ss += __shfl_xor(ss, 32);
        if (fq == 0) red[wave * 16 + fr] = ss;
        __syncthreads();
        const float rstd = 1.0f / sqrtf((ss + red[(wave ^ 1) * 16 + fr]) * (1.0f / 128.0f) + RMS_EPS);
#pragma unroll
        for (int n = 0; n < 4; ++n) { const int v0 = h * 128 + 16 * (4 * nh + n) + 4 * fq; const u32x2 gw = *(const u32x2*)(GATE + tok * 1024 + v0); const f32x4 ng = *(const f32x4*)(norm_g + v0);
            u32x2 w; w.x = cvt_pk_bf16(o[n][0] * rstd * ng[0] * bf_lo(gw.x), o[n][1] * rstd * ng[1] * bf_hi(gw.x)); w.y = cvt_pk_bf16(o[n][2] * rstd * ng[2] * bf_lo(gw.y), o[n][3] * rstd * ng[3] * bf_hi(gw.y));
            *(u32x2*)(OG + tok * 1024 + v0) = w; }
    }
    __syncthreads();
}

constexpr int KS_STRIDE = 272, VS_STRIDE = 528, KS_BYTES = 256 * KS_STRIDE, VS_BYTES = 128 * VS_STRIDE, PRE_OFF = KS_BYTES + VS_BYTES;
constexpr float ATT_SC2 = 0.08838834764831845f * 1.4426950408889634f;
__device__ __forceinline__ int list_off(int n) { return 256 * (63 * n - (n * (n - 1)) / 2); }
__device__ __forceinline__ void mb_stage(const bf16* K, const bf16* VT, int h, int n, LAS unsigned char* lds, int tid) {
#pragma unroll
    for (int i = 0; i < 8; ++i) { const int row = (tid >> 4) + 32 * i, ch = tid & 15; *(LAS u32x4*)(lds + row * KS_STRIDE + ch * 16) = *(const u32x4*)(K + (size_t)(256 * n + row) * 1024 + h * 128 + 8 * ch); }
#pragma unroll
    for (int i = 0; i < 8; ++i) { const int row = (tid >> 5) + 16 * i, ch = tid & 31; *(LAS u32x4*)(lds + KS_BYTES + row * VS_STRIDE + ch * 16) = *(const u32x4*)(VT + (size_t)(h * 128 + row) * M + 256 * n + 8 * ch); }
}
__device__ __forceinline__ void attn_group(LAS const unsigned char* lds, const bf16* qrow, bool valid, float ref2, int nkt, bool causal, int qpos, int fr, int fq, f32x4 (&o)[8], float& l) {
    bf16x8 qf[4];
#pragma unroll
    for (int ks = 0; ks < 4; ++ks) qf[ks] = valid ? *(const bf16x8*)(qrow + 32 * ks + 8 * fq) : (bf16x8){0, 0, 0, 0, 0, 0, 0, 0};
    unsigned pk[16][2]; float lsum = 0.f;
#pragma unroll
    for (int kt = 0; kt < 16; ++kt) {
        if (kt < nkt) { f32x4 s = {0.f, 0.f, 0.f, 0.f};
#pragma unroll
            for (int ks = 0; ks < 4; ++ks) { const bf16x8 kf = *(const LAS bf16x8*)(lds + (16 * kt + fr) * KS_STRIDE + (32 * ks + 8 * fq) * 2); s = MFMA16(kf, qf[ks], s); }
            float pv[4];
#pragma unroll
            for (int j = 0; j < 4; ++j) { pv[j] = __builtin_amdgcn_exp2f(s[j] * ATT_SC2 - ref2); if (causal && (16 * kt + 4 * fq + j > qpos)) pv[j] = 0.f; lsum += pv[j]; }
            pk[kt][0] = cvt_pk_bf16(pv[0], pv[1]); pk[kt][1] = cvt_pk_bf16(pv[2], pv[3]);
        } else { pk[kt][0] = 0u; pk[kt][1] = 0u; } }
#pragma unroll
    for (int dt = 0; dt < 8; ++dt) o[dt] = (f32x4){0.f, 0.f, 0.f, 0.f};
#pragma unroll
    for (int kk = 0; kk < 8; ++kk) if (2 * kk < nkt) {
        u32x4 pw; pw.x = pk[2 * kk][0]; pw.y = pk[2 * kk][1]; pw.z = pk[2 * kk + 1][0]; pw.w = pk[2 * kk + 1][1]; const bf16x8 pf = __builtin_bit_cast(bf16x8, pw);
#pragma unroll
        for (int dt = 0; dt < 8; ++dt) { LAS const unsigned char* vp = lds + KS_BYTES + (16 * dt + fr) * VS_STRIDE + (32 * kk + 4 * fq) * 2;
            const u32x2 lo = *(const LAS u32x2*)vp, hi = *(const LAS u32x2*)(vp + 32); u32x4 vw; vw.x = lo.x; vw.y = lo.y; vw.z = hi.x; vw.w = hi.y;
            o[dt] = MFMA16(__builtin_bit_cast(bf16x8, vw), pf, o[dt]); } }
    lsum += __shfl_xor(lsum, 16); lsum += __shfl_xor(lsum, 32); l = lsum;
}
__device__ __forceinline__ void mb_kmean(const Params& p, unsigned char* ws, LAS unsigned char* lds, int tid, int wave, int lane) {
    int bid = blockIdx.x, gdim = gridDim.x; asm volatile("" : "+s"(bid), "+s"(gdim));
    const bf16* K = (const bf16*)(ws + WS_K); float* KMEAN = (float*)(ws + WS_KMEAN); float* KNMAX = (float*)(ws + WS_KNMAX);
    LAS float* part = (LAS float*)lds; LAS float* mx = part + 8 * 128;
    for (int unit = bid; unit < 512; unit += gdim) { const int h = unit >> 6, n = unit & 63;
        float s0 = 0.f, s1 = 0.f, rm = 0.f;
        for (int r = wave; r < 256; r += 8) { const unsigned w = *(const unsigned*)(K + (size_t)(256 * n + r) * 1024 + h * 128 + 2 * lane); const float x0 = bf_lo(w), x1 = bf_hi(w);
            s0 += x0; s1 += x1; rm = fmaxf(rm, wave_sum(x0 * x0 + x1 * x1)); }
        part[wave * 128 + 2 * lane] = s0; part[wave * 128 + 2 * lane + 1] = s1; if (lane == 0) mx[wave] = rm;
        __syncthreads();
        if (tid < 128) { float s = 0.f;
#pragma unroll
            for (int w = 0; w < 8; ++w) s += part[w * 128 + tid];
            KMEAN[(size_t)unit * 128 + tid] = s * (1.0f / 256.0f); }
        if (tid == 0) { float m = 0.f;
#pragma unroll
            for (int w = 0; w < 8; ++w) m = fmaxf(m, mx[w]);
            KNMAX[unit] = m; }
        __syncthreads(); }
}
__device__ __forceinline__ void mb_gate(const Params& p, unsigned char* ws, LAS unsigned char* lds, int tid) {
    int bid = blockIdx.x, gdim = gridDim.x; asm volatile("" : "+s"(bid), "+s"(gdim));
    const bf16* Q = (const bf16*)(ws + WS_Q); const float* KMEAN = (const float*)(ws + WS_KMEAN); const float* KNMAX = (const float*)(ws + WS_KNMAX);
    int* CNT = (int*)(ws + WS_CNT); unsigned short* LIST = (unsigned short*)(ws + WS_LIST); float* QREF = (float*)(ws + WS_QREF);
    LAS float* km = (LAS float*)lds; LAS float* kn = km + 64 * 128;
    for (int item = bid; item < 256; item += gdim) { const int h = item >> 5, s = (item & 31) * 512 + tid, blk = s >> 8;
        __syncthreads();
        for (int i = tid; i < 64 * 128 / 4; i += 512) ((LAS f32x4*)km)[i] = ((const f32x4*)(KMEAN + (size_t)h * 64 * 128))[i];
        if (tid < 64) kn[tid] = KNMAX[h * 64 + tid];
        __syncthreads();
        unsigned qp[64]; float qq = 0.f;
#pragma unroll
        for (int ch = 0; ch < 16; ++ch) { const u32x4 w = *(const u32x4*)(Q + (size_t)s * 1024 + h * 128 + 8 * ch); qp[4 * ch] = w.x; qp[4 * ch + 1] = w.y; qp[4 * ch + 2] = w.z; qp[4 * ch + 3] = w.w; }
#pragma unroll
        for (int i = 0; i < 64; ++i) { const float x0 = bf_lo(qp[i]), x1 = bf_hi(qp[i]); qq += x0 * x0 + x1 * x1; }
        float kmax = 0.f;
#pragma unroll 8
        for (int n = 0; n < 64; ++n) kmax = fmaxf(kmax, kn[n]);
        QREF[(size_t)s * 8 + h] = sqrtf(qq) * sqrtf(kmax) * ATT_SC2;
        float b0 = -3.0e38f, b1 = -3.0e38f, b2 = -3.0e38f; int i0 = 0, i1 = 0, i2 = 0;
#pragma unroll 1
        for (int n = 0; n < blk; ++n) { float d0 = 0.f, d1 = 0.f, d2 = 0.f, d3 = 0.f;
#pragma unroll
            for (int c8 = 0; c8 < 4; ++c8) {
#pragma unroll
                for (int c4 = 8 * c8; c4 < 8 * c8 + 8; ++c4) { const f32x4 k4 = *(const LAS f32x4*)(km + n * 128 + 4 * c4);
                    d0 += bf_lo(qp[2 * c4]) * k4[0]; d1 += bf_hi(qp[2 * c4]) * k4[1]; d2 += bf_lo(qp[2 * c4 + 1]) * k4[2]; d3 += bf_hi(qp[2 * c4 + 1]) * k4[3]; }
                asm volatile("" ::: "memory"); }
            const float v = (d0 + d1) + (d2 + d3);
            if (v > b0) { b2 = b1; i2 = i1; b1 = b0; i1 = i0; b0 = v; i0 = n; } else if (v > b1) { b2 = b1; i2 = i1; b1 = v; i1 = n; } else if (v > b2) { b2 = v; i2 = n; } }
#pragma unroll
        for (int r = 0; r < 3; ++r) { if (r < blk) { const int bi = r == 0 ? i0 : (r == 1 ? i1 : i2);
                const int pos = atomicAdd(&CNT[h * 64 + bi], 1);
                LIST[(size_t)h * LIST_PER_HEAD + list_off(bi) + pos] = (unsigned short)(s | (r << 14)); } }
    }
    __syncthreads();
}
__device__ __forceinline__ void mb_sel(const Params& p, unsigned char* ws, LAS unsigned char* lds, int tid, int wave, int lane) {
    int bid = blockIdx.x, gdim = gridDim.x; asm volatile("" : "+s"(bid), "+s"(gdim));
    const bf16* Q = (const bf16*)(ws + WS_Q); const bf16* K = (const bf16*)(ws + WS_K); const bf16* VT = (const bf16*)(ws + WS_VT);
    const int* CNT = (const int*)(ws + WS_CNT); const unsigned short* LIST = (const unsigned short*)(ws + WS_LIST); const float* QREF = (const float*)(ws + WS_QREF);
    bf16* PART = (bf16*)(ws + WS_PART); float* LPART = (float*)(ws + WS_LPART);
    LAS int* pre = (LAS int*)(lds + PRE_OFF); LAS int* wtot = pre + 520;
    const int fr = lane & 15, fq = lane >> 4;
    { const int tl = (CNT[tid] + 127) >> 7; int x = tl;
#pragma unroll
        for (int o = 1; o < 64; o <<= 1) { const int y = __shfl_up(x, o); if (lane >= o) x += y; }
        if (lane == 63) wtot[wave] = x;
        __syncthreads();
        int add = 0;
#pragma unroll
        for (int w = 0; w < 8; ++w) if (w < wave) add += wtot[w];
        pre[tid + 1] = x + add; if (tid == 0) pre[0] = 0;
        __syncthreads(); }
    const int T = pre[512];
    const int lo = (int)(((long)T * bid) / gdim), hi = (int)(((long)T * (bid + 1)) / gdim);
    int cur = -1;
    for (int it = lo; it < hi; ++it) {
        int a = 0, b = 511;
        while (a < b) { const int mid = (a + b + 1) >> 1; if (pre[mid] <= it) a = mid; else b = mid - 1; }
        const int hn = a, h = hn >> 6, n = hn & 63, tile = it - pre[hn];
        if (hn != cur) { __syncthreads(); mb_stage(K, VT, h, n, lds, tid); __syncthreads(); cur = hn; }
        const int cnt = CNT[hn], e0 = (tile * 8 + wave) * 16;
        if (e0 < cnt) { const int idx = e0 + fr; const bool valid = idx < cnt;
            const unsigned ent = valid ? LIST[(size_t)h * LIST_PER_HEAD + list_off(n) + idx] : 0u; const int s = ent & 0x3fff, slot = ent >> 14;
            f32x4 o[8]; float l;
            attn_group(lds, Q + (size_t)s * 1024 + h * 128, valid, QREF[(size_t)s * 8 + h], 16, false, 0, fr, fq, o, l);
            if (valid) { bf16* pp = PART + ((size_t)slot * M + s) * 1024 + h * 128 + 4 * fq;
#pragma unroll
                for (int dt = 0; dt < 8; ++dt) { u32x2 w; w.x = cvt_pk_bf16(o[dt][0], o[dt][1]); w.y = cvt_pk_bf16(o[dt][2], o[dt][3]); *(u32x2*)(pp + 16 * dt) = w; }
                if (fq == 0) LPART[((size_t)slot * M + s) * 8 + h] = l; } }
    }
    __syncthreads();
}
__device__ __forceinline__ void mb_own(const Params& p, unsigned char* ws, LAS unsigned char* lds, int tid, int wave, int lane) {
    int bid = blockIdx.x, gdim = gridDim.x; asm volatile("" : "+s"(bid), "+s"(gdim));
    const bf16* Q = (const bf16*)(ws + WS_Q); const bf16* K = (const bf16*)(ws + WS_K); const bf16* VT = (const bf16*)(ws + WS_VT);
    const float* QREF = (const float*)(ws + WS_QREF); const bf16* PART = (const bf16*)(ws + WS_PART); const float* LPART = (const float*)(ws + WS_LPART); bf16* OG = (bf16*)(ws + WS_Q);
    const int fr = lane & 15, fq = lane >> 4;
    for (int unit = bid; unit < 512; unit += gdim) { const int h = unit >> 6, b = unit & 63;
        __syncthreads(); mb_stage(K, VT, h, b, lds, tid); __syncthreads();
        const int nsl = b < 3 ? b : 3;
#pragma unroll 1
        for (int gi = 0; gi < 2; ++gi) { const int g = gi ? 15 - wave : wave, s = 256 * b + 16 * g + fr;
            f32x4 o[8]; float l;
            attn_group(lds, Q + (size_t)s * 1024 + h * 128, true, QREF[(size_t)s * 8 + h], g + 1, true, 16 * g + fr, fr, fq, o, l);
            for (int j = 0; j < nsl; ++j) { const bf16* pp = PART + ((size_t)j * M + s) * 1024 + h * 128 + 4 * fq; l += LPART[((size_t)j * M + s) * 8 + h];
#pragma unroll
                for (int dt = 0; dt < 8; ++dt) { const u32x2 w = *(const u32x2*)(pp + 16 * dt); o[dt][0] += bf_lo(w.x); o[dt][1] += bf_hi(w.x); o[dt][2] += bf_lo(w.y); o[dt][3] += bf_hi(w.y); } }
            const float inv = 1.0f / l; bf16* op = OG + (size_t)s * 1024 + h * 128 + 4 * fq;
#pragma unroll
            for (int dt = 0; dt < 8; ++dt) { u32x2 w; w.x = cvt_pk_bf16(o[dt][0] * inv, o[dt][1] * inv); w.y = cvt_pk_bf16(o[dt][2] * inv, o[dt][3] * inv); *(u32x2*)(op + 16 * dt) = w; } }
    }
    __syncthreads();
}
__device__ __forceinline__ void sc_conv(const Params& p, unsigned char* ws, int L, int tid) {
    int bid = blockIdx.x, gdim = gridDim.x; asm volatile("" : "+s"(bid), "+s"(gdim));
    const bf16* PROJ = (const bf16*)(ws + WS_PROJ); bf16* OG = (bf16*)(ws + WS_OGSC); const float* cw = as_global(p.in[base_of(L) + 1]);
    for (int idx = bid * 512 + tid; idx < (M / 8) * 128; idx += gdim * 512) { const int t0 = (idx >> 7) * 8, c = (idx & 127) * 8;
        f32x4 w[3][2];
#pragma unroll
        for (int k = 0; k < 3; ++k) { w[k][0] = *(const f32x4*)(cw + k * 1024 + c); w[k][1] = *(const f32x4*)(cw + k * 1024 + c + 4); }
        float p0[8], p1[8], p2[8];
#pragma unroll
        for (int j = 0; j < 8; ++j) { p0[j] = 0.f; p1[j] = 0.f; p2[j] = 0.f; }
#pragma unroll
        for (int k = -2; k < 8; ++k) { const int tt = t0 + k;
#pragma unroll
            for (int j = 0; j < 8; ++j) { p0[j] = p1[j]; p1[j] = p2[j]; p2[j] = 0.f; }
            if (tt >= 0) { float cgv[8], hv[8]; unpack8(*(const bf16x8*)(PROJ + (size_t)tt * 3072 + 1024 + c), cgv); unpack8(*(const bf16x8*)(PROJ + (size_t)tt * 3072 + 2048 + c), hv);
#pragma unroll
                for (int j = 0; j < 8; ++j) p2[j] = cgv[j] * hv[j]; }
            if (k >= 0) { float bg[8], o[8]; unpack8(*(const bf16x8*)(PROJ + (size_t)tt * 3072 + c), bg);
#pragma unroll
                for (int j = 0; j < 8; ++j) o[j] = bg[j] * (w[0][j >> 2][j & 3] * p0[j] + w[1][j >> 2][j & 3] * p1[j] + w[2][j >> 2][j & 3] * p2[j]);
                *(bf16x8*)(OG + (size_t)tt * 1024 + c) = pack8(o); } } }
}

#define XB_TMO      128
#define XB_XCNT(j)  (256  + 64 * (j))
#define XB_XSUB(j)  (1280 + 64 * (j))
#define XB_XGEN(j)  (2304 + 64 * (j))
#define XB_TOP      3328
#define XB_TOPGEN   3392
#define XCD_BAR_WORDS 3456
#define XB_SPIN_CAP (1u << 18)

__device__ __forceinline__ unsigned xb_ld(unsigned* p)              { return __hip_atomic_load(p, __ATOMIC_RELAXED, __HIP_MEMORY_SCOPE_AGENT); }
__device__ __forceinline__ unsigned xb_add(unsigned* p, unsigned v) { return __hip_atomic_fetch_add(p, v, __ATOMIC_RELAXED, __HIP_MEMORY_SCOPE_AGENT); }
__device__ __forceinline__ unsigned xb_xcc_id() { return (unsigned)__builtin_amdgcn_s_getreg((3 << 11) | 20) & 0xFu; }
#define XB_SPIN(cond, bar) do { unsigned _sp = 0; while (cond) { __builtin_amdgcn_s_sleep(1); \
    if ((++_sp & 255u) == 0u) { if (xb_ld(&(bar)[XB_TMO])) break; if (_sp > XB_SPIN_CAP) { atomicAdd(&(bar)[XB_TMO], 1u); break; } } } } while (0)

struct XcdBarrier {
    unsigned* bar; unsigned x;
    volatile LAS unsigned* st;
};

__device__ __forceinline__ XcdBarrier xcd_barrier_post(unsigned* bar, volatile LAS unsigned* st) {
    XcdBarrier b; b.bar = bar; b.x = xb_xcc_id(); b.st = st;
    if (threadIdx.x == 0) (void)xb_add(&bar[XB_XCNT(b.x)], 1u);
    return b;
}
__device__ __forceinline__ void xcd_barrier_complete(unsigned* bar, unsigned x, unsigned& nloc, unsigned& nx) {
    const unsigned G = gridDim.x * gridDim.y * gridDim.z;
    unsigned sum, cnt, mine, sp = 0u;
    for (;;) {
        sum = 0u; cnt = 0u; mine = 0u;
#pragma unroll
        for (unsigned j = 0; j < 16; ++j) { const unsigned c = xb_ld(&bar[XB_XCNT(j)]); sum += c; cnt += (c > 0u) ? 1u : 0u; mine = (j == x) ? c : mine; }
        if (sum == G) break;
        __builtin_amdgcn_s_sleep(1);
        if ((++sp & 255u) == 0u) { if (xb_ld(&bar[XB_TMO])) break; if (sp > XB_SPIN_CAP) { atomicAdd(&bar[XB_TMO], 1u); break; } }
    }
    nloc = mine > 0u ? mine : 1u; nx = cnt > 0u ? cnt : 1u;
}

__device__ __forceinline__ void xcd_barrier(const XcdBarrier& b) {
    asm volatile("s_waitcnt vmcnt(0)" ::: "memory");
    __syncthreads();
    if (threadIdx.x == 0) {
        unsigned* bar = b.bar;
        __builtin_amdgcn_s_waitcnt(0);
        unsigned nloc = b.st[0], nx = b.st[1];
        if (nloc == 0u) { xcd_barrier_complete(bar, b.x, nloc, nx); b.st[0] = nloc; b.st[1] = nx; }
        const unsigned old = xb_add(&bar[XB_XSUB(b.x)], 1u);
        const unsigned gen = old / nloc;
        if (old + 1u == (gen + 1u) * nloc) {
            __builtin_amdgcn_fence(__ATOMIC_RELEASE, "agent");
            asm volatile("s_waitcnt vmcnt(0)" ::: "memory");
            const unsigned og = xb_add(&bar[XB_TOP], 1u);
            const unsigned tg = og / nx;
            if (og + 1u == (tg + 1u) * nx) xb_add(&bar[XB_TOPGEN], 1u);
            else XB_SPIN(xb_ld(&bar[XB_TOPGEN]) == tg, bar);
            __builtin_amdgcn_fence(__ATOMIC_ACQUIRE, "agent");
            xb_add(&bar[XB_XGEN(b.x)], 1u);
            asm volatile("s_waitcnt vmcnt(0)" ::: "memory");
        } else {
            XB_SPIN(xb_ld(&bar[XB_XGEN(b.x)]) == gen, bar);
            __builtin_amdgcn_fence(__ATOMIC_ACQUIRE, "agent");
            asm volatile("s_waitcnt vmcnt(0)" ::: "memory");
        }
    }
    __syncthreads();
}


__global__ void __launch_bounds__(512, 2) mk_fwd(Params p) {
    extern __shared__ __attribute__((aligned(16))) unsigned char lds_raw[];
    LAS unsigned char* lds = (LAS unsigned char*)lds_raw;
    const int G = gridDim.x;
    if (threadIdx.x < 4) ((LAS unsigned*)(lds + LDS_BARST))[threadIdx.x] = 0u;
    __syncthreads();
    if (p.hi - p.lo > 1) (void)xcd_barrier_post((unsigned*)(as_global(p.ws) + WS_BAR), (volatile LAS unsigned*)(lds + LDS_BARST));
#define GRID_BAR() do { size_t zb = 0; asm volatile("" : "+s"(zb)); unsigned char* wsb = p.ws + zb; XcdBarrier xb_; xb_.bar = (unsigned*)(wsb + WS_BAR); xb_.x = xb_xcc_id(); xb_.st = (volatile LAS unsigned*)(lds + LDS_BARST); xcd_barrier(xb_); } while (0)
#define FRESH() size_t zo = 0; int zero = 0; int tid = threadIdx.x; int bid = blockIdx.x, gdim = gridDim.x; asm volatile("" : "+s"(zo), "+s"(zero), "+v"(tid), "+s"(bid), "+s"(gdim)); \
        unsigned char* ws = p.ws + zo; float* Y = p.out + zo; \
        const int lane = tid & 63, wave = __builtin_amdgcn_readfirstlane(tid >> 6), gw = bid * 8 + wave, NGW = gdim * 8; bf16* XB = (bf16*)(ws + WS_XB); (void)lane; (void)gw; (void)NGW; (void)XB; (void)Y; (void)zero;
    for (int pi = p.lo; pi < p.hi; ++pi) {
        const int pw = __builtin_amdgcn_readfirstlane((int)p.prog[pi]); const int op = pw & 31, L = pw >> 5;
        if (op == OP_PRO) { FRESH();
            const float* x = as_global(p.in[zero]);
            for (size_t i = (size_t)bid * 512 + tid; i < (size_t)M * D / 8; i += (size_t)gdim * 512) { const f32x4 a = ((const f32x4*)x)[2 * i], b = ((const f32x4*)x)[2 * i + 1];
                u32x4 w; w.x = cvt_pk_bf16(a.x, a.y); w.y = cvt_pk_bf16(a.z, a.w); w.z = cvt_pk_bf16(b.x, b.y); w.w = cvt_pk_bf16(b.z, b.w); ((u32x4*)XB)[i] = w; }
            if (bid == 0 && tid == 0) *(unsigned*)(ws + 3 * 1024) = 0u;
            if (bid == 0) { const float* lbp = as_global(p.in[2 + zero]); float* LB = (float*)(ws + WS_LBTAB);
                for (int c = tid; c < 1024; c += 512) { const float a0 = lbp[c], a1 = lbp[1024 + c], a2 = lbp[2048 + c], a3 = lbp[3072 + c]; const float mx = fmaxf(fmaxf(a0, a1), fmaxf(a2, a3));
                    const float e0 = __expf(a0 - mx), e1 = __expf(a1 - mx), e2 = __expf(a2 - mx), e3 = __expf(a3 - mx); const float inv = 1.0f / (e0 + e1 + e2 + e3);
                    LB[c] = 0.f; LB[1024 + c] = (e1 + e2 + e3) * inv; } }
            convert_weights(p, ws, 0, lds, gw, NGW, wave, lane);
        } else if (op == OP_HG_IN || op == OP_MB_IN || op == OP_SC_IN || op == OP_OUT || op == OP_UP || op == OP_DOWN) {
            FRESH(); const int nsub = (op == OP_HG_IN || op == OP_MB_IN) ? 2 : 1;
            if (op == OP_MB_IN && bid == 0) ((int*)(ws + WS_CNT))[tid] = 0;
            for (int subx = 0; subx < nsub * (1 + DUP_GEMM); ++subx) { const int sub = subx % nsub;
                pg8::Gemm g; pg8::Epi E; int nM, nN; g.M = M; g.amode = 0; E.aux = nullptr; E.pos = nullptr; E.O1 = nullptr; E.ldc = 1024;
                bf16* WIN = (bf16*)(ws + WS_WIN);
                if (op == OP_HG_IN) {
                    if (sub == 0) { g.A = XB; g.Bt = WIN; g.N = 2048; g.K = 1024; nM = 64; nN = 8; E.mode = pg8::EPI_SILU_SPLIT; E.O0 = ws + WS_Q; E.O1 = ws + WS_GATE; }
                    else { g.A = WIN + (size_t)2048 * 1024; g.Bt = XB; g.N = M; g.K = 1024; nM = 8; nN = 64; E.mode = pg8::EPI_T_HGRN; E.O0 = ws + WS_GT; E.O1 = ws + WS_VT; E.aux = (const float*)(ws + WS_LBTAB) + (L == 0 ? 0 : 1024); }
                } else if (op == OP_MB_IN) {
                    if (sub == 0) { g.A = XB; g.Bt = WIN; g.N = 2048; g.K = 1024; nM = 64; nN = 8; E.mode = pg8::EPI_ROPE_SPLIT; E.O0 = ws + WS_Q; E.O1 = ws + WS_K; E.pos = (const int*)as_global(p.in[1 + zero]); }
                    else { g.A = WIN + (size_t)2048 * 1024; g.Bt = XB; g.N = M; g.K = 1024; nM = 4; nN = 64; E.mode = pg8::EPI_T_PLAIN; E.O0 = ws + WS_VT; }
                } else if (op == OP_SC_IN) { g.A = XB; g.Bt = WIN; g.N = 3072; g.K = 1024; nM = 64; nN = 12; E.mode = pg8::EPI_PLAIN; E.O0 = ws + WS_PROJ; E.ldc = 3072;
                } else if (op == OP_OUT) { g.A = (const bf16*)(ws + (kind_of(L) == 2 ? WS_OGSC : WS_Q)); g.Bt = (const bf16*)(ws + WS_WOUT); g.N = 1024; g.K = 1024; nM = 64; nN = 4; E.mode = pg8::EPI_RES; E.O0 = Y; E.O1 = XB;
                } else if (op == OP_UP) { g.A = XB - (size_t)2 * 1024; g.Bt = (const bf16*)(ws + WS_WUP); g.N = NFF; g.K = 1024; g.amode = 1; nM = 67; nN = 22; E.mode = pg8::EPI_UPCONV; E.O0 = ws + WS_H; E.aux = as_global(p.in[wout_of(L) + 4]);
                } else { g.A = (const bf16*)(ws + WS_H); g.Bt = (const bf16*)(ws + WS_WDN); g.N = 1024; g.K = DFF; nM = 64; nN = 4; E.mode = pg8::EPI_RES; E.O0 = Y; E.O1 = XB; }
                pg8::StaticOrder S; S.init(nM, nN, gdim, bid);
                pg8::gemm_phase<pg8::Epi, pg8::StaticOrder, true, true>(lds, g, S, E);
            }
        } else if (op == OP_HG_R1) { FRESH(); hg_r1(p, ws, wave, lane);
        } else if (op == OP_HG_R2) { FRESH(); hg_r2(p, ws, tid);
        } else if (op == OP_HG_R3) { FRESH(); hg_r3(p, ws, L, lds, tid, wave, lane);
        } else if (op == OP_MB_KMEAN) { FRESH(); mb_kmean(p, ws, lds, tid, wave, lane);
        } else if (op == OP_MB_GATE) { FRESH(); mb_gate(p, ws, lds, tid);
        } else if (op == OP_MB_SEL) { FRESH(); mb_sel(p, ws, lds, tid, wave, lane);
        } else if (op == OP_MB_OWN) { FRESH(); mb_own(p, ws, lds, tid, wave, lane);
        } else if (op == OP_SC_CONV) { FRESH(); sc_conv(p, ws, L, tid);
        } else if (op == OP_LN1 || op == OP_LN2) { FRESH();
            const int wo = wout_of(L); const float* gg = as_global(p.in[wo + (op == OP_LN1 ? 1 : 6)]); const float* bb = as_global(p.in[wo + (op == OP_LN1 ? 2 : 7)]);
            const bool fin = (op == OP_LN2 && L == 3);
            for (int r = gw; r < M; r += NGW) ln_row(Y + (size_t)r * D, gg, bb, fin ? nullptr : XB + (size_t)r * D, fin ? Y + (size_t)r * D : nullptr, lane);
            if (op == OP_LN2 && L < 3) convert_weights(p, ws, L + 1, lds, gw, NGW, wave, lane);
        }
        else if (op == OP_CONVW) { FRESH(); convert_weights(p, ws, L, lds, gw, NGW, wave, lane); }
        else if (op == OP_DIAG1) { FRESH(); const unsigned short* R = (const unsigned short*)(ws + DIAG_OFF); unsigned bad = 0;
            for (size_t i = (size_t)bid * 512 + tid; i < (size_t)DIAG_ELEMS; i += (size_t)gdim * 512) { const unsigned short v = R[i]; if ((v & 0x7f80u) == 0x7f80u) bad = 1; }
            if (bad) atomicOr((unsigned*)(ws + 3 * 1024), 1u); }
        else if (op == OP_DIAG2) { FRESH(); const float A = (*(const unsigned*)(ws + 3 * 1024)) ? 3.0f : 0.0f; for (size_t i = (size_t)bid * 512 + tid; i < (size_t)M * D; i += (size_t)gdim * 512) Y[i] = A; }
        else if (op == OP_DUMP) { FRESH(); for (size_t i = (size_t)bid * 512 + tid; i < (size_t)M * D; i += (size_t)gdim * 512) Y[i] = bf2f(XB[i]); }
        if (pi + 1 < p.hi) {
            if (p.nprog < 0) cg::this_grid().sync();
            GRID_BAR();
#if DUP_SYNC
            GRID_BAR();
#endif
        }
    }
}

extern "C" void kernel_launch(void* const* d_in, const int* in_sizes, int n_in, void* d_out, int out_size, void* d_ws, size_t ws_size, hipStream_t stream) {
    static int grid = 0;
    if (grid == 0) {
        if (n_in != 42 || out_size != M * D || ws_size < WS_NEED) { fprintf(stderr, "kernel_launch: unexpected shapes (n_in %d out %d ws %zu need %zu)\n", n_in, out_size, ws_size, (size_t)WS_NEED); grid = -1; return; }
        int dev = 0, cus = 0, per_cu = 0;
        hipGetDevice(&dev); hipDeviceGetAttribute(&cus, hipDeviceAttributeMultiprocessorCount, dev);
        hipFuncSetAttribute((const void*)mk_fwd, hipFuncAttributeMaxDynamicSharedMemorySize, LDS_BYTES);
        hipOccupancyMaxActiveBlocksPerMultiprocessor(&per_cu, (const void*)mk_fwd, 512, LDS_BYTES);
        (void)hipGetLastError();
        if (per_cu < 1) per_cu = 1;
        grid = cus * 1;
        if (grid > 256) grid = 256;
    }
    if (grid < 0) return;
    Params p{};
    for (int i = 0; i < 42; ++i) p.in[i] = (const float*)d_in[i];
    p.out = (float*)d_out; p.ws = (unsigned char*)d_ws;
    int n = 0;
    p.prog[n++] = OP_PRO;
#ifndef DBG_MIX
#define DBG_MIX 15
#endif
#ifndef DBG_FFN
#define DBG_FFN 15
#endif
    bool have_w = true, out_done = false;
    for (int L = 0; L < 4; ++L) { const int k = L % 3; const unsigned char lb = (unsigned char)(L << 5);
        const bool mix = (DBG_MIX >> L) & 1, ffn = (DBG_FFN >> L) & 1;
        if (!have_w && (mix || ffn)) { p.prog[n++] = lb | OP_CONVW; have_w = true; }
        if (mix) {
            if (k == 0) { p.prog[n++] = lb | OP_HG_IN;
#ifndef DBG_SKIPR
#define DBG_SKIPR 0
#endif
                if (!(DBG_SKIPR & 1)) p.prog[n++] = lb | OP_HG_R1;
#ifdef DBG_DIAG_AFTER_R1
                p.prog[n++] = OP_DIAG1; p.prog[n++] = OP_DIAG2; goto prog_done;
#endif
 if (!(DBG_SKIPR & 2)) p.prog[n++] = lb | OP_HG_R2; if (!(DBG_SKIPR & 4)) p.prog[n++] = lb | OP_HG_R3; }
            else if (k == 1) { p.prog[n++] = lb | OP_MB_IN; p.prog[n++] = lb | OP_MB_KMEAN; p.prog[n++] = lb | OP_MB_GATE; p.prog[n++] = lb | OP_MB_SEL; p.prog[n++] = lb | OP_MB_OWN; }
            else { p.prog[n++] = lb | OP_SC_IN; p.prog[n++] = lb | OP_SC_CONV; }
            p.prog[n++] = lb | OP_OUT; p.prog[n++] = lb | OP_LN1; }
        if (ffn) { p.prog[n++] = lb | OP_UP; p.prog[n++] = lb | OP_DOWN; p.prog[n++] = lb | OP_LN2; out_done = (L == 3); }
        else have_w = false; }
    if (!out_done) p.prog[n++] = OP_DUMP;
prog_done:
    p.nprog = n;
#if ONE_LAUNCH
    p.lo = 0; p.hi = n;
    if (hipMemsetAsync((char*)d_ws + WS_BAR, 0, BAR_ZERO_BYTES, stream) != hipSuccess) { fprintf(stderr, "memset of barrier words failed\n"); return; }
    void* args[] = {&p};
    hipError_t e = hipLaunchCooperativeKernel((const void*)mk_fwd, dim3(grid), dim3(512), args, LDS_BYTES, stream);
    if (e != hipSuccess) fprintf(stderr, "cooperative launch failed: %s (grid %d)\n", hipGetErrorString(e), grid);
#else
    for (int i = 0; i < n; ++i) { p.lo = i; p.hi = i + 1; hipLaunchKernelGGL(mk_fwd, dim3(grid), dim3(512), LDS_BYTES, stream, p); }
#endif
}
```

```cpp
#include <hip/hip_runtime.h>
#include <hip/hip_cooperative_groups.h>
#include <cstdio>
#include <cstdint>
namespace cg = cooperative_groups;

#ifndef ONE_LAUNCH
#define ONE_LAUNCH 1
#endif
#define DBG_SKIPR 0
#define R1_VAR 0
#ifndef DUP_SYNC
#define DUP_SYNC 0
#endif
#ifndef DUP_GEMM
#define DUP_GEMM 0
#endif

namespace pg8 {
#define PG8_LAS __attribute__((address_space(3)))
typedef unsigned short bf16_t;
typedef short bf16x8 __attribute__((ext_vector_type(8)));
typedef float f32x4 __attribute__((ext_vector_type(4)));
typedef unsigned u32x4 __attribute__((ext_vector_type(4)));
constexpr int BM = 256, BK = 64, HALF = 128, HTB = HALF * BK * 2  , STAGE_BYTES = 8 * HTB, NXCD = 8, WGM = 8;

__host__ __device__ __forceinline__ int lds_byte(int r, int c) { const int st = (r >> 4) * 2 + (c >> 5), rr = r & 15, cc = c & 31, ob = rr * 64 + cc * 2; return st * 1024 + (ob ^ (((ob >> 9) & 1) << 5)); }
__host__ __device__ __forceinline__ void stage_rc(int b, int& R, int& C) { const int st = b / 1024, sb = b % 1024, swz = sb ^ (((sb >> 9) & 1) << 5); R = (st >> 1) * 16 + swz / 64; C = (st & 1) * 32 + (swz % 64) / 2; }
__host__ __device__ __forceinline__ int perm32(int rho) { const int n = rho >> 4, i = rho & 15; return 8 * (i >> 2) + 4 * n + (i & 3); }

struct Unit { int pm, pn; };
struct Gemm { const bf16_t* A; const bf16_t* Bt; int M, N, K, amode; };

typedef float f32x2_t __attribute__((ext_vector_type(2))); typedef __bf16 bf16x2_t __attribute__((ext_vector_type(2)));
__device__ __forceinline__ unsigned cvt_pk_bf16(float lo, float hi) { f32x2_t v = {lo, hi}; bf16x2_t b = __builtin_convertvector(v, bf16x2_t); return __builtin_bit_cast(unsigned, b); }

struct StaticOrder {
    int nM, nN, nwg, G, c;
    __host__ __device__ void init(int nM_, int nN_, int G_, int c_) { nM = nM_; nN = nN_; nwg = nM * nN; G = G_; c = c_; }
    __host__ __device__ bool next(int i, Unit& u) const {
        const long L = (long)i * G + c; if (L >= nwg) return false;
        int wgid = (int)L; { const int q = nwg / NXCD, r = nwg % NXCD, xcd = wgid % NXCD, off = wgid / NXCD; wgid = (xcd < r ? xcd * (q + 1) : r * (q + 1) + (xcd - r) * q) + off; }
        const int nig = WGM * nN, gid = wgid / nig, fm = gid * WGM, gsz = (nM - fm) < WGM ? (nM - fm) : WGM;
        u.pm = fm + ((wgid % nig) % gsz); u.pn = (wgid % nig) / gsz; return true;
    }
    __device__ __forceinline__ void a_ready(const Unit&) const {}
    __device__ __forceinline__ void done(const Unit&) const {}
};

typedef unsigned u32x2 __attribute__((ext_vector_type(2)));
typedef _Float16 h16x4 __attribute__((ext_vector_type(4)));
__device__ __forceinline__ float bf_lo(unsigned w) { return __uint_as_float(w << 16); }
__device__ __forceinline__ float bf_hi(unsigned w) { return __uint_as_float(w & 0xffff0000u); }
__device__ __forceinline__ float silu_f(float x) { return x * __builtin_amdgcn_rcpf(1.0f + __builtin_amdgcn_exp2f(-1.4426950408889634f * x)); }
__device__ __forceinline__ float ror1(float x) { return __int_as_float(__builtin_amdgcn_update_dpp(0, __float_as_int(x), 0x121, 0xF, 0xF, false)); }
__device__ __forceinline__ float ror2(float x) { return __int_as_float(__builtin_amdgcn_update_dpp(0, __float_as_int(x), 0x122, 0xF, 0xF, false)); }
__device__ const double ROPE_F[16] = {0.15915494309189535, 0.070086521587798503, 0.03086376340470123, 0.013591370636193905, 0.0059851857127137054, 0.002635675898667414, 0.001160663641240061, 0.00051111750453754386,
    0.00022507907903927653, 9.9117309369019355e-05, 4.3647952792802891e-05, 1.9221100684944863e-05, 8.4643308082414014e-06, 3.7274086019153519e-06, 1.6414262627950345e-06, 7.2282930688328648e-07};
constexpr int TOK = 16384;
constexpr float DN_ALPHA = 1.6817928305074290f;
enum { EPI_SILU_SPLIT = 0, EPI_PLAIN = 1, EPI_ROPE_SPLIT = 2, EPI_T_HGRN = 3, EPI_T_PLAIN = 4, EPI_RES = 5, EPI_UPCONV = 6 };
struct Epi {
    static constexpr bool PERM = false, AFTER_DRAIN = false;
    int mode, ldc; void* O0; void* O1; const float* aux; const int* pos;
    __device__ __forceinline__ void st4(bf16_t* p, f32x4 v) const { u32x2 w; w.x = cvt_pk_bf16(v[0], v[1]); w.y = cvt_pk_bf16(v[2], v[3]); *(u32x2*)p = w; }
    __device__ __forceinline__ void operator()(const f32x4 (&acc)[2][2][4][2], const Unit& u, int wr, int wc, int fr, int fq) const {
        const int row0 = u.pm * BM + wr * 64 + fr, col0 = u.pn * BM + wc * 32 + 4 * fq;
        if (mode == EPI_RES) {
            float* Y = (float*)O0; const bf16_t* XB = (const bf16_t*)O1;
#pragma unroll
            for (int ai = 0; ai < 2; ++ai)
#pragma unroll
                for (int m = 0; m < 4; ++m) { const size_t ro = (size_t)(row0 + ai * HALF + m * 16) * 1024 + col0;
#pragma unroll
                    for (int bj = 0; bj < 2; ++bj)
#pragma unroll
                        for (int n = 0; n < 2; ++n) { const size_t o = ro + bj * HALF + n * 16; const u32x2 xw = *(const u32x2*)(XB + o);
                            f32x4 r; r[0] = DN_ALPHA * bf_lo(xw.x) + acc[ai][bj][m][n][0]; r[1] = DN_ALPHA * bf_hi(xw.x) + acc[ai][bj][m][n][1];
                            r[2] = DN_ALPHA * bf_lo(xw.y) + acc[ai][bj][m][n][2]; r[3] = DN_ALPHA * bf_hi(xw.y) + acc[ai][bj][m][n][3];
                            *(f32x4*)(Y + o) = r; } }
        } else if (mode == EPI_UPCONV) {
            bf16_t* H = (bf16_t*)O0; const float* cw = aux;
            const int cbase = 128 * u.pn + 32 * wc + 4 * fq;
#pragma unroll
            for (int n = 0; n < 2; ++n) {
                const f32x4 wa0 = *(const f32x4*)(cw + cbase + 16 * n), wa1 = *(const f32x4*)(cw + 5632 + cbase + 16 * n), wa2 = *(const f32x4*)(cw + 2 * 5632 + cbase + 16 * n);
                const f32x4 wb0 = *(const f32x4*)(cw + 2816 + cbase + 16 * n), wb1 = *(const f32x4*)(cw + 5632 + 2816 + cbase + 16 * n), wb2 = *(const f32x4*)(cw + 2 * 5632 + 2816 + cbase + 16 * n);
#pragma unroll
                for (int ai = 0; ai < 2; ++ai) { const int tok0 = 248 * u.pm + 62 * (2 * ai + wr) - 2;
                    f32x4 pa1 = {0.f, 0.f, 0.f, 0.f}, pa2 = pa1, pb1 = pa1, pb2 = pa1;
#pragma unroll
                    for (int m = 0; m < 4; ++m) { const int rho = 16 * m + fr, tok = tok0 + rho;
                        const f32x4 za = acc[ai][0][m][n], zb = acc[ai][1][m][n]; f32x4 ra1, ra2, rb1, rb2, hv;
#pragma unroll
                        for (int e = 0; e < 4; ++e) { ra1[e] = ror1(za[e]); ra2[e] = ror2(za[e]); rb1[e] = ror1(zb[e]); rb2[e] = ror2(zb[e]); }
#pragma unroll
                        for (int e = 0; e < 4; ++e) {
                            float a1 = fr == 0 ? pa1[e] : ra1[e], a2 = fr < 2 ? pa2[e] : ra2[e], b1 = fr == 0 ? pb1[e] : rb1[e], b2 = fr < 2 ? pb2[e] : rb2[e];
                            if (tok < 1) { a1 = 0.f; b1 = 0.f; } if (tok < 2) { a2 = 0.f; b2 = 0.f; }
                            const float ua = wa2[e] * za[e] + wa1[e] * a1 + wa0[e] * a2, ub = wb2[e] * zb[e] + wb1[e] * b1 + wb0[e] * b2;
                            hv[e] = silu_f(ua) * ub; }
                        if (rho >= 2 && tok < TOK) st4(H + (size_t)tok * 2816 + cbase + 16 * n, hv);
                        pa1 = ra1; pa2 = ra2; pb1 = rb1; pb2 = rb2; }
                    asm volatile("" ::: "memory"); } }
        } else if (mode == EPI_T_HGRN || mode == EPI_T_PLAIN) {
            const bool isg = (mode == EPI_T_HGRN) && (u.pm < 4);
            bf16_t* base = (mode == EPI_T_HGRN && u.pm >= 4) ? (bf16_t*)O1 - (size_t)1024 * TOK : (bf16_t*)O0;
#pragma unroll
            for (int ai = 0; ai < 2; ++ai)
#pragma unroll
                for (int m = 0; m < 4; ++m) { const int r = row0 + ai * HALF + m * 16; const size_t ro = (size_t)r * TOK + col0; const float lb = isg ? aux[r] : 0.f;
#pragma unroll
                    for (int bj = 0; bj < 2; ++bj)
#pragma unroll
                        for (int n = 0; n < 2; ++n) { const f32x4 v = acc[ai][bj][m][n]; bf16_t* p = base + ro + bj * HALF + n * 16;
                            if (isg) { h16x4 hg;
#pragma unroll
                                for (int e = 0; e < 4; ++e) { const float sg = __builtin_amdgcn_rcpf(1.0f + __expf(-v[e])); hg[e] = (_Float16)__logf(lb + (1.0f - lb) * sg); }
                                *(h16x4*)p = hg; }
                            else st4(p, v); } }
        } else {
            int colt = u.pn * BM; bf16_t* base = (bf16_t*)O0;
            if (mode != EPI_PLAIN) { if (colt >= 1024) { base = (bf16_t*)O1; colt -= 1024; } }
            const int c0 = colt + wc * 32 + 4 * fq;
            double rf[4];
#pragma unroll
            for (int e = 0; e < 4; ++e) rf[e] = ROPE_F[4 * fq + e];
#pragma unroll
            for (int ai = 0; ai < 2; ++ai)
#pragma unroll
                for (int m = 0; m < 4; ++m) { const int r = row0 + ai * HALF + m * 16; bf16_t* rowp = base + (size_t)r * ldc + c0;
                    float cs[4], sn[4];
                    if (mode == EPI_ROPE_SPLIT && wc == 0) { const double pp = (double)pos[r];
#pragma unroll
                        for (int e = 0; e < 4; ++e) { double tt = pp * rf[e]; tt -= __builtin_floor(tt); const float tf = (float)tt; sn[e] = __builtin_amdgcn_sinf(tf); cs[e] = __builtin_amdgcn_cosf(tf); } }
#pragma unroll
                    for (int bj = 0; bj < 2; ++bj) { f32x4 v0 = acc[ai][bj][m][0], v1 = acc[ai][bj][m][1];
                        if (mode == EPI_SILU_SPLIT) {
#pragma unroll
                            for (int e = 0; e < 4; ++e) { v0[e] = silu_f(v0[e]); v1[e] = silu_f(v1[e]); } }
                        if (mode == EPI_ROPE_SPLIT && wc == 0) {
#pragma unroll
                            for (int e = 0; e < 4; ++e) { const float x1 = v0[e], x2 = v1[e]; v0[e] = x1 * cs[e] - x2 * sn[e]; v1[e] = x2 * cs[e] + x1 * sn[e]; } }
                        st4(rowp + bj * HALF, v0); st4(rowp + bj * HALF + 16, v1); } }
        }
    }
};

template <class Epi, class Sched, bool ALIGN_EPI = false, bool SP2 = false>
__device__ __forceinline__ void gemm_phase(PG8_LAS unsigned char* lds, const Gemm g, const Sched& S, const Epi& E) {
    int tid = threadIdx.x; asm volatile("" : "+v"(tid));
    const int wid = __builtin_amdgcn_readfirstlane(tid >> 6), lane = tid & 63, wr = wid >> 2, wc = wid & 3, fr = lane & 15, fq = lane >> 4;
    const int K = g.K, nt = K / BK;
    unsigned voffA[2], voffB[2];
#pragma unroll
    for (int i = 0; i < 2; ++i) { int R, C; stage_rc(tid * 16 + i * 8192, R, C); const int Rb = Epi::PERM ? ((R & ~31) + perm32(R & 31)) : R;
        voffA[i] = (unsigned)((g.amode ? (R - 2 * (R >> 6)) : R) * K + C) * 2u; voffB[i] = (unsigned)(Rb * K + C) * 2u; }
    const size_t kstep = (size_t)(BK * 2);
    const size_t hstep = (size_t)HALF * K * 2;
    const size_t tstep = 2 * hstep;  const size_t hstepA = g.amode ? (size_t)124 * K * 2 : hstep, tstepA = 2 * hstepA;
    const unsigned ldsw = (unsigned)wid * 1024u;
    const int aoff = lds_byte(wr * 64 + fr, fq * 8), boff = lds_byte(wc * 32 + fr, fq * 8);
#define PG8_SA(b, h) (((b) * 2 + (h)) * HTB)
#define PG8_SB(b, h) ((4 + (b) * 2 + (h)) * HTB)
#define PG8_STAGE(bufoff, gbase, voff) do { _Pragma("unroll") for (int _i = 0; _i < 2; ++_i) \
        __builtin_amdgcn_global_load_lds((const unsigned*)((const char*)(gbase) + (voff)[_i]), (PG8_LAS unsigned*)(lds + (bufoff) + ldsw + _i * 8192), 16, 0, 0); } while (0)
#define PG8_LDA(dst, b, h) do { _Pragma("unroll") for (int m = 0; m < 4; ++m) _Pragma("unroll") for (int k = 0; k < 2; ++k) dst[m][k] = *(const PG8_LAS bf16x8*)(lds + PG8_SA(b, h) + aoff + m * 2048 + k * 1024); } while (0)
#define PG8_LDB(dst, b, h) do { _Pragma("unroll") for (int n = 0; n < 2; ++n) _Pragma("unroll") for (int k = 0; k < 2; ++k) dst[n][k] = *(const PG8_LAS bf16x8*)(lds + PG8_SB(b, h) + boff + n * 2048 + k * 1024); } while (0)
#define PG8_MMA(ai, bj, At, Bt) do { __builtin_amdgcn_s_setprio(1); _Pragma("unroll") for (int m = 0; m < 4; ++m) _Pragma("unroll") for (int n = 0; n < 2; ++n) _Pragma("unroll") for (int k = 0; k < 2; ++k) \
        acc[ai][bj][m][n] = __builtin_amdgcn_mfma_f32_16x16x32_bf16(Bt[n][k], At[m][k], acc[ai][bj][m][n], 0, 0, 0); __builtin_amdgcn_s_setprio(0); } while (0)
#define PG8_WAIT_V(n) asm volatile("s_waitcnt vmcnt(" #n ")" ::: "memory")
#define PG8_WAIT_L(n) asm volatile("s_waitcnt lgkmcnt(" #n ")" ::: "memory")
#define PG8_BAR __builtin_amdgcn_s_barrier()
#define PG8_SCHED __builtin_amdgcn_sched_barrier(0)
    Unit cur, nxt; int ui = 0;
    if (!S.next(0, cur)) return;
    f32x4 acc[2][2][4][2];
#pragma unroll
    for (int a = 0; a < 2; ++a)
#pragma unroll
        for (int b = 0; b < 2; ++b)
#pragma unroll
            for (int m = 0; m < 4; ++m)
#pragma unroll
                for (int n = 0; n < 2; ++n) acc[a][b][m][n] = (f32x4){0.f, 0.f, 0.f, 0.f};
    bf16x8 At[4][2], B0[2][2], B1[2][2];
    const char* cA = (const char*)g.A + (size_t)cur.pm * tstepA; const char* cB = (const char*)g.Bt + (size_t)cur.pn * tstep;
    S.a_ready(cur);
    if constexpr (SP2) {
        PG8_STAGE(PG8_SB(0, 0), cB, voffB); PG8_STAGE(PG8_SB(0, 1), cB + hstep, voffB); PG8_STAGE(PG8_SA(0, 0), cA, voffA); PG8_STAGE(PG8_SA(0, 1), cA + hstepA, voffA);
        if (wr == 1) PG8_BAR;
        PG8_WAIT_V(2); PG8_BAR;
        PG8_STAGE(PG8_SB(1, 0), cB + kstep, voffB); PG8_STAGE(PG8_SA(1, 0), cA + kstep, voffA); PG8_STAGE(PG8_SB(1, 1), cB + hstep + kstep, voffB);
        PG8_WAIT_V(6); PG8_BAR;
    } else {
        PG8_STAGE(PG8_SB(0, 0), cB, voffB); PG8_STAGE(PG8_SA(0, 0), cA, voffA); PG8_STAGE(PG8_SB(0, 1), cB + hstep, voffB); PG8_STAGE(PG8_SA(0, 1), cA + hstepA, voffA);
        if (wr == 1) PG8_BAR;
        PG8_WAIT_V(4); PG8_BAR;
        PG8_STAGE(PG8_SB(1, 0), cB + kstep, voffB); PG8_STAGE(PG8_SA(1, 0), cA + kstep, voffA); PG8_STAGE(PG8_SB(1, 1), cB + hstep + kstep, voffB);
        PG8_WAIT_V(6); PG8_BAR;
    }
    for (;;) {
        const bool has_next = S.next(ui + 1, nxt);
        const char* nA = has_next ? (const char*)g.A + (size_t)nxt.pm * tstepA : cA; const char* nB = has_next ? (const char*)g.Bt + (size_t)nxt.pn * tstep : cB;
        for (int t = 0; t < nt; t += 2) {
            const bool last = (t == nt - 2);
            const char* a1 = cA + (size_t)(t + 1) * kstep;
            const char* a2 = last ? nA : cA + (size_t)(t + 2) * kstep; const char* b2 = last ? nB : cB + (size_t)(t + 2) * kstep;
            const char* a3 = a2 + kstep; const char* b3 = b2 + kstep;
            if (last && has_next) S.a_ready(nxt);
            if constexpr (SP2) {
            PG8_LDB(B0, 0, 0); PG8_LDB(B1, 0, 1); PG8_SCHED; PG8_LDA(At, 0, 0); PG8_STAGE(PG8_SA(1, 1), a1 + hstepA, voffA);
            PG8_WAIT_V(8); PG8_WAIT_L(0); PG8_BAR; PG8_MMA(0, 0, At, B0); PG8_MMA(0, 1, At, B1); PG8_BAR; PG8_SCHED;
            PG8_LDA(At, 0, 1); PG8_STAGE(PG8_SB(0, 0), b2, voffB); PG8_STAGE(PG8_SB(0, 1), b2 + hstep, voffB); PG8_STAGE(PG8_SA(0, 0), a2, voffA);
            PG8_WAIT_V(8); PG8_WAIT_L(0); PG8_BAR; PG8_MMA(1, 0, At, B0); PG8_MMA(1, 1, At, B1); PG8_BAR; PG8_SCHED;
            PG8_LDB(B0, 1, 0); PG8_LDB(B1, 1, 1); PG8_SCHED; PG8_LDA(At, 1, 0); PG8_STAGE(PG8_SA(0, 1), a2 + hstepA, voffA);
            PG8_WAIT_V(8); PG8_WAIT_L(0); PG8_BAR; PG8_MMA(0, 0, At, B0); PG8_MMA(0, 1, At, B1); PG8_BAR; PG8_SCHED;
            PG8_LDA(At, 1, 1); PG8_STAGE(PG8_SB(1, 0), b3, voffB); PG8_STAGE(PG8_SB(1, 1), b3 + hstep, voffB); PG8_STAGE(PG8_SA(1, 0), a3, voffA);
            PG8_WAIT_V(8); PG8_WAIT_L(0); PG8_BAR; PG8_MMA(1, 0, At, B0); PG8_MMA(1, 1, At, B1); PG8_BAR; PG8_SCHED;
            } else {
            PG8_LDB(B0, 0, 0); PG8_SCHED; PG8_LDA(At, 0, 0); PG8_STAGE(PG8_SA(1, 1), a1 + hstepA, voffA);
            PG8_WAIT_L(8); PG8_BAR; PG8_WAIT_L(0); PG8_MMA(0, 0, At, B0); PG8_BAR; PG8_SCHED;
            PG8_LDB(B1, 0, 1); PG8_STAGE(PG8_SB(0, 0), b2, voffB);
            PG8_BAR; PG8_WAIT_L(0); PG8_MMA(0, 1, At, B1); PG8_BAR;
            PG8_LDA(At, 0, 1); PG8_STAGE(PG8_SA(0, 0), a2, voffA);
            PG8_BAR; PG8_WAIT_L(0); PG8_MMA(1, 0, At, B0); PG8_BAR; PG8_SCHED;
            PG8_STAGE(PG8_SB(0, 1), b2 + hstep, voffB);
            PG8_WAIT_V(6); PG8_BAR; PG8_MMA(1, 1, At, B1); PG8_BAR;
            PG8_LDB(B0, 1, 0); PG8_SCHED; PG8_LDA(At, 1, 0); PG8_STAGE(PG8_SA(0, 1), a2 + hstepA, voffA);
            PG8_WAIT_L(8); PG8_BAR; PG8_WAIT_L(0); PG8_MMA(0, 0, At, B0); PG8_BAR; PG8_SCHED;
            PG8_LDB(B1, 1, 1); PG8_STAGE(PG8_SB(1, 0), b3, voffB);
            PG8_BAR; PG8_WAIT_L(0); PG8_MMA(0, 1, At, B1); PG8_BAR;
            PG8_LDA(At, 1, 1); PG8_STAGE(PG8_SA(1, 0), a3, voffA);
            PG8_BAR; PG8_WAIT_L(0); PG8_MMA(1, 0, At, B0); PG8_BAR; PG8_SCHED;
            PG8_STAGE(PG8_SB(1, 1), b3 + hstep, voffB);
            PG8_WAIT_V(6); PG8_BAR; PG8_MMA(1, 1, At, B1); PG8_BAR;
            }
        }
        if constexpr (ALIGN_EPI) { if (wr == 0) PG8_BAR; }
        if constexpr (!Epi::AFTER_DRAIN) { E(acc, cur, wr, wc, fr, fq); S.done(cur); __builtin_amdgcn_s_waitcnt(0x0F70); }
        if (!has_next) break;
#pragma unroll
        for (int a = 0; a < 2; ++a)
#pragma unroll
            for (int b = 0; b < 2; ++b)
#pragma unroll
                for (int m = 0; m < 4; ++m)
#pragma unroll
                    for (int n = 0; n < 2; ++n) acc[a][b][m][n] = (f32x4){0.f, 0.f, 0.f, 0.f};
        cur = nxt; cA = nA; cB = nB; ++ui;
        if constexpr (ALIGN_EPI) { if (wr == 1) PG8_BAR; }
    }
    PG8_WAIT_V(0);
    if constexpr (!ALIGN_EPI) { if (wr == 0) PG8_BAR; }
    PG8_BAR;
    if constexpr (Epi::AFTER_DRAIN) { E.fused(acc, cur, wr, wc, fr, fq, lds, wid, lane); S.done(cur); }
#undef PG8_SA
#undef PG8_SB
#undef PG8_STAGE
#undef PG8_LDA
#undef PG8_LDB
#undef PG8_MMA
#undef PG8_WAIT_V
#undef PG8_WAIT_L
#undef PG8_BAR
#undef PG8_SCHED
}
}

#define LAS __attribute__((address_space(3)))
typedef unsigned short bf16;
typedef short bf16x8 __attribute__((ext_vector_type(8)));
typedef float f32x4 __attribute__((ext_vector_type(4)));
typedef unsigned u32x4 __attribute__((ext_vector_type(4)));
typedef unsigned u32x2 __attribute__((ext_vector_type(2)));
typedef _Float16 h16x8 __attribute__((ext_vector_type(8)));
using pg8::bf_lo; using pg8::bf_hi; using pg8::cvt_pk_bf16;

constexpr int M = 16384, D = 1024, DFF = 2816, NFF = 5632;
constexpr float LN_EPS = 1e-5f, RMS_EPS = 1e-6f;
constexpr size_t MiB = 1u << 20;
constexpr size_t WS_CNT = 0, WS_LBTAB = 4096, WS_KNMAX = 16384, WS_KMEAN = 65536, WS_QREF = 512 * 1024, WS_DEC = 1 * MiB, WS_LPART = 2 * MiB;
constexpr size_t WS_WIN = 4 * MiB, WS_WOUT = 12 * MiB, WS_WUP = 14 * MiB, WS_WDN = 25 * MiB;
constexpr size_t WS_XB = 32 * MiB, WS_L = 64 * MiB;
constexpr size_t WS_Q = WS_L, WS_GT = WS_L + 32 * MiB, WS_VT = WS_L + 64 * MiB, WS_GATE = WS_L + 96 * MiB, WS_ST = WS_L + 128 * MiB;
constexpr size_t WS_K = WS_L + 32 * MiB, WS_LIST = WS_L + 96 * MiB, WS_PART = WS_L + 104 * MiB;
constexpr size_t WS_PROJ = WS_L, WS_OGSC = WS_L + 96 * MiB;
constexpr size_t WS_H = WS_L;
constexpr size_t WS_NEED = WS_PART + 96 * MiB;
constexpr int LDS_BYTES = 147456;
constexpr size_t WS_BAR = 32 * 1024, BAR_ZERO_BYTES = 16 * 1024;
constexpr int LDS_BARST = LDS_BYTES - 16;
#ifndef DIAG_OFF
#define DIAG_OFF WS_VT
#define DIAG_ELEMS (16u << 20)
#endif
constexpr int LIST_PER_HEAD = 256 * 2016;

enum { OP_PRO = 0, OP_HG_IN, OP_HG_R1, OP_HG_R2, OP_HG_R3, OP_MB_IN, OP_MB_KMEAN, OP_MB_GATE, OP_MB_SEL, OP_MB_OWN, OP_SC_IN, OP_SC_CONV, OP_OUT, OP_LN1, OP_UP, OP_DOWN, OP_LN2, OP_CONVW, OP_DUMP, OP_DIAG1, OP_DIAG2 };
struct Params { const float* in[42]; float* out; unsigned char* ws; unsigned char prog[64]; int nprog, lo, hi, pad; };

template <class T> __device__ __forceinline__ T* as_global(T* q) { return (T*)(__attribute__((address_space(1))) T*)q; }
__device__ __forceinline__ unsigned f2bf(float f) { unsigned u = __float_as_uint(f); return (u + 0x7fffu + ((u >> 16) & 1u)) >> 16; }
__device__ __forceinline__ float bf2f(unsigned short b) { return __uint_as_float((unsigned)b << 16); }
__device__ __forceinline__ bf16x8 pack8(const float (&v)[8]) { u32x4 w; w.x = cvt_pk_bf16(v[0], v[1]); w.y = cvt_pk_bf16(v[2], v[3]); w.z = cvt_pk_bf16(v[4], v[5]); w.w = cvt_pk_bf16(v[6], v[7]); return __builtin_bit_cast(bf16x8, w); }
__device__ __forceinline__ void unpack8(bf16x8 x, float (&v)[8]) { const u32x4 w = __builtin_bit_cast(u32x4, x); v[0] = bf_lo(w.x); v[1] = bf_hi(w.x); v[2] = bf_lo(w.y); v[3] = bf_hi(w.y); v[4] = bf_lo(w.z); v[5] = bf_hi(w.z); v[6] = bf_lo(w.w); v[7] = bf_hi(w.w); }
__device__ __forceinline__ float wave_sum(float v) {
#pragma unroll
    for (int o = 1; o < 64; o <<= 1) v += __shfl_xor(v, o);
    return v;
}
#define MFMA16(a, b, c) __builtin_amdgcn_mfma_f32_16x16x32_bf16((a), (b), (c), 0, 0, 0)

__device__ __forceinline__ int kind_of(int L) { return L == 1 ? 1 : (L == 2 ? 2 : 0); }
__device__ __forceinline__ int base_of(int L) { return L == 0 ? 3 : (L == 1 ? 13 : (L == 2 ? 22 : 32)); }
__device__ __forceinline__ int wout_of(int L) { return base_of(L) + (L == 1 ? 1 : 2); }

__device__ __forceinline__ void transpose_item(const float* W, int ldw, int K, int col0, int ncols, bf16* WT, int drow0, int mode, LAS float* scr, int item, int lane) {
    const int nblk = ncols / 32, kb = item / nblk, nb = item % nblk, k0 = 64 * kb, n0 = 32 * nb;
    int dr;
    if (mode == 1) { const int c = n0; dr = c < DFF ? 256 * (c / 128) + (c % 128) : 256 * ((c - DFF) / 128) + 128 + ((c - DFF) % 128); } else dr = drow0 + n0;
    f32x4 wv[8];
#pragma unroll
    for (int i = 0; i < 8; ++i) wv[i] = *(const f32x4*)(W + (size_t)(k0 + 8 * i + (lane >> 3)) * ldw + col0 + n0 + 4 * (lane & 7));
#pragma unroll
    for (int i = 0; i < 8; ++i) { LAS float* d = scr + (8 * i + (lane >> 3)) * 33 + 4 * (lane & 7); d[0] = wv[i][0]; d[1] = wv[i][1]; d[2] = wv[i][2]; d[3] = wv[i][3]; }
    asm volatile("s_waitcnt lgkmcnt(0)" ::: "memory");
    const int c = lane & 7;
#pragma unroll
    for (int j = 0; j < 4; ++j) { const int n = (lane >> 3) + 8 * j; const LAS float* s = scr + (8 * c) * 33 + n;
        u32x4 o; o.x = cvt_pk_bf16(s[0 * 33], s[1 * 33]); o.y = cvt_pk_bf16(s[2 * 33], s[3 * 33]); o.z = cvt_pk_bf16(s[4 * 33], s[5 * 33]); o.w = cvt_pk_bf16(s[6 * 33], s[7 * 33]);
        *(u32x4*)(WT + (size_t)(dr + n) * K + k0 + 8 * c) = o; }
    asm volatile("s_waitcnt lgkmcnt(0)" ::: "memory");
}
__device__ __forceinline__ void convert_weights(const Params& p, unsigned char* ws, int L, LAS unsigned char* lds, int gw, int NGW, int wave, int lane) {
    LAS float* scr = (LAS float*)(lds + wave * 16384);
    const int kind = kind_of(L), wo = wout_of(L);
    const float* w_in = as_global(p.in[base_of(L)]); const float* w_out = as_global(p.in[wo]); const float* w_up = as_global(p.in[wo + 3]); const float* w_dn = as_global(p.in[wo + 5]);
    bf16* WIN = (bf16*)(ws + WS_WIN); bf16* WOUT = (bf16*)(ws + WS_WOUT); bf16* WUP = (bf16*)(ws + WS_WUP); bf16* WDN = (bf16*)(ws + WS_WDN);
    const int ldin = kind == 0 ? 4096 : 3072;
    const int n0 = (kind == 0 ? 1024 : 3072), n1 = (kind == 0 ? 1024 : 0), n2 = (kind == 0 ? 2048 : 0);
    const int i0 = 16 * (n0 / 32), i1 = 16 * (n1 / 32), i2 = 16 * (n2 / 32), i3 = 16 * 32, i4 = 16 * (NFF / 32), i5 = (DFF / 64) * 32;
    const int total = i0 + i1 + i2 + i3 + i4 + i5;
    for (int it = gw; it < total; it += NGW) {
        int r = it;
        if (r < i0) { transpose_item(w_in, ldin, 1024, 0, n0, WIN, 0, 0, scr, r, lane); continue; } r -= i0;
        if (r < i1) { transpose_item(w_in, ldin, 1024, 3072, n1, WIN, 1024, 0, scr, r, lane); continue; } r -= i1;
        if (r < i2) { transpose_item(w_in, ldin, 1024, 1024, n2, WIN, 2048, 0, scr, r, lane); continue; } r -= i2;
        if (r < i3) { transpose_item(w_out, 1024, 1024, 0, 1024, WOUT, 0, 0, scr, r, lane); continue; } r -= i3;
        if (r < i4) { transpose_item(w_up, NFF, 1024, 0, NFF, WUP, 0, 1, scr, r, lane); continue; } r -= i4;
        transpose_item(w_dn, 1024, DFF, 0, 1024, WDN, 0, 0, scr, r, lane);
    }
}

__device__ __forceinline__ void ln_row(const float* yrow, const float* g, const float* b, bf16* orow, float* frow, int lane) {
    const f32x4* xr = (const f32x4*)yrow + lane;
    f32x4 v[4]; float s = 0.f;
#pragma unroll
    for (int j = 0; j < 4; ++j) { v[j] = xr[64 * j]; s += (v[j].x + v[j].y) + (v[j].z + v[j].w); }
    const float mean = wave_sum(s) * (1.f / D); float s2 = 0.f;
#pragma unroll
    for (int j = 0; j < 4; ++j) { v[j] = v[j] - mean; s2 += (v[j].x * v[j].x + v[j].y * v[j].y) + (v[j].z * v[j].z + v[j].w * v[j].w); }
    const float rstd = 1.f / sqrtf(wave_sum(s2) * (1.f / D) + LN_EPS);
#pragma unroll
    for (int j = 0; j < 4; ++j) { const f32x4 gg = ((const f32x4*)g)[lane + 64 * j], bb = ((const f32x4*)b)[lane + 64 * j]; const f32x4 o = v[j] * rstd * gg + bb;
        if (orow) { u32x2 w; w.x = cvt_pk_bf16(o.x, o.y); w.y = cvt_pk_bf16(o.z, o.w); ((u32x2*)orow)[lane + 64 * j] = w; }
        if (frow) ((f32x4*)frow)[lane + 64 * j] = o; }
}

__device__ __forceinline__ void hg_prefix(const h16x8 v0, const h16x8 v1, int fr, int fq, float (&g)[2][8], float (&b)[2][8], float& blast) {
    float t0 = 0.f, t1 = 0.f;
#pragma unroll
    for (int j = 0; j < 8; ++j) { g[0][j] = (float)v0[j]; t0 += g[0][j]; b[0][j] = t0; g[1][j] = (float)v1[j]; t1 += g[1][j]; b[1][j] = t1; }
    float off0 = 0.f, off1 = 0.f, sum0 = 0.f, sum1 = 0.f;
#pragma unroll
    for (int q = 0; q < 4; ++q) { const float a0 = __shfl(t0, fr + 16 * q), a1 = __shfl(t1, fr + 16 * q); if (q < fq) { off0 += a0; off1 += a1; } sum0 += a0; sum1 += a1; }
#pragma unroll
    for (int j = 0; j < 8; ++j) { b[0][j] += off0; b[1][j] += sum0 + off1; }
    blast = sum0 + sum1;
}

__device__ __forceinline__ void hg_r1(const Params& p, unsigned char* ws, int wave, int lane) {
    int bid = blockIdx.x, gdim = gridDim.x; asm volatile("" : "+s"(bid), "+s"(gdim));
    const _Float16* GT = (const _Float16*)(ws + WS_GT); const bf16* VT = (const bf16*)(ws + WS_VT); bf16* ST = (bf16*)(ws + WS_ST); float* DEC = (float*)(ws + WS_DEC);
    const int fr = lane & 15, fq = lane >> 4;
    for (int unit = bid; unit < 2048; unit += gdim) {
        const int h = unit >> 8, c = unit & 255, d = 16 * wave + fr;
        float g[2][8], b[2][8], blast;
        const _Float16* grow = GT + (size_t)(h * 128 + d) * M + c * 64;
        const h16x8 gv0 = *(const h16x8*)(grow + 8 * fq), gv1 = *(const h16x8*)(grow + 32 + 8 * fq);
        bf16x8 bfrv[8][2];
#pragma unroll
        for (int nt = 0; nt < 8; ++nt)
#pragma unroll
            for (int ks = 0; ks < 2; ++ks) bfrv[nt][ks] = *(const bf16x8*)(VT + (size_t)(h * 128 + 16 * nt + fr) * M + c * 64 + 32 * ks + 8 * fq);
        hg_prefix(gv0, gv1, fr, fq, g, b, blast);
        bf16x8 afr[2];
#pragma unroll
        for (int ks = 0; ks < 2; ++ks) { float kd[8];
#pragma unroll
            for (int j = 0; j < 8; ++j) {
#if R1_VAR == 1
                kd[j] = (1.0f - __expf(g[ks][j]));
#elif R1_VAR == 2
                kd[j] = __expf(blast - b[ks][j]);
#elif R1_VAR == 3
                kd[j] = 1.0f;
#else
                kd[j] = (1.0f - __expf(g[ks][j])) * __expf(blast - b[ks][j]);
#endif
            }
            afr[ks] = pack8(kd); }
        if (fq == 0) DEC[(h * 256 + c) * 128 + d] = __expf(blast);
#pragma unroll
        for (int nt = 0; nt < 8; ++nt) { f32x4 acc = {0.f, 0.f, 0.f, 0.f};
#pragma unroll
            for (int ks = 0; ks < 2; ++ks) acc = MFMA16(afr[ks], bfrv[nt][ks], acc);
            u32x2 w; w.x = cvt_pk_bf16(acc[0], acc[1]); w.y = cvt_pk_bf16(acc[2], acc[3]);
            *(u32x2*)(ST + ((size_t)(h * 256 + c) * 128 + 16 * nt + fr) * 128 + 16 * wave + 4 * fq) = w; }
    }
}
__device__ __forceinline__ void hg_r2(const Params& p, unsigned char* ws, int tid) {
    int bid = blockIdx.x, gdim = gridDim.x; asm volatile("" : "+s"(bid), "+s"(gdim));
    bf16* ST = (bf16*)(ws + WS_ST); const float* DEC = (const float*)(ws + WS_DEC);
    for (int e = bid * 512 + tid; e < 131072; e += gdim * 512) {
        const int h = e >> 14, r = e & 16383, d = r & 127;
        bf16* sp = ST + (size_t)h * 256 * 16384 + r; const float* dp = DEC + h * 256 * 128 + d;
        float S = 0.f;
#pragma unroll 1
        for (int c = 0; c < 256; c += 32) { unsigned short loc[32]; float dc[32];
#pragma unroll
            for (int i = 0; i < 32; ++i) { loc[i] = sp[(size_t)(c + i) * 16384]; dc[i] = dp[(c + i) * 128]; }
#pragma unroll
            for (int i = 0; i < 32; ++i) { sp[(size_t)(c + i) * 16384] = (bf16)f2bf(S); S = dc[i] * S + bf2f(loc[i]); } }
    }
}
__device__ __forceinline__ void hg_r3(const Params& p, unsigned char* ws, int L, LAS unsigned char* lds, int tid, int wave, int lane) {
    int bid = blockIdx.x, gdim = gridDim.x; asm volatile("" : "+s"(bid), "+s"(gdim));
    const _Float16* GT = (const _Float16*)(ws + WS_GT); const bf16* VT = (const bf16*)(ws + WS_VT); const bf16* ST = (const bf16*)(ws + WS_ST);
    const bf16* Q = (const bf16*)(ws + WS_Q); const bf16* GATE = (const bf16*)(ws + WS_GATE); bf16* OG = (bf16*)(ws + WS_Q);
    const float* norm_g = as_global(p.in[base_of(L) + 1]);
    LAS float* bt = (LAS float*)lds; LAS float* red = bt + 65 * 132;
    const int fr = lane & 15, fq = lane >> 4;
    if (tid < 132) bt[tid] = 0.f;
    const int mt = wave >> 1, nh = wave & 1;
    for (int unit = bid; unit < 2048; unit += gdim) {
        const int h = unit >> 8, c = unit & 255;
        const int t = 16 * mt + fr; const size_t tok = (size_t)c * 64 + t;
        bf16x8 qraw[4], sfrv[4][4];
        { const int d = 16 * wave + fr; float g[2][8], b[2][8], blast;
            const _Float16* grow = GT + (size_t)(h * 128 + d) * M + c * 64;
            const h16x8 gv0 = *(const h16x8*)(grow + 8 * fq), gv1 = *(const h16x8*)(grow + 32 + 8 * fq);
#pragma unroll
            for (int ks = 0; ks < 4; ++ks) qraw[ks] = *(const bf16x8*)(Q + tok * 1024 + h * 128 + 32 * ks + 8 * fq);
#pragma unroll
            for (int n = 0; n < 4; ++n)
#pragma unroll
                for (int ks = 0; ks < 4; ++ks) sfrv[n][ks] = *(const bf16x8*)(ST + ((size_t)(h * 256 + c) * 128 + 16 * (4 * nh + n) + fr) * 128 + 32 * ks + 8 * fq);
            hg_prefix(gv0, gv1, fr, fq, g, b, blast);
#pragma unroll
            for (int ks = 0; ks < 2; ++ks)
#pragma unroll
                for (int j = 0; j < 8; ++j) bt[(32 * ks + 8 * fq + j + 1) * 132 + d] = b[ks][j]; }
        __syncthreads();
        bf16x8 qtil[4], qhat[4]; float Rr[4][8];
#pragma unroll
        for (int ks = 0; ks < 4; ++ks) { float qf[8], bq[8], a[8], a2[8];
            unpack8(qraw[ks], qf);
            const f32x4 b0 = *(const LAS f32x4*)(bt + (t + 1) * 132 + 32 * ks + 8 * fq), b1 = *(const LAS f32x4*)(bt + (t + 1) * 132 + 32 * ks + 8 * fq + 4);
            const f32x4 r0 = *(const LAS f32x4*)(bt + (16 * mt) * 132 + 32 * ks + 8 * fq), r1 = *(const LAS f32x4*)(bt + (16 * mt) * 132 + 32 * ks + 8 * fq + 4);
#pragma unroll
            for (int j = 0; j < 4; ++j) { bq[j] = b0[j]; bq[4 + j] = b1[j]; Rr[ks][j] = r0[j]; Rr[ks][4 + j] = r1[j]; }
#pragma unroll
            for (int j = 0; j < 8; ++j) { a[j] = qf[j] * __expf(bq[j]); a2[j] = qf[j] * __expf(bq[j] - Rr[ks][j]); }
            qtil[ks] = pack8(a); qhat[ks] = pack8(a2); }
        f32x4 o[4];
#pragma unroll
        for (int n = 0; n < 4; ++n) { o[n] = (f32x4){0.f, 0.f, 0.f, 0.f};
#pragma unroll
            for (int ks = 0; ks < 4; ++ks) o[n] = MFMA16(sfrv[n][ks], qtil[ks], o[n]); }
        unsigned pk[4][2];
#pragma unroll
        for (int i = 0; i < 4; ++i) {
            if (i <= mt) { f32x4 sc = {0.f, 0.f, 0.f, 0.f}; const int s = 16 * i + fr;
#pragma unroll
                for (int ks = 0; ks < 4; ++ks) { float kt[8];
                    const f32x4 b0 = *(const LAS f32x4*)(bt + (s + 1) * 132 + 32 * ks + 8 * fq), b1 = *(const LAS f32x4*)(bt + (s + 1) * 132 + 32 * ks + 8 * fq + 4);
                    const f32x4 m0 = *(const LAS f32x4*)(bt + s * 132 + 32 * ks + 8 * fq), m1 = *(const LAS f32x4*)(bt + s * 132 + 32 * ks + 8 * fq + 4);
#pragma unroll
                    for (int j = 0; j < 4; ++j) { kt[j] = (1.0f - __expf(b0[j] - m0[j])) * __expf(Rr[ks][j] - b0[j]); kt[4 + j] = (1.0f - __expf(b1[j] - m1[j])) * __expf(Rr[ks][4 + j] - b1[j]); }
                    sc = MFMA16(pack8(kt), qhat[ks], sc); }
                if (i == mt) {
#pragma unroll
                    for (int j = 0; j < 4; ++j) if (4 * fq + j > fr) sc[j] = 0.f; }
                pk[i][0] = cvt_pk_bf16(sc[0], sc[1]); pk[i][1] = cvt_pk_bf16(sc[2], sc[3]);
            } else { pk[i][0] = 0u; pk[i][1] = 0u; } }
#pragma unroll
        for (int kk = 0; kk < 2; ++kk) if (2 * kk <= mt) {
            u32x4 pw; pw.x = pk[2 * kk][0]; pw.y = pk[2 * kk][1]; pw.z = pk[2 * kk + 1][0]; pw.w = pk[2 * kk + 1][1]; const bf16x8 pf = __builtin_bit_cast(bf16x8, pw);
#pragma unroll
            for (int n = 0; n < 4; ++n) { const bf16* vrow = VT + (size_t)(h * 128 + 16 * (4 * nh + n) + fr) * M + c * 64 + 32 * kk + 4 * fq;
                const u32x2 lo = *(const u32x2*)vrow, hi = *(const u32x2*)(vrow + 16); u32x4 vw; vw.x = lo.x; vw.y = lo.y; vw.z = hi.x; vw.w = hi.y;
                o[n] = MFMA16(__builtin_bit_cast(bf16x8, vw), pf, o[n]); } }
        float ss = 0.f;
#pragma unroll
        for (int n = 0; n < 4; ++n) ss += (o[n][0] * o[n][0] + o[n][1] * o[n][1]) + (o[n][2] * o[n][2] + o[n][3] * o[n][3]);
        ss += __shfl_xor(ss, 16); ss += __shfl_xor(ss, 32);
        if (fq == 0) red[wave * 16 + fr] = ss;
        __syncthreads();
        const float rstd = 1.0f / sqrtf((ss + red[(wave ^ 1) * 16 + fr]) * (1.0f / 128.0f) + RMS_EPS);
#pragma unroll
        for (int n = 0; n < 4; ++n) { const int v0 = h * 128 + 16 * (4 * nh + n) + 4 * fq; const u32x2 gw = *(const u32x2*)(GATE + tok * 1024 + v0); const f32x4 ng = *(const f32x4*)(norm_g + v0);
            u32x2 w; w.x = cvt_pk_bf16(o[n][0] * rstd * ng[0] * bf_lo(gw.x), o[n][1] * rstd * ng[1] * bf_hi(gw.x)); w.y = cvt_pk_bf16(o[n][2] * rstd * ng[2] * bf_lo(gw.y), o[n][3] * rstd * ng[3] * bf_hi(gw.y));
            *(u32x2*)(OG + tok * 1024 + v0) = w; }
    }
    __syncthreads();
}

constexpr int KS_STRIDE = 272, VS_STRIDE = 528, KS_BYTES = 256 * KS_STRIDE, VS_BYTES = 128 * VS_STRIDE, PRE_OFF = KS_BYTES + VS_BYTES;
constexpr float ATT_SC2 = 0.08838834764831845f * 1.4426950408889634f;
__device__ __forceinline__ int list_off(int n) { return 256 * (63 * n - (n * (n - 1)) / 2); }
__device__ __forceinline__ void mb_stage(const bf16* K, const bf16* VT, int h, int n, LAS unsigned char* lds, int tid) {
#pragma unroll
    for (int i = 0; i < 8; ++i) { const int row = (tid >> 4) + 32 * i, ch = tid & 15; *(LAS u32x4*)(lds + row * KS_STRIDE + ch * 16) = *(const u32x4*)(K + (size_t)(256 * n + row) * 1024 + h * 128 + 8 * ch); }
#pragma unroll
    for (int i = 0; i < 8; ++i) { const int row = (tid >> 5) + 16 * i, ch = tid & 31; *(LAS u32x4*)(lds + KS_BYTES + row * VS_STRIDE + ch * 16) = *(const u32x4*)(VT + (size_t)(h * 128 + row) * M + 256 * n + 8 * ch); }
}
__device__ __forceinline__ void attn_group(LAS const unsigned char* lds, const bf16x8 (&qf)[4], float ref2, int nkt, bool causal, int qpos, int fr, int fq, f32x4 (&o)[8], float& l) {
    unsigned pk[16][2]; float lsum = 0.f;
#pragma unroll
    for (int kt = 0; kt < 16; ++kt) {
        if (kt < nkt) { f32x4 s = {0.f, 0.f, 0.f, 0.f};
#pragma unroll
            for (int ks = 0; ks < 4; ++ks) { const bf16x8 kf = *(const LAS bf16x8*)(lds + (16 * kt + fr) * KS_STRIDE + (32 * ks + 8 * fq) * 2); s = MFMA16(kf, qf[ks], s); }
            float pv[4];
#pragma unroll
            for (int j = 0; j < 4; ++j) { pv[j] = __builtin_amdgcn_exp2f(s[j] * ATT_SC2 - ref2); if (causal && (16 * kt + 4 * fq + j > qpos)) pv[j] = 0.f; lsum += pv[j]; }
            pk[kt][0] = cvt_pk_bf16(pv[0], pv[1]); pk[kt][1] = cvt_pk_bf16(pv[2], pv[3]);
        } else { pk[kt][0] = 0u; pk[kt][1] = 0u; } }
#pragma unroll
    for (int dt = 0; dt < 8; ++dt) o[dt] = (f32x4){0.f, 0.f, 0.f, 0.f};
#pragma unroll
    for (int kk = 0; kk < 8; ++kk) if (2 * kk < nkt) {
        u32x4 pw; pw.x = pk[2 * kk][0]; pw.y = pk[2 * kk][1]; pw.z = pk[2 * kk + 1][0]; pw.w = pk[2 * kk + 1][1]; const bf16x8 pf = __builtin_bit_cast(bf16x8, pw);
#pragma unroll
        for (int dt = 0; dt < 8; ++dt) { LAS const unsigned char* vp = lds + KS_BYTES + (16 * dt + fr) * VS_STRIDE + (32 * kk + 4 * fq) * 2;
            const u32x2 lo = *(const LAS u32x2*)vp, hi = *(const LAS u32x2*)(vp + 32); u32x4 vw; vw.x = lo.x; vw.y = lo.y; vw.z = hi.x; vw.w = hi.y;
            o[dt] = MFMA16(__builtin_bit_cast(bf16x8, vw), pf, o[dt]); } }
    lsum += __shfl_xor(lsum, 16); lsum += __shfl_xor(lsum, 32); l = lsum;
}
__device__ __forceinline__ void mb_kmean(const Params& p, unsigned char* ws, LAS unsigned char* lds, int tid, int wave, int lane) {
    int bid = blockIdx.x, gdim = gridDim.x; asm volatile("" : "+s"(bid), "+s"(gdim));
    const bf16* K = (const bf16*)(ws + WS_K); float* KMEAN = (float*)(ws + WS_KMEAN); float* KNMAX = (float*)(ws + WS_KNMAX);
    LAS float* part = (LAS float*)lds; LAS float* mx = part + 8 * 128;
    for (int unit = bid; unit < 512; unit += gdim) { const int h = unit >> 6, n = unit & 63;
        float s0 = 0.f, s1 = 0.f, rm = 0.f;
        for (int r = wave; r < 256; r += 8) { const unsigned w = *(const unsigned*)(K + (size_t)(256 * n + r) * 1024 + h * 128 + 2 * lane); const float x0 = bf_lo(w), x1 = bf_hi(w);
            s0 += x0; s1 += x1; rm = fmaxf(rm, wave_sum(x0 * x0 + x1 * x1)); }
        part[wave * 128 + 2 * lane] = s0; part[wave * 128 + 2 * lane + 1] = s1; if (lane == 0) mx[wave] = rm;
        __syncthreads();
        if (tid < 128) { float s = 0.f;
#pragma unroll
            for (int w = 0; w < 8; ++w) s += part[w * 128 + tid];
            KMEAN[(size_t)unit * 128 + tid] = s * (1.0f / 256.0f); }
        if (tid == 0) { float m = 0.f;
#pragma unroll
            for (int w = 0; w < 8; ++w) m = fmaxf(m, mx[w]);
            KNMAX[unit] = m; }
        __syncthreads(); }
}
__device__ __forceinline__ void mb_gate(const Params& p, unsigned char* ws, LAS unsigned char* lds, int tid) {
    int bid = blockIdx.x, gdim = gridDim.x; asm volatile("" : "+s"(bid), "+s"(gdim));
    const bf16* Q = (const bf16*)(ws + WS_Q); const float* KMEAN = (const float*)(ws + WS_KMEAN); const float* KNMAX = (const float*)(ws + WS_KNMAX);
    int* CNT = (int*)(ws + WS_CNT); unsigned short* LIST = (unsigned short*)(ws + WS_LIST); float* QREF = (float*)(ws + WS_QREF);
    LAS float* km = (LAS float*)lds; LAS float* kn = km + 64 * 128;
    for (int item = bid; item < 256; item += gdim) { const int h = item >> 5, s = (item & 31) * 512 + tid, blk = s >> 8;
        __syncthreads();
        for (int i = tid; i < 64 * 128 / 4; i += 512) ((LAS f32x4*)km)[i] = ((const f32x4*)(KMEAN + (size_t)h * 64 * 128))[i];
        if (tid < 64) kn[tid] = KNMAX[h * 64 + tid];
        __syncthreads();
        unsigned qp[64]; float qq = 0.f;
#pragma unroll
        for (int ch = 0; ch < 16; ++ch) { const u32x4 w = *(const u32x4*)(Q + (size_t)s * 1024 + h * 128 + 8 * ch); qp[4 * ch] = w.x; qp[4 * ch + 1] = w.y; qp[4 * ch + 2] = w.z; qp[4 * ch + 3] = w.w; }
#pragma unroll
        for (int i = 0; i < 64; ++i) { const float x0 = bf_lo(qp[i]), x1 = bf_hi(qp[i]); qq += x0 * x0 + x1 * x1; }
        float kmax = 0.f;
#pragma unroll 8
        for (int n = 0; n < 64; ++n) kmax = fmaxf(kmax, kn[n]);
        QREF[(size_t)s * 8 + h] = sqrtf(qq) * sqrtf(kmax) * ATT_SC2;
        float b0 = -3.0e38f, b1 = -3.0e38f, b2 = -3.0e38f; int i0 = 0, i1 = 0, i2 = 0;
#pragma unroll 1
        for (int n = 0; n < blk; ++n) { float d0 = 0.f, d1 = 0.f, d2 = 0.f, d3 = 0.f;
#pragma unroll
            for (int c8 = 0; c8 < 4; ++c8) {
#pragma unroll
                for (int c4 = 8 * c8; c4 < 8 * c8 + 8; ++c4) { const f32x4 k4 = *(const LAS f32x4*)(km + n * 128 + 4 * c4);
                    d0 += bf_lo(qp[2 * c4]) * k4[0]; d1 += bf_hi(qp[2 * c4]) * k4[1]; d2 += bf_lo(qp[2 * c4 + 1]) * k4[2]; d3 += bf_hi(qp[2 * c4 + 1]) * k4[3]; }
                asm volatile("" ::: "memory"); }
            const float v = (d0 + d1) + (d2 + d3);
            if (v > b0) { b2 = b1; i2 = i1; b1 = b0; i1 = i0; b0 = v; i0 = n; } else if (v > b1) { b2 = b1; i2 = i1; b1 = v; i1 = n; } else if (v > b2) { b2 = v; i2 = n; } }
#pragma unroll
        for (int r = 0; r < 3; ++r) { if (r < blk) { const int bi = r == 0 ? i0 : (r == 1 ? i1 : i2);
                const int pos = atomicAdd(&CNT[h * 64 + bi], 1);
                LIST[(size_t)h * LIST_PER_HEAD + list_off(bi) + pos] = (unsigned short)(s | (r << 14)); } }
    }
    __syncthreads();
}
__device__ __forceinline__ void mb_sel(const Params& p, unsigned char* ws, LAS unsigned char* lds, int tid, int wave, int lane) {
    int bid = blockIdx.x, gdim = gridDim.x; asm volatile("" : "+s"(bid), "+s"(gdim));
    const bf16* Q = (const bf16*)(ws + WS_Q); const bf16* K = (const bf16*)(ws + WS_K); const bf16* VT = (const bf16*)(ws + WS_VT);
    const int* CNT = (const int*)(ws + WS_CNT); const unsigned short* LIST = (const unsigned short*)(ws + WS_LIST); const float* QREF = (const float*)(ws + WS_QREF);
    bf16* PART = (bf16*)(ws + WS_PART); float* LPART = (float*)(ws + WS_LPART);
    LAS int* pre = (LAS int*)(lds + PRE_OFF); LAS int* wtot = pre + 520;
    const int fr = lane & 15, fq = lane >> 4;
    { const int tl = (CNT[tid] + 127) >> 7; int x = tl;
#pragma unroll
        for (int o = 1; o < 64; o <<= 1) { const int y = __shfl_up(x, o); if (lane >= o) x += y; }
        if (lane == 63) wtot[wave] = x;
        __syncthreads();
        int add = 0;
#pragma unroll
        for (int w = 0; w < 8; ++w) if (w < wave) add += wtot[w];
        pre[tid + 1] = x + add; if (tid == 0) pre[0] = 0;
        __syncthreads(); }
    const int T = pre[512];
    const int lo = (int)(((long)T * bid) / gdim), hi = (int)(((long)T * (bid + 1)) / gdim);
    LAS unsigned short* ents = (LAS unsigned short*)(lds + PRE_OFF + 2112); constexpr int ENT_TILES = 30;
    { const int nit = (hi - lo) < ENT_TILES ? (hi - lo) : ENT_TILES;
        for (int j = tid; j < nit * 128; j += 512) { const int it = lo + (j >> 7); int a = 0, b2 = 511;
            while (a < b2) { const int mid = (a + b2 + 1) >> 1; if (pre[mid] <= it) a = mid; else b2 = mid - 1; }
            const int idx = (it - pre[a]) * 128 + (j & 127);
            ents[j] = idx < CNT[a] ? LIST[(size_t)(a >> 6) * LIST_PER_HEAD + list_off(a & 63) + idx] : (unsigned short)0xFFFFu; }
        __syncthreads(); }
    int c_hn = 0, c_s = 0, c_slot = 0; bool c_valid = false; float c_ref = 0.f; bf16x8 c_qf[4];
    int n_hn = 0, n_s = 0, n_slot = 0; bool n_valid = false; float n_ref = 0.f; bf16x8 n_qf[4];
#define MB_FETCH(IT, HN, S_, SLOT, VALID, REF, QF) do { const int it_ = (IT); int a_ = 0, b_ = 511; \
        while (a_ < b_) { const int mid = (a_ + b_ + 1) >> 1; if (pre[mid] <= it_) a_ = mid; else b_ = mid - 1; } \
        HN = a_; unsigned ent_; const int rel_ = it_ - lo; \
        if (rel_ < ENT_TILES) ent_ = ents[rel_ * 128 + wave * 16 + fr]; \
        else { const int idx_ = (it_ - pre[a_]) * 128 + wave * 16 + fr; ent_ = idx_ < CNT[a_] ? LIST[(size_t)(a_ >> 6) * LIST_PER_HEAD + list_off(a_ & 63) + idx_] : 0xFFFFu; } \
        VALID = ent_ != 0xFFFFu; S_ = VALID ? (int)(ent_ & 0x3fffu) : 0; SLOT = (int)(ent_ >> 14); \
        const bf16* qr_ = Q + (size_t)S_ * 1024 + (a_ >> 6) * 128; \
        _Pragma("unroll") for (int ks = 0; ks < 4; ++ks) QF[ks] = *(const bf16x8*)(qr_ + 32 * ks + 8 * fq); \
        REF = QREF[(size_t)S_ * 8 + (a_ >> 6)]; } while (0)
    if (lo < hi) MB_FETCH(lo, c_hn, c_s, c_slot, c_valid, c_ref, c_qf);
    int cur = -1;
    for (int it = lo; it < hi; ++it) {
        if (it + 1 < hi) MB_FETCH(it + 1, n_hn, n_s, n_slot, n_valid, n_ref, n_qf);
        const int hn = c_hn, h = hn >> 6, n = hn & 63;
        if (hn != cur) { __syncthreads(); mb_stage(K, VT, h, n, lds, tid); __syncthreads(); cur = hn; }
        if (__ballot(c_valid) != 0ull) {
            f32x4 o[8]; float l;
            attn_group(lds, c_qf, c_ref, 16, false, 0, fr, fq, o, l);
            if (c_valid) { bf16* pp = PART + ((size_t)c_slot * M + c_s) * 1024 + h * 128 + 4 * fq;
#pragma unroll
                for (int dt = 0; dt < 8; ++dt) { u32x2 w; w.x = cvt_pk_bf16(o[dt][0], o[dt][1]); w.y = cvt_pk_bf16(o[dt][2], o[dt][3]); *(u32x2*)(pp + 16 * dt) = w; }
                if (fq == 0) LPART[((size_t)c_slot * M + c_s) * 8 + h] = l; } }
        c_hn = n_hn; c_s = n_s; c_slot = n_slot; c_valid = n_valid; c_ref = n_ref;
#pragma unroll
        for (int ks = 0; ks < 4; ++ks) c_qf[ks] = n_qf[ks];
    }
#undef MB_FETCH
    __syncthreads();
}
__device__ __forceinline__ void mb_own(const Params& p, unsigned char* ws, LAS unsigned char* lds, int tid, int wave, int lane) {
    int bid = blockIdx.x, gdim = gridDim.x; asm volatile("" : "+s"(bid), "+s"(gdim));
    const bf16* Q = (const bf16*)(ws + WS_Q); const bf16* K = (const bf16*)(ws + WS_K); const bf16* VT = (const bf16*)(ws + WS_VT);
    const float* QREF = (const float*)(ws + WS_QREF); const bf16* PART = (const bf16*)(ws + WS_PART); const float* LPART = (const float*)(ws + WS_LPART); bf16* OG = (bf16*)(ws + WS_Q);
    const int fr = lane & 15, fq = lane >> 4;
    for (int unit = bid; unit < 512; unit += gdim) { const int h = unit >> 6, b = unit & 63;
        __syncthreads(); mb_stage(K, VT, h, b, lds, tid); __syncthreads();
        const int nsl = b < 3 ? b : 3;
#pragma unroll 1
        for (int gi = 0; gi < 2; ++gi) { const int g = gi ? 15 - wave : wave, s = 256 * b + 16 * g + fr;
            f32x4 o[8]; float l; bf16x8 qf[4];
#pragma unroll
            for (int ks = 0; ks < 4; ++ks) qf[ks] = *(const bf16x8*)(Q + (size_t)s * 1024 + h * 128 + 32 * ks + 8 * fq);
            attn_group(lds, qf, QREF[(size_t)s * 8 + h], g + 1, true, 16 * g + fr, fr, fq, o, l);
            for (int j = 0; j < nsl; ++j) { const bf16* pp = PART + ((size_t)j * M + s) * 1024 + h * 128 + 4 * fq; l += LPART[((size_t)j * M + s) * 8 + h];
#pragma unroll
                for (int dt = 0; dt < 8; ++dt) { const u32x2 w = *(const u32x2*)(pp + 16 * dt); o[dt][0] += bf_lo(w.x); o[dt][1] += bf_hi(w.x); o[dt][2] += bf_lo(w.y); o[dt][3] += bf_hi(w.y); } }
            const float inv = 1.0f / l; bf16* op = OG + (size_t)s * 1024 + h * 128 + 4 * fq;
#pragma unroll
            for (int dt = 0; dt < 8; ++dt) { u32x2 w; w.x = cvt_pk_bf16(o[dt][0] * inv, o[dt][1] * inv); w.y = cvt_pk_bf16(o[dt][2] * inv, o[dt][3] * inv); *(u32x2*)(op + 16 * dt) = w; } }
    }
    __syncthreads();
}
__device__ __forceinline__ void sc_conv(const Params& p, unsigned char* ws, int L, int tid) {
    int bid = blockIdx.x, gdim = gridDim.x; asm volatile("" : "+s"(bid), "+s"(gdim));
    const bf16* PROJ = (const bf16*)(ws + WS_PROJ); bf16* OG = (bf16*)(ws + WS_OGSC); const float* cw = as_global(p.in[base_of(L) + 1]);
    for (int idx = bid * 512 + tid; idx < (M / 8) * 128; idx += gdim * 512) { const int t0 = (idx >> 7) * 8, c = (idx & 127) * 8;
        f32x4 w[3][2];
#pragma unroll
        for (int k = 0; k < 3; ++k) { w[k][0] = *(const f32x4*)(cw + k * 1024 + c); w[k][1] = *(const f32x4*)(cw + k * 1024 + c + 4); }
        float p0[8], p1[8], p2[8];
#pragma unroll
        for (int j = 0; j < 8; ++j) { p0[j] = 0.f; p1[j] = 0.f; p2[j] = 0.f; }
#pragma unroll
        for (int k = -2; k < 8; ++k) { const int tt = t0 + k;
#pragma unroll
            for (int j = 0; j < 8; ++j) { p0[j] = p1[j]; p1[j] = p2[j]; p2[j] = 0.f; }
            if (tt >= 0) { float cgv[8], hv[8]; unpack8(*(const bf16x8*)(PROJ + (size_t)tt * 3072 + 1024 + c), cgv); unpack8(*(const bf16x8*)(PROJ + (size_t)tt * 3072 + 2048 + c), hv);
#pragma unroll
                for (int j = 0; j < 8; ++j) p2[j] = cgv[j] * hv[j]; }
            if (k >= 0) { float bg[8], o[8]; unpack8(*(const bf16x8*)(PROJ + (size_t)tt * 3072 + c), bg);
#pragma unroll
                for (int j = 0; j < 8; ++j) o[j] = bg[j] * (w[0][j >> 2][j & 3] * p0[j] + w[1][j >> 2][j & 3] * p1[j] + w[2][j >> 2][j & 3] * p2[j]);
                *(bf16x8*)(OG + (size_t)tt * 1024 + c) = pack8(o); } } }
}

#define XB_TMO      128
#define XB_XCNT(j)  (256  + 64 * (j))
#define XB_XSUB(j)  (1280 + 64 * (j))
#define XB_XGEN(j)  (2304 + 64 * (j))
#define XB_TOP      3328
#define XB_TOPGEN   3392
#define XCD_BAR_WORDS 3456
#define XB_SPIN_CAP (1u << 18)

__device__ __forceinline__ unsigned xb_ld(unsigned* p)              { return __hip_atomic_load(p, __ATOMIC_RELAXED, __HIP_MEMORY_SCOPE_AGENT); }
__device__ __forceinline__ unsigned xb_add(unsigned* p, unsigned v) { return __hip_atomic_fetch_add(p, v, __ATOMIC_RELAXED, __HIP_MEMORY_SCOPE_AGENT); }
__device__ __forceinline__ unsigned xb_xcc_id() { return (unsigned)__builtin_amdgcn_s_getreg((3 << 11) | 20) & 0xFu; }
#define XB_SPIN(cond, bar) do { unsigned _sp = 0; while (cond) { __builtin_amdgcn_s_sleep(1); \
    if ((++_sp & 255u) == 0u) { if (xb_ld(&(bar)[XB_TMO])) break; if (_sp > XB_SPIN_CAP) { atomicAdd(&(bar)[XB_TMO], 1u); break; } } } } while (0)

struct XcdBarrier {
    unsigned* bar; unsigned x;
    volatile LAS unsigned* st;
};

__device__ __forceinline__ XcdBarrier xcd_barrier_post(unsigned* bar, volatile LAS unsigned* st) {
    XcdBarrier b; b.bar = bar; b.x = xb_xcc_id(); b.st = st;
    if (threadIdx.x == 0) (void)xb_add(&bar[XB_XCNT(b.x)], 1u);
    return b;
}
__device__ __forceinline__ void xcd_barrier_complete(unsigned* bar, unsigned x, unsigned& nloc, unsigned& nx) {
    const unsigned G = gridDim.x * gridDim.y * gridDim.z;
    unsigned sum, cnt, mine, sp = 0u;
    for (;;) {
        sum = 0u; cnt = 0u; mine = 0u;
#pragma unroll
        for (unsigned j = 0; j < 16; ++j) { const unsigned c = xb_ld(&bar[XB_XCNT(j)]); sum += c; cnt += (c > 0u) ? 1u : 0u; mine = (j == x) ? c : mine; }
        if (sum == G) break;
        __builtin_amdgcn_s_sleep(1);
        if ((++sp & 255u) == 0u) { if (xb_ld(&bar[XB_TMO])) break; if (sp > XB_SPIN_CAP) { atomicAdd(&bar[XB_TMO], 1u); break; } }
    }
    nloc = mine > 0u ? mine : 1u; nx = cnt > 0u ? cnt : 1u;
}

__device__ __forceinline__ void xcd_barrier(const XcdBarrier& b) {
    asm volatile("s_waitcnt vmcnt(0)" ::: "memory");
    __syncthreads();
    if (threadIdx.x == 0) {
        unsigned* bar = b.bar;
        __builtin_amdgcn_s_waitcnt(0);
        unsigned nloc = b.st[0], nx = b.st[1];
        if (nloc == 0u) { xcd_barrier_complete(bar, b.x, nloc, nx); b.st[0] = nloc; b.st[1] = nx; }
        const unsigned old = xb_add(&bar[XB_XSUB(b.x)], 1u);
        const unsigned gen = old / nloc;
        if (old + 1u == (gen + 1u) * nloc) {
            __builtin_amdgcn_fence(__ATOMIC_RELEASE, "agent");
            asm volatile("s_waitcnt vmcnt(0)" ::: "memory");
            const unsigned og = xb_add(&bar[XB_TOP], 1u);
            const unsigned tg = og / nx;
            if (og + 1u == (tg + 1u) * nx) xb_add(&bar[XB_TOPGEN], 1u);
            else XB_SPIN(xb_ld(&bar[XB_TOPGEN]) == tg, bar);
            __builtin_amdgcn_fence(__ATOMIC_ACQUIRE, "agent");
            xb_add(&bar[XB_XGEN(b.x)], 1u);
            asm volatile("s_waitcnt vmcnt(0)" ::: "memory");
        } else {
            XB_SPIN(xb_ld(&bar[XB_XGEN(b.x)]) == gen, bar);
            __builtin_amdgcn_fence(__ATOMIC_ACQUIRE, "agent");
            asm volatile("s_waitcnt vmcnt(0)" ::: "memory");
        }
    }
    __syncthreads();
}


__global__ void __launch_bounds__(512, 2) mk_fwd(Params p) {
    extern __shared__ __attribute__((aligned(16))) unsigned char lds_raw[];
    LAS unsigned char* lds = (LAS unsigned char*)lds_raw;
    const int G = gridDim.x;
    if (threadIdx.x < 4) ((LAS unsigned*)(lds + LDS_BARST))[threadIdx.x] = 0u;
    __syncthreads();
    if (p.hi - p.lo > 1) (void)xcd_barrier_post((unsigned*)(as_global(p.ws) + WS_BAR), (volatile LAS unsigned*)(lds + LDS_BARST));
#define GRID_BAR() do { size_t zb = 0; asm volatile("" : "+s"(zb)); unsigned char* wsb = p.ws + zb; XcdBarrier xb_; xb_.bar = (unsigned*)(wsb + WS_BAR); xb_.x = xb_xcc_id(); xb_.st = (volatile LAS unsigned*)(lds + LDS_BARST); xcd_barrier(xb_); } while (0)
#define FRESH() size_t zo = 0; int zero = 0; int tid = threadIdx.x; int bid = blockIdx.x, gdim = gridDim.x; asm volatile("" : "+s"(zo), "+s"(zero), "+v"(tid), "+s"(bid), "+s"(gdim)); \
        unsigned char* ws = p.ws + zo; float* Y = p.out + zo; \
        const int lane = tid & 63, wave = __builtin_amdgcn_readfirstlane(tid >> 6), gw = bid * 8 + wave, NGW = gdim * 8; bf16* XB = (bf16*)(ws + WS_XB); (void)lane; (void)gw; (void)NGW; (void)XB; (void)Y; (void)zero;
    for (int pi = p.lo; pi < p.hi; ++pi) {
        const int pw = __builtin_amdgcn_readfirstlane((int)p.prog[pi]); const int op = pw & 31, L = pw >> 5;
        if (op == OP_PRO) { FRESH();
            const float* x = as_global(p.in[zero]);
            for (size_t i = (size_t)bid * 512 + tid; i < (size_t)M * D / 8; i += (size_t)gdim * 512) { const f32x4 a = ((const f32x4*)x)[2 * i], b = ((const f32x4*)x)[2 * i + 1];
                u32x4 w; w.x = cvt_pk_bf16(a.x, a.y); w.y = cvt_pk_bf16(a.z, a.w); w.z = cvt_pk_bf16(b.x, b.y); w.w = cvt_pk_bf16(b.z, b.w); ((u32x4*)XB)[i] = w; }
            if (bid == 0 && tid == 0) *(unsigned*)(ws + 3 * 1024) = 0u;
            if (bid == 0) { const float* lbp = as_global(p.in[2 + zero]); float* LB = (float*)(ws + WS_LBTAB);
                for (int c = tid; c < 1024; c += 512) { const float a0 = lbp[c], a1 = lbp[1024 + c], a2 = lbp[2048 + c], a3 = lbp[3072 + c]; const float mx = fmaxf(fmaxf(a0, a1), fmaxf(a2, a3));
                    const float e0 = __expf(a0 - mx), e1 = __expf(a1 - mx), e2 = __expf(a2 - mx), e3 = __expf(a3 - mx); const float inv = 1.0f / (e0 + e1 + e2 + e3);
                    LB[c] = 0.f; LB[1024 + c] = (e1 + e2 + e3) * inv; } }
            convert_weights(p, ws, 0, lds, gw, NGW, wave, lane);
        } else if (op == OP_HG_IN || op == OP_MB_IN || op == OP_SC_IN || op == OP_OUT || op == OP_UP || op == OP_DOWN) {
            FRESH(); const int nsub = (op == OP_HG_IN || op == OP_MB_IN) ? 2 : 1;
            if (op == OP_MB_IN && bid == 0) ((int*)(ws + WS_CNT))[tid] = 0;
            for (int subx = 0; subx < nsub * (1 + DUP_GEMM); ++subx) { const int sub = subx % nsub;
                pg8::Gemm g; pg8::Epi E; int nM, nN; g.M = M; g.amode = 0; E.aux = nullptr; E.pos = nullptr; E.O1 = nullptr; E.ldc = 1024;
                bf16* WIN = (bf16*)(ws + WS_WIN);
                if (op == OP_HG_IN) {
                    if (sub == 0) { g.A = XB; g.Bt = WIN; g.N = 2048; g.K = 1024; nM = 64; nN = 8; E.mode = pg8::EPI_SILU_SPLIT; E.O0 = ws + WS_Q; E.O1 = ws + WS_GATE; }
                    else { g.A = WIN + (size_t)2048 * 1024; g.Bt = XB; g.N = M; g.K = 1024; nM = 8; nN = 64; E.mode = pg8::EPI_T_HGRN; E.O0 = ws + WS_GT; E.O1 = ws + WS_VT; E.aux = (const float*)(ws + WS_LBTAB) + (L == 0 ? 0 : 1024); }
                } else if (op == OP_MB_IN) {
                    if (sub == 0) { g.A = XB; g.Bt = WIN; g.N = 2048; g.K = 1024; nM = 64; nN = 8; E.mode = pg8::EPI_ROPE_SPLIT; E.O0 = ws + WS_Q; E.O1 = ws + WS_K; E.pos = (const int*)as_global(p.in[1 + zero]); }
                    else { g.A = WIN + (size_t)2048 * 1024; g.Bt = XB; g.N = M; g.K = 1024; nM = 4; nN = 64; E.mode = pg8::EPI_T_PLAIN; E.O0 = ws + WS_VT; }
                } else if (op == OP_SC_IN) { g.A = XB; g.Bt = WIN; g.N = 3072; g.K = 1024; nM = 64; nN = 12; E.mode = pg8::EPI_PLAIN; E.O0 = ws + WS_PROJ; E.ldc = 3072;
                } else if (op == OP_OUT) { g.A = (const bf16*)(ws + (kind_of(L) == 2 ? WS_OGSC : WS_Q)); g.Bt = (const bf16*)(ws + WS_WOUT); g.N = 1024; g.K = 1024; nM = 64; nN = 4; E.mode = pg8::EPI_RES; E.O0 = Y; E.O1 = XB;
                } else if (op == OP_UP) { g.A = XB - (size_t)2 * 1024; g.Bt = (const bf16*)(ws + WS_WUP); g.N = NFF; g.K = 1024; g.amode = 1; nM = 67; nN = 22; E.mode = pg8::EPI_UPCONV; E.O0 = ws + WS_H; E.aux = as_global(p.in[wout_of(L) + 4]);
                } else { g.A = (const bf16*)(ws + WS_H); g.Bt = (const bf16*)(ws + WS_WDN); g.N = 1024; g.K = DFF; nM = 64; nN = 4; E.mode = pg8::EPI_RES; E.O0 = Y; E.O1 = XB; }
                pg8::StaticOrder S; S.init(nM, nN, gdim, bid);
                pg8::gemm_phase<pg8::Epi, pg8::StaticOrder, true, true>(lds, g, S, E);
            }
        } else if (op == OP_HG_R1) { FRESH(); hg_r1(p, ws, wave, lane);
        } else if (op == OP_HG_R2) { FRESH(); hg_r2(p, ws, tid);
        } else if (op == OP_HG_R3) { FRESH(); hg_r3(p, ws, L, lds, tid, wave, lane);
        } else if (op == OP_MB_KMEAN) { FRESH(); mb_kmean(p, ws, lds, tid, wave, lane);
        } else if (op == OP_MB_GATE) { FRESH(); mb_gate(p, ws, lds, tid);
        } else if (op == OP_MB_SEL) { FRESH(); mb_sel(p, ws, lds, tid, wave, lane);
        } else if (op == OP_MB_OWN) { FRESH(); mb_own(p, ws, lds, tid, wave, lane);
        } else if (op == OP_SC_CONV) { FRESH(); sc_conv(p, ws, L, tid);
        } else if (op == OP_LN1 || op == OP_LN2) { FRESH();
            const int wo = wout_of(L); const float* gg = as_global(p.in[wo + (op == OP_LN1 ? 1 : 6)]); const float* bb = as_global(p.in[wo + (op == OP_LN1 ? 2 : 7)]);
            const bool fin = (op == OP_LN2 && L == 3);
            for (int r = gw; r < M; r += NGW) ln_row(Y + (size_t)r * D, gg, bb, fin ? nullptr : XB + (size_t)r * D, fin ? Y + (size_t)r * D : nullptr, lane);
            if (op == OP_LN2 && L < 3) convert_weights(p, ws, L + 1, lds, gw, NGW, wave, lane);
        }
        else if (op == OP_CONVW) { FRESH(); convert_weights(p, ws, L, lds, gw, NGW, wave, lane); }
        else if (op == OP_DIAG1) { FRESH(); const unsigned short* R = (const unsigned short*)(ws + DIAG_OFF); unsigned bad = 0;
            for (size_t i = (size_t)bid * 512 + tid; i < (size_t)DIAG_ELEMS; i += (size_t)gdim * 512) { const unsigned short v = R[i]; if ((v & 0x7f80u) == 0x7f80u) bad = 1; }
            if (bad) atomicOr((unsigned*)(ws + 3 * 1024), 1u); }
        else if (op == OP_DIAG2) { FRESH(); const float A = (*(const unsigned*)(ws + 3 * 1024)) ? 3.0f : 0.0f; for (size_t i = (size_t)bid * 512 + tid; i < (size_t)M * D; i += (size_t)gdim * 512) Y[i] = A; }
        else if (op == OP_DUMP) { FRESH(); for (size_t i = (size_t)bid * 512 + tid; i < (size_t)M * D; i += (size_t)gdim * 512) Y[i] = bf2f(XB[i]); }
        if (pi + 1 < p.hi) {
            if (p.nprog < 0) cg::this_grid().sync();
            GRID_BAR();
#if DUP_SYNC
            GRID_BAR();
#endif
        }
    }
}

extern "C" void kernel_launch(void* const* d_in, const int* in_sizes, int n_in, void* d_out, int out_size, void* d_ws, size_t ws_size, hipStream_t stream) {
    static int grid = 0;
    if (grid == 0) {
        if (n_in != 42 || out_size != M * D || ws_size < WS_NEED) { fprintf(stderr, "kernel_launch: unexpected shapes (n_in %d out %d ws %zu need %zu)\n", n_in, out_size, ws_size, (size_t)WS_NEED); grid = -1; return; }
        int dev = 0, cus = 0, per_cu = 0;
        hipGetDevice(&dev); hipDeviceGetAttribute(&cus, hipDeviceAttributeMultiprocessorCount, dev);
        hipFuncSetAttribute((const void*)mk_fwd, hipFuncAttributeMaxDynamicSharedMemorySize, LDS_BYTES);
        hipOccupancyMaxActiveBlocksPerMultiprocessor(&per_cu, (const void*)mk_fwd, 512, LDS_BYTES);
        (void)hipGetLastError();
        if (per_cu < 1) per_cu = 1;
        grid = cus * 1;
        if (grid > 256) grid = 256;
    }
    if (grid < 0) return;
    Params p{};
    for (int i = 0; i < 42; ++i) p.in[i] = (const float*)d_in[i];
    p.out = (float*)d_out; p.ws = (unsigned char*)d_ws;
    int n = 0;
    p.prog[n++] = OP_PRO;
#ifndef DBG_MIX
#define DBG_MIX 15
#endif
#ifndef DBG_FFN
#define DBG_FFN 15
#endif
    bool have_w = true, out_done = false;
    for (int L = 0; L < 4; ++L) { const int k = L % 3; const unsigned char lb = (unsigned char)(L << 5);
        const bool mix = (DBG_MIX >> L) & 1, ffn = (DBG_FFN >> L) & 1;
        if (!have_w && (mix || ffn)) { p.prog[n++] = lb | OP_CONVW; have_w = true; }
        if (mix) {
            if (k == 0) { p.prog[n++] = lb | OP_HG_IN;
#ifndef DBG_SKIPR
#define DBG_SKIPR 0
#endif
                if (!(DBG_SKIPR & 1)) p.prog[n++] = lb | OP_HG_R1;
#ifdef DBG_DIAG_AFTER_R1
                p.prog[n++] = OP_DIAG1; p.prog[n++] = OP_DIAG2; goto prog_done;
#endif
 if (!(DBG_SKIPR & 2)) p.prog[n++] = lb | OP_HG_R2; if (!(DBG_SKIPR & 4)) p.prog[n++] = lb | OP_HG_R3; }
            else if (k == 1) { p.prog[n++] = lb | OP_MB_IN; p.prog[n++] = lb | OP_MB_KMEAN; p.prog[n++] = lb | OP_MB_GATE; p.prog[n++] = lb | OP_MB_SEL; p.prog[n++] = lb | OP_MB_OWN; }
            else { p.prog[n++] = lb | OP_SC_IN; p.prog[n++] = lb | OP_SC_CONV; }
            p.prog[n++] = lb | OP_OUT; p.prog[n++] = lb | OP_LN1; }
        if (ffn) { p.prog[n++] = lb | OP_UP; p.prog[n++] = lb | OP_DOWN; p.prog[n++] = lb | OP_LN2; out_done = (L == 3); }
        else have_w = false; }
    if (!out_done) p.prog[n++] = OP_DUMP;
prog_done:
    p.nprog = n;
#if ONE_LAUNCH
    p.lo = 0; p.hi = n;
    if (hipMemsetAsync((char*)d_ws + WS_BAR, 0, BAR_ZERO_BYTES, stream) != hipSuccess) { fprintf(stderr, "memset of barrier words failed\n"); return; }
    void* args[] = {&p};
    hipError_t e = hipLaunchCooperativeKernel((const void*)mk_fwd, dim3(grid), dim3(512), args, LDS_BYTES, stream);
    if (e != hipSuccess) fprintf(stderr, "cooperative launch failed: %s (grid %d)\n", hipGetErrorString(e), grid);
#else
    for (int i = 0; i < n; ++i) { p.lo = i; p.hi = i + 1; hipLaunchKernelGGL(mk_fwd, dim3(grid), dim3(512), LDS_BYTES, stream, p); }
#endif
}
```
